# Optimizing an MI355X kernel written in HIP

```python
import math
import jax, jax.numpy as jnp
from jax import lax
import numpy as np

D_MODEL = 1024
BATCH = 8
SEQ = 2048
DEPTH = 2

CHUNK = 64
EPS = 1e-6
A_HEADS = 8
A_DK = 128
A_DV = 128
A_QK = A_HEADS * A_DK
A_VW = A_HEADS * A_DV
CONV_K = 4
A_CONV_CH = 2 * A_QK + A_VW
B_HEADS = 16
B_DH = 64
B_W = B_HEADS * B_DH
BAND_CHUNKS = 8
BAND_LEN = (BAND_CHUNKS + 1) * CHUNK
MAX_REL = 256
N_REL = (CHUNK - 1) + MAX_REL + 1
MEM_LEN = 256
M_HEADS = 4
M_DH = D_MODEL // M_HEADS
D_FF = ((8 * D_MODEL + 3 * 256 - 1) // (3 * 256)) * 256
IN_SPLITS = (A_QK, A_QK, A_VW, A_VW, A_HEADS, A_HEADS, B_W, B_W, B_W, D_MODEL, D_MODEL)
N_IN = sum(IN_SPLITS)

kernel_name = "hybrid_stream_delta_band_block"


def rmsnorm(x, g):
    xf = x.astype(jnp.float32)
    y = xf * lax.rsqrt(jnp.mean(xf * xf, axis=-1, keepdims=True) + EPS)
    return (y * g.astype(jnp.float32)).astype(x.dtype)


def _l2norm(x):
    return x * lax.rsqrt(jnp.sum(x * x, axis=-1, keepdims=True) + EPS)


def _split_cols(t, sizes):
    outs, start = [], 0
    for n in sizes:
        outs.append(t[..., start:start + n])
        start += n
    return outs


def _to_chunks(t, h, d):
    b, s, _ = t.shape
    return t.reshape(b, s // CHUNK, CHUNK, h, d).transpose(0, 3, 1, 2, 4)


def _heads_to_chunks(t):
    b, s, h = t.shape
    return t.reshape(b, s // CHUNK, CHUNK, h).transpose(0, 3, 1, 2)


def _causal_dwconv(t, w):
    return lax.conv_general_dilated(
        t, w[:, None, :], window_strides=(1,), padding=[(CONV_K - 1, 0)],
        dimension_numbers=("NWC", "WIO", "NWC"), feature_group_count=t.shape[-1])


def _gated_deltanet(q, k, v, alpha, beta, a_log, dt_bias):
    dtype = v.dtype
    b, s, _ = v.shape
    f32 = jnp.float32
    q = _l2norm(_to_chunks(q.astype(f32), A_HEADS, A_DK)) * (A_DK ** -0.5)
    k = _l2norm(_to_chunks(k.astype(f32), A_HEADS, A_DK))
    v = _to_chunks(v.astype(f32), A_HEADS, A_DV)
    beta = _heads_to_chunks(jax.nn.sigmoid(beta.astype(f32)))
    g = -jnp.exp(a_log.astype(f32)) * jax.nn.softplus(alpha.astype(f32) + dt_bias.astype(f32))
    G = jnp.cumsum(_heads_to_chunks(g), axis=-1)
    incl = jnp.tril(jnp.ones((CHUNK, CHUNK), dtype=bool))
    strict = jnp.tril(jnp.ones((CHUNK, CHUNK), dtype=bool), -1)
    diff = G[..., :, None] - G[..., None, :]
    decay = jnp.where(incl, jnp.exp(jnp.where(incl, diff, 0.0)), 0.0)
    kk = jnp.einsum("bhncd,bhnjd->bhncj", k, k)
    L = jnp.where(strict, beta[..., :, None] * kk * decay, 0.0)
    rhs = jnp.concatenate([beta[..., None] * v, (beta * jnp.exp(G))[..., None] * k], axis=-1)
    sol = lax.linalg.triangular_solve(jnp.eye(CHUNK, dtype=f32) + L, rhs, left_side=True,
                                      lower=True, unit_diagonal=True)
    u_t, w = sol[..., :A_DV], sol[..., A_DV:]
    p_intra = jnp.einsum("bhncd,bhnjd->bhncj", q, k) * decay
    q_dec = q * jnp.exp(G)[..., None]
    g_last = G[..., -1]
    k_dec = k * jnp.exp(g_last[..., None] - G)[..., None]
    xs = tuple(jnp.moveaxis(t, 2, 0) for t in (u_t, w, p_intra, q_dec, k_dec, jnp.exp(g_last)))

    def step(S, inp):
        ut, wt, pt, qt, kt, et = inp
        U = ut - jnp.einsum("bhck,bhkv->bhcv", wt, S)
        o = jnp.einsum("bhck,bhkv->bhcv", qt, S) + jnp.einsum("bhcj,bhjv->bhcv", pt, U)
        S = S * et[..., None, None] + jnp.einsum("bhck,bhcv->bhkv", kt, U)
        return S, o

    S0 = jnp.zeros((b, A_HEADS, A_DK, A_DV), f32)
    _, o = lax.scan(step, S0, xs)
    return o.transpose(1, 0, 3, 2, 4).reshape(b, s, A_HEADS, A_DV).astype(dtype)


def _band_bias(rel_bias):
    i = jnp.arange(CHUNK)[:, None]
    kpos = jnp.arange(BAND_LEN)[None, :]
    r = (BAND_CHUNKS - kpos // CHUNK) * CHUNK + i - kpos % CHUNK
    idx = jnp.clip(r, -(CHUNK - 1), MAX_REL) + (CHUNK - 1)
    return rel_bias[:, idx].astype(jnp.float32)


def _chunk_band_attention(q, k, v, bias):
    b, s, _ = q.shape
    q = _to_chunks(q, B_HEADS, B_DH)
    pad = ((0, 0), (0, 0), (BAND_CHUNKS, 0), (0, 0), (0, 0))
    kp = jnp.pad(_to_chunks(k, B_HEADS, B_DH), pad)
    vp = jnp.pad(_to_chunks(v, B_HEADS, B_DH), pad)
    key_chunk_off = jnp.repeat(jnp.arange(BAND_CHUNKS + 1), CHUNK) - BAND_CHUNKS
    scale = B_DH ** -0.5

    def one_chunk(n):
        qn = lax.dynamic_index_in_dim(q, n, axis=2, keepdims=False)
        kb = lax.dynamic_slice_in_dim(kp, n, BAND_CHUNKS + 1, axis=2).reshape(b, B_HEADS, BAND_LEN, B_DH)
        vb = lax.dynamic_slice_in_dim(vp, n, BAND_CHUNKS + 1, axis=2).reshape(b, B_HEADS, BAND_LEN, B_DH)
        sc = jnp.einsum("bhqd,bhkd->bhqk", qn, kb).astype(jnp.float32) * scale + bias
        sc = jnp.where((n + key_chunk_off) >= 0, sc, -1e30)
        p = jax.nn.softmax(sc, axis=-1).astype(vb.dtype)
        return jnp.einsum("bhqk,bhkd->bhqd", p, vb)

    o = lax.map(one_chunk, jnp.arange(s // CHUNK))
    return o.transpose(1, 0, 3, 2, 4).reshape(b, s, B_W)


def _memory_xattn(h, memn, w_q, w_kv, w_out):
    b, s, _ = h.shape
    m = memn.shape[1]
    q = (h @ w_q).reshape(b, s, M_HEADS, M_DH)
    kk, vv = _split_cols(memn @ w_kv, (M_HEADS * M_DH, M_HEADS * M_DH))
    kk = kk.reshape(b, m, M_HEADS, M_DH)
    vv = vv.reshape(b, m, M_HEADS, M_DH)
    sc = jnp.einsum("bqhd,bkhd->bhqk", q, kk).astype(jnp.float32) * (M_DH ** -0.5)
    p = jax.nn.softmax(sc, axis=-1).astype(vv.dtype)
    o = jnp.einsum("bhqk,bkhd->bqhd", p, vv).reshape(b, s, M_HEADS * M_DH)
    return o @ w_out


def setup_inputs(seed: int = 0) -> dict:
    key = jax.random.key(seed)
    ks = jax.random.split(key, 24)
    f32 = jnp.float32

    def nrm(k, shape, scale):
        return jax.random.normal(k, shape, f32) * scale

    def gain(k, shape):
        return 1.0 + 0.02 * jax.random.normal(k, shape, f32)

    dt = jnp.exp(jax.random.uniform(ks[6], (DEPTH, A_HEADS), f32, math.log(1e-3), math.log(1e-1)))
    return {
        "x": nrm(ks[0], (BATCH, SEQ, D_MODEL), 1.0),
        "mem": nrm(ks[1], (BATCH, MEM_LEN, D_MODEL), 1.0),
        "norm_mix": gain(ks[2], (DEPTH, D_MODEL)),
        "w_in": nrm(ks[3], (DEPTH, D_MODEL, N_IN), D_MODEL ** -0.5),
        "conv_w": nrm(ks[4], (DEPTH, CONV_K, A_CONV_CH), CONV_K ** -0.5),
        "a_log": jnp.log(jax.random.uniform(ks[5], (DEPTH, A_HEADS), f32, 1.0, 16.0)),
        "dt_bias": dt + jnp.log(-jnp.expm1(-dt)),
        "head_norm": gain(ks[7], (DEPTH, A_DV)),
        "w_a_out": nrm(ks[8], (DEPTH, A_VW, D_MODEL), A_VW ** -0.5),
        "w_b_out": nrm(ks[9], (DEPTH, B_W, D_MODEL), B_W ** -0.5),
        "rel_bias": nrm(ks[10], (B_HEADS, N_REL), 0.5),
        "w_o": nrm(ks[11], (DEPTH, D_MODEL, D_MODEL), D_MODEL ** -0.5),
        "norm_xattn": gain(ks[12], (DEPTH, D_MODEL)),
        "norm_mem": gain(ks[13], (DEPTH, D_MODEL)),
        "w_mq": nrm(ks[14], (DEPTH, D_MODEL, M_HEADS * M_DH), D_MODEL ** -0.5),
        "w_mkv": nrm(ks[15], (DEPTH, D_MODEL, 2 * M_HEADS * M_DH), D_MODEL ** -0.5),
        "w_mo": nrm(ks[16], (DEPTH, M_HEADS * M_DH, D_MODEL), (M_HEADS * M_DH) ** -0.5),
        "norm_ffn": gain(ks[17], (DEPTH, D_MODEL)),
        "w_gate_up": nrm(ks[18], (DEPTH, D_MODEL, 2 * D_FF), D_MODEL ** -0.5),
        "w_down": nrm(ks[19], (DEPTH, D_FF, D_MODEL), D_FF ** -0.5),
        "norm_final": gain(ks[20], (D_MODEL,)),
    }


def reference(x, mem, norm_mix, w_in, conv_w, a_log, dt_bias, head_norm, w_a_out, w_b_out,
              rel_bias, w_o, norm_xattn, norm_mem, w_mq, w_mkv, w_mo, norm_ffn, w_gate_up,
              w_down, norm_final):
    b, s, _ = x.shape
    band_bias = _band_bias(rel_bias)
    for l in range(DEPTH):
        h = rmsnorm(x, norm_mix[l])
        qa, ka, va, za, alpha, beta, qb, kb, vb, ga, gb = _split_cols(h @ w_in[l], IN_SPLITS)
        qkv = jax.nn.silu(_causal_dwconv(jnp.concatenate([qa, ka, va], axis=-1), conv_w[l]))
        qa, ka, va = _split_cols(qkv, (A_QK, A_QK, A_VW))
        oa = _gated_deltanet(qa, ka, va, alpha, beta, a_log[l], dt_bias[l])
        oa = rmsnorm(oa, head_norm[l]) * jax.nn.silu(za.reshape(b, s, A_HEADS, A_DV))
        oa = oa.reshape(b, s, A_VW)
        ob = _chunk_band_attention(qb, kb, vb, band_bias)
        y = jax.nn.sigmoid(ga) * (oa @ w_a_out[l]) + jax.nn.sigmoid(gb) * (ob @ w_b_out[l])
        x = x + y @ w_o[l]
        x = x + _memory_xattn(rmsnorm(x, norm_xattn[l]), rmsnorm(mem, norm_mem[l]),
                              w_mq[l], w_mkv[l], w_mo[l])
        gate, up = _split_cols(rmsnorm(x, norm_ffn[l]) @ w_gate_up[l], (D_FF, D_FF))
        x = x + (jax.nn.silu(gate) * up) @ w_down[l]
    return rmsnorm(x, norm_final)
```

```cpp
#include <hip/hip_runtime.h>
#include <hip/hip_cooperative_groups.h>
#include <cstdio>
#include <cstdint>
namespace cg = cooperative_groups;
namespace pg8 {
#define PG8_LAS __attribute__((address_space(3)))
typedef unsigned short bf16_t;
typedef short bf16x8 __attribute__((ext_vector_type(8)));
typedef float f32x4 __attribute__((ext_vector_type(4)));
typedef unsigned u32x4 __attribute__((ext_vector_type(4)));
constexpr int BM = 256, BK = 64, HALF = 128, HTB = HALF * BK * 2  , STAGE_BYTES = 8 * HTB, NXCD = 8, WGM = 8;

__host__ __device__ __forceinline__ int lds_byte(int r, int c) { const int st = (r >> 4) * 2 + (c >> 5), rr = r & 15, cc = c & 31, ob = rr * 64 + cc * 2; return st * 1024 + (ob ^ (((ob >> 9) & 1) << 5)); }
__host__ __device__ __forceinline__ void stage_rc(int b, int& R, int& C) { const int st = b / 1024, sb = b % 1024, swz = sb ^ (((sb >> 9) & 1) << 5); R = (st >> 1) * 16 + swz / 64; C = (st & 1) * 32 + (swz % 64) / 2; }
__host__ __device__ __forceinline__ int perm32(int rho) { const int n = rho >> 4, i = rho & 15; return 8 * (i >> 2) + 4 * n + (i & 3); }

struct Unit { int pm, pn; };
struct Gemm { const bf16_t* A; const bf16_t* Bt; int M, N, K; };

struct StaticOrder {
    int nM, nN, nwg, G, c;
    __host__ __device__ void init(int M, int N, int G_, int c_) { nM = M / BM; nN = N / BM; nwg = nM * nN; G = G_; c = c_; }
    __host__ __device__ bool next(int i, Unit& u) const {
        const long L = (long)i * G + c; if (L >= nwg) return false;
        int wgid = (int)L; { const int q = nwg / NXCD, r = nwg % NXCD, xcd = wgid % NXCD, off = wgid / NXCD; wgid = (xcd < r ? xcd * (q + 1) : r * (q + 1) + (xcd - r) * q) + off; }
        const int nig = WGM * nN, gid = wgid / nig, fm = gid * WGM, gsz = (nM - fm) < WGM ? (nM - fm) : WGM;
        u.pm = fm + ((wgid % nig) % gsz); u.pn = (wgid % nig) / gsz; return true;
    }
    __device__ __forceinline__ void a_ready(const Unit&) const {}
    __device__ __forceinline__ void done(const Unit&) const {}
};

typedef float f32x2 __attribute__((ext_vector_type(2)));
typedef __bf16 bf16x2_t __attribute__((ext_vector_type(2)));
typedef unsigned u32x2 __attribute__((ext_vector_type(2)));
__device__ __forceinline__ unsigned pk2(float lo, float hi) { f32x2 v = {lo, hi}; bf16x2_t b = __builtin_convertvector(v, bf16x2_t); return __builtin_bit_cast(unsigned, b); }
template <class Epi, class Sched, bool ALIGN_EPI = false, bool SP2 = false>
__device__ __forceinline__ void gemm_phase(PG8_LAS unsigned char* lds, const Gemm g, const Sched& S, const Epi& E) {
    int tid_ = threadIdx.x; asm volatile("" : "+v"(tid_));
    const int tid = tid_, wid = __builtin_amdgcn_readfirstlane(tid >> 6), lane = tid & 63, wr = wid >> 2, wc = wid & 3, fr = lane & 15, fq = lane >> 4;
    const int K = g.K, nt = K / BK;
    unsigned voffA[2], voffB[2];
#pragma unroll
    for (int i = 0; i < 2; ++i) { int R, C; stage_rc(tid * 16 + i * 8192, R, C); const int Rb = Epi::PERM ? ((R & ~31) + perm32(R & 31)) : R;
        voffA[i] = (unsigned)(R * K + C) * 2u; voffB[i] = (unsigned)(Rb * K + C) * 2u; }
    const size_t kstep = (size_t)(BK * 2);
    const size_t hstep = (size_t)HALF * K * 2;
    const size_t tstep = 2 * hstep;
    const unsigned ldsw = (unsigned)wid * 1024u;
    const int aoff = lds_byte(wr * 64 + fr, fq * 8), boff = lds_byte(wc * 32 + fr, fq * 8);
#define PG8_SA(b, h) (((b) * 2 + (h)) * HTB)
#define PG8_SB(b, h) ((4 + (b) * 2 + (h)) * HTB)
#define PG8_STAGE(bufoff, gbase, voff) do { _Pragma("unroll") for (int _i = 0; _i < 2; ++_i) \
        __builtin_amdgcn_global_load_lds((const unsigned*)((const char*)(gbase) + (voff)[_i]), (PG8_LAS unsigned*)(lds + (bufoff) + ldsw + _i * 8192), 16, 0, 0); } while (0)
#define PG8_LDA(dst, b, h) do { _Pragma("unroll") for (int m = 0; m < 4; ++m) _Pragma("unroll") for (int k = 0; k < 2; ++k) dst[m][k] = *(const PG8_LAS bf16x8*)(lds + PG8_SA(b, h) + aoff + m * 2048 + k * 1024); } while (0)
#define PG8_LDB(dst, b, h) do { _Pragma("unroll") for (int n = 0; n < 2; ++n) _Pragma("unroll") for (int k = 0; k < 2; ++k) dst[n][k] = *(const PG8_LAS bf16x8*)(lds + PG8_SB(b, h) + boff + n * 2048 + k * 1024); } while (0)
#define PG8_MMA(ai, bj, At, Bt) do { __builtin_amdgcn_s_setprio(1); _Pragma("unroll") for (int m = 0; m < 4; ++m) _Pragma("unroll") for (int n = 0; n < 2; ++n) _Pragma("unroll") for (int k = 0; k < 2; ++k) \
        acc[ai][bj][m][n] = __builtin_amdgcn_mfma_f32_16x16x32_bf16(Bt[n][k], At[m][k], acc[ai][bj][m][n], 0, 0, 0); __builtin_amdgcn_s_setprio(0); } while (0)
#define PG8_WAIT_V(n) asm volatile("s_waitcnt vmcnt(" #n ")" ::: "memory")
#define PG8_WAIT_L(n) asm volatile("s_waitcnt lgkmcnt(" #n ")" ::: "memory")
#define PG8_BAR __builtin_amdgcn_s_barrier()
#define PG8_SCHED __builtin_amdgcn_sched_barrier(0)
    Unit cur, nxt; int ui = 0;
    if (!S.next(0, cur)) return;
    f32x4 acc[2][2][4][2];
#pragma unroll
    for (int a = 0; a < 2; ++a)
#pragma unroll
        for (int b = 0; b < 2; ++b)
#pragma unroll
            for (int m = 0; m < 4; ++m)
#pragma unroll
                for (int n = 0; n < 2; ++n) acc[a][b][m][n] = (f32x4){0.f, 0.f, 0.f, 0.f};
    bf16x8 At[4][2], B0[2][2], B1[2][2];
    const char* cA = (const char*)g.A + (size_t)cur.pm * tstep; const char* cB = (const char*)g.Bt + (size_t)cur.pn * tstep;
    S.a_ready(cur);
    if constexpr (SP2) {
        PG8_STAGE(PG8_SB(0, 0), cB, voffB); PG8_STAGE(PG8_SB(0, 1), cB + hstep, voffB); PG8_STAGE(PG8_SA(0, 0), cA, voffA); PG8_STAGE(PG8_SA(0, 1), cA + hstep, voffA);
        if (wr == 1) PG8_BAR;
        PG8_WAIT_V(2); PG8_BAR;
        PG8_STAGE(PG8_SB(1, 0), cB + kstep, voffB); PG8_STAGE(PG8_SA(1, 0), cA + kstep, voffA); PG8_STAGE(PG8_SB(1, 1), cB + hstep + kstep, voffB);
        PG8_WAIT_V(6); PG8_BAR;
    } else {
        PG8_STAGE(PG8_SB(0, 0), cB, voffB); PG8_STAGE(PG8_SA(0, 0), cA, voffA); PG8_STAGE(PG8_SB(0, 1), cB + hstep, voffB); PG8_STAGE(PG8_SA(0, 1), cA + hstep, voffA);
        if (wr == 1) PG8_BAR;
        PG8_WAIT_V(4); PG8_BAR;
        PG8_STAGE(PG8_SB(1, 0), cB + kstep, voffB); PG8_STAGE(PG8_SA(1, 0), cA + kstep, voffA); PG8_STAGE(PG8_SB(1, 1), cB + hstep + kstep, voffB);
        PG8_WAIT_V(6); PG8_BAR;
    }
    for (;;) {
        const bool has_next = S.next(ui + 1, nxt);
        const char* nA = has_next ? (const char*)g.A + (size_t)nxt.pm * tstep : cA; const char* nB = has_next ? (const char*)g.Bt + (size_t)nxt.pn * tstep : cB;
        for (int t = 0; t < nt; t += 2) {
            const bool last = (t == nt - 2);
            const char* a1 = cA + (size_t)(t + 1) * kstep;
            const char* a2 = last ? nA : cA + (size_t)(t + 2) * kstep; const char* b2 = last ? nB : cB + (size_t)(t + 2) * kstep;
            const char* a3 = a2 + kstep; const char* b3 = b2 + kstep;
            if (last && has_next) S.a_ready(nxt);
            if constexpr (SP2) {
            PG8_LDB(B0, 0, 0); PG8_LDB(B1, 0, 1); PG8_SCHED; PG8_LDA(At, 0, 0); PG8_STAGE(PG8_SA(1, 1), a1 + hstep, voffA);
            PG8_WAIT_V(8); PG8_WAIT_L(0); PG8_BAR; PG8_MMA(0, 0, At, B0); PG8_MMA(0, 1, At, B1); PG8_BAR; PG8_SCHED;
            PG8_LDA(At, 0, 1); PG8_STAGE(PG8_SB(0, 0), b2, voffB); PG8_STAGE(PG8_SB(0, 1), b2 + hstep, voffB); PG8_STAGE(PG8_SA(0, 0), a2, voffA);
            PG8_WAIT_V(8); PG8_WAIT_L(0); PG8_BAR; PG8_MMA(1, 0, At, B0); PG8_MMA(1, 1, At, B1); PG8_BAR; PG8_SCHED;
            PG8_LDB(B0, 1, 0); PG8_LDB(B1, 1, 1); PG8_SCHED; PG8_LDA(At, 1, 0); PG8_STAGE(PG8_SA(0, 1), a2 + hstep, voffA);
            PG8_WAIT_V(8); PG8_WAIT_L(0); PG8_BAR; PG8_MMA(0, 0, At, B0); PG8_MMA(0, 1, At, B1); PG8_BAR; PG8_SCHED;
            PG8_LDA(At, 1, 1); PG8_STAGE(PG8_SB(1, 0), b3, voffB); PG8_STAGE(PG8_SB(1, 1), b3 + hstep, voffB); PG8_STAGE(PG8_SA(1, 0), a3, voffA);
            PG8_WAIT_V(8); PG8_WAIT_L(0); PG8_BAR; PG8_MMA(1, 0, At, B0); PG8_MMA(1, 1, At, B1); PG8_BAR; PG8_SCHED;
            } else {
            PG8_LDB(B0, 0, 0); PG8_SCHED; PG8_LDA(At, 0, 0); PG8_STAGE(PG8_SA(1, 1), a1 + hstep, voffA);
            PG8_WAIT_L(8); PG8_BAR; PG8_WAIT_L(0); PG8_MMA(0, 0, At, B0); PG8_BAR; PG8_SCHED;
            PG8_LDB(B1, 0, 1); PG8_STAGE(PG8_SB(0, 0), b2, voffB);
            PG8_BAR; PG8_WAIT_L(0); PG8_MMA(0, 1, At, B1); PG8_BAR;
            PG8_LDA(At, 0, 1); PG8_STAGE(PG8_SA(0, 0), a2, voffA);
            PG8_BAR; PG8_WAIT_L(0); PG8_MMA(1, 0, At, B0); PG8_BAR; PG8_SCHED;
            PG8_STAGE(PG8_SB(0, 1), b2 + hstep, voffB);
            PG8_WAIT_V(6); PG8_BAR; PG8_MMA(1, 1, At, B1); PG8_BAR;
            PG8_LDB(B0, 1, 0); PG8_SCHED; PG8_LDA(At, 1, 0); PG8_STAGE(PG8_SA(0, 1), a2 + hstep, voffA);
            PG8_WAIT_L(8); PG8_BAR; PG8_WAIT_L(0); PG8_MMA(0, 0, At, B0); PG8_BAR; PG8_SCHED;
            PG8_LDB(B1, 1, 1); PG8_STAGE(PG8_SB(1, 0), b3, voffB);
            PG8_BAR; PG8_WAIT_L(0); PG8_MMA(0, 1, At, B1); PG8_BAR;
            PG8_LDA(At, 1, 1); PG8_STAGE(PG8_SA(1, 0), a3, voffA);
            PG8_BAR; PG8_WAIT_L(0); PG8_MMA(1, 0, At, B0); PG8_BAR; PG8_SCHED;
            PG8_STAGE(PG8_SB(1, 1), b3 + hstep, voffB);
            PG8_WAIT_V(6); PG8_BAR; PG8_MMA(1, 1, At, B1); PG8_BAR;
            }
        }
        if constexpr (ALIGN_EPI) { if (wr == 0) PG8_BAR; }
        if constexpr (!Epi::AFTER_DRAIN) { E(acc, cur, wr, wc, fr, fq); S.done(cur); }
        if (!has_next) break;
#pragma unroll
        for (int a = 0; a < 2; ++a)
#pragma unroll
            for (int b = 0; b < 2; ++b)
#pragma unroll
                for (int m = 0; m < 4; ++m)
#pragma unroll
                    for (int n = 0; n < 2; ++n) acc[a][b][m][n] = (f32x4){0.f, 0.f, 0.f, 0.f};
        cur = nxt; cA = nA; cB = nB; ++ui;
        if constexpr (ALIGN_EPI) { if (wr == 1) PG8_BAR; }
    }
    PG8_WAIT_V(0);
    if constexpr (!ALIGN_EPI) { if (wr == 0) PG8_BAR; }
    PG8_BAR;
    if constexpr (Epi::AFTER_DRAIN) { E.fused(acc, cur, wr, wc, fr, fq, lds, wid, lane); S.done(cur); }
#undef PG8_SA
#undef PG8_SB
#undef PG8_STAGE
#undef PG8_LDA
#undef PG8_LDB
#undef PG8_MMA
#undef PG8_WAIT_V
#undef PG8_WAIT_L
#undef PG8_BAR
#undef PG8_SCHED
}
}
using namespace pg8;
#define LAS __attribute__((address_space(3)))
#define GAS __attribute__((address_space(1)))
template <class T> __device__ __forceinline__ T* as_global(T* p) { return (T*)(GAS T*)p; }
typedef short s16x4 __attribute__((ext_vector_type(4)));
typedef float f32x16 __attribute__((ext_vector_type(16)));

constexpr int BATCH = 8, SEQ = 2048, DM = 1024, MROWS = BATCH * SEQ, DEPTH = 2, NCH = 32;
constexpr int DFF = 2816, NIN = 9232, NIN_PAD = 9472, MEMROWS = BATCH * 256;
constexpr float EPS = 1e-6f, LOG2E = 1.4426950408889634f;
constexpr float QB_SCALE = 0.125f * LOG2E, QM_SCALE = 0.0625f * LOG2E;
constexpr size_t MiB = 1u << 20, SLOTB = 32 * MiB, SLOTE = (size_t)MROWS * DM;
constexpr size_t WS_SSQ = 1 * MiB, WS_AB = 2 * MiB, WS_HALO = 3 * MiB, WS_E = 8 * MiB, WS_MSSQ = 8 * MiB + 65536;
constexpr size_t WS_MEMB = 12 * MiB, WS_MEMKV = 16 * MiB, WS_W = 24 * MiB, WS_XB = 76 * MiB, WS_BIG = 108 * MiB, WS_END = 284 * MiB;
constexpr size_t WO_IN = 0, WO_A = WO_IN + (size_t)NIN_PAD * 1024, WO_B = WO_A + 1048576, WO_O = WO_B + 1048576, WO_MQ = WO_O + 1048576,
                 WO_MKV = WO_MQ + 1048576, WO_MO = WO_MKV + 2097152, WO_GU = WO_MO + 1048576, WO_DN = WO_GU + (size_t)2 * DFF * 1024, WO_END = WO_DN + (size_t)DFF * 1024;
static_assert(WS_W + WO_END * 2 <= WS_XB, "weights fit");
constexpr int LDS_BYTES = 147456;

__device__ __forceinline__ float bf2f(unsigned short b) { return __uint_as_float((unsigned)b << 16); }
__device__ __forceinline__ float bflo(unsigned w) { return __uint_as_float(w << 16); }
__device__ __forceinline__ float bfhi(unsigned w) { return __uint_as_float(w & 0xffff0000u); }
__device__ __forceinline__ float sigmoidf_(float x) { return __builtin_amdgcn_rcpf(1.f + __expf(-x)); }
__device__ __forceinline__ float siluf_(float x) { return x * __builtin_amdgcn_rcpf(1.f + __expf(-x)); }
__device__ __forceinline__ float row_rstd(const float* ssq, int row) {
    const f32x4* p = (const f32x4*)(ssq + (size_t)row * 16); const f32x4 a = p[0], b = p[1], c = p[2], d = p[3];
    const float s = ((a.x + a.y) + (a.z + a.w)) + ((b.x + b.y) + (b.z + b.w)) + ((c.x + c.y) + (c.z + c.w)) + ((d.x + d.y) + (d.z + d.w));
    return rsqrtf(s * (1.f / 1024.f) + EPS);
}
__device__ __forceinline__ float wave_sum(float v) {
#pragma unroll
    for (int o = 1; o < 64; o <<= 1) v += __shfl_xor(v, o);
    return v;
}

struct EpiIn {
    static constexpr bool PERM = true, AFTER_DRAIN = false;
    bf16_t* slot0; int act_slot, ab_tile; float* ab; bf16_t* halo; const float* ssq; int slot2;
    __device__ __forceinline__ void operator()(const f32x4 (&acc)[2][2][4][2], const Unit& u, int wr, int wc, int fr, int fq) const {
        float rs[2][4];
#pragma unroll
        for (int ai = 0; ai < 2; ++ai)
#pragma unroll
            for (int m = 0; m < 4; ++m) rs[ai][m] = row_rstd(ssq, u.pm * BM + ai * HALF + wr * 64 + m * 16 + fr);
        if (u.pn == ab_tile) {
            if (wc == 0 && fq < 2) {
#pragma unroll
                for (int ai = 0; ai < 2; ++ai)
#pragma unroll
                    for (int m = 0; m < 4; ++m) { const int row = u.pm * BM + ai * HALF + wr * 64 + m * 16 + fr;
#pragma unroll
                        for (int n = 0; n < 2; ++n) *(f32x4*)(ab + (size_t)row * 16 + 8 * fq + 4 * n) = acc[ai][0][m][n] * rs[ai][m]; }
            }
            return;
        }
        const int slot = u.pn >> 2; bf16_t* base = slot0 + (size_t)(slot == 2 ? slot2 : slot) * SLOTE; const bool act = (slot == act_slot);
        const int col0 = (u.pn & 3) * BM + wc * 32 + 8 * fq;
#pragma unroll
        for (int ai = 0; ai < 2; ++ai)
#pragma unroll
            for (int m = 0; m < 4; ++m) { const int row = u.pm * BM + ai * HALF + wr * 64 + m * 16 + fr; bf16_t* rowp = base + (size_t)row * DM + col0;
#pragma unroll
                for (int bj = 0; bj < 2; ++bj) { f32x4 v0 = acc[ai][bj][m][0] * rs[ai][m], v1 = acc[ai][bj][m][1] * rs[ai][m];
                    if (act) { v0 = (f32x4){siluf_(v0[0]), siluf_(v0[1]), siluf_(v0[2]), siluf_(v0[3])}; v1 = (f32x4){siluf_(v1[0]), siluf_(v1[1]), siluf_(v1[2]), siluf_(v1[3])}; }
                    u32x4 w; w.x = pk2(v0[0], v0[1]); w.y = pk2(v0[2], v0[3]); w.z = pk2(v1[0], v1[1]); w.w = pk2(v1[2], v1[3]);
                    *(u32x4*)(rowp + bj * HALF) = w;
                    if (halo && slot < 3 && m == 3 && fr >= 13) { const int hrow = (row >> 6) * 3 + (fr - 13); *(u32x4*)(halo + (size_t)hrow * 3072 + slot * 1024 + col0 + bj * HALF) = w; }
                } }
    }
};
struct EpiB {
    static constexpr bool PERM = true, AFTER_DRAIN = false;
    bf16_t* O; int ldc; const float* ssq; const bf16_t* g1; const bf16_t* t; int mode;
    __device__ __forceinline__ void operator()(const f32x4 (&acc)[2][2][4][2], const Unit& u, int wr, int wc, int fr, int fq) const {
        const int col0 = u.pn * BM + wc * 32 + 8 * fq;
#pragma unroll
        for (int ai = 0; ai < 2; ++ai)
#pragma unroll
            for (int m = 0; m < 4; ++m) { const int row = u.pm * BM + ai * HALF + wr * 64 + m * 16 + fr; const size_t off = (size_t)row * ldc + col0;
                float rs = 1.f; if (mode < 2) rs = row_rstd(ssq, row);
#pragma unroll
                for (int bj = 0; bj < 2; ++bj) { f32x4 v0 = acc[ai][bj][m][0] * rs, v1 = acc[ai][bj][m][1] * rs;
                    if (mode == 1) { v0 = (f32x4){sigmoidf_(v0[0]), sigmoidf_(v0[1]), sigmoidf_(v0[2]), sigmoidf_(v0[3])}; v1 = (f32x4){sigmoidf_(v1[0]), sigmoidf_(v1[1]), sigmoidf_(v1[2]), sigmoidf_(v1[3])}; }
                    if (mode >= 2) { const u32x4 g = *(const u32x4*)(g1 + off + bj * HALF);
                        v0 = v0 * (f32x4){bflo(g.x), bfhi(g.x), bflo(g.y), bfhi(g.y)}; v1 = v1 * (f32x4){bflo(g.z), bfhi(g.z), bflo(g.w), bfhi(g.w)};
                        if (mode == 3) { const u32x4 tt = *(const u32x4*)(t + off + bj * HALF);
                            v0 = v0 + (f32x4){bflo(tt.x), bfhi(tt.x), bflo(tt.y), bfhi(tt.y)}; v1 = v1 + (f32x4){bflo(tt.z), bfhi(tt.z), bflo(tt.w), bfhi(tt.w)}; } }
                    u32x4 w; w.x = pk2(v0[0], v0[1]); w.y = pk2(v0[2], v0[3]); w.z = pk2(v1[0], v1[1]); w.w = pk2(v1[2], v1[3]);
                    *(u32x4*)(O + off + bj * HALF) = w; } }
    }
};
struct EpiFfn {
    static constexpr bool PERM = true, AFTER_DRAIN = false;
    bf16_t* O; const float* ssq;
    __device__ __forceinline__ void operator()(const f32x4 (&acc)[2][2][4][2], const Unit& u, int wr, int wc, int fr, int fq) const {
        const int col0 = u.pn * HALF + wc * 32 + 8 * fq;
#pragma unroll
        for (int ai = 0; ai < 2; ++ai)
#pragma unroll
            for (int m = 0; m < 4; ++m) { const int row = u.pm * BM + ai * HALF + wr * 64 + m * 16 + fr; const float rs = row_rstd(ssq, row);
                const f32x4 g0 = acc[ai][0][m][0] * rs, g1 = acc[ai][0][m][1] * rs, u0 = acc[ai][1][m][0] * rs, u1 = acc[ai][1][m][1] * rs;
                u32x4 w; w.x = pk2(siluf_(g0[0]) * u0[0], siluf_(g0[1]) * u0[1]); w.y = pk2(siluf_(g0[2]) * u0[2], siluf_(g0[3]) * u0[3]);
                w.z = pk2(siluf_(g1[0]) * u1[0], siluf_(g1[1]) * u1[1]); w.w = pk2(siluf_(g1[2]) * u1[2], siluf_(g1[3]) * u1[3]);
                *(u32x4*)(O + (size_t)row * DFF + col0) = w; }
    }
};
struct EpiRes {
    static constexpr bool PERM = false, AFTER_DRAIN = false;
    const float* base; float* out; bf16_t* xb; float* ssq;
    __device__ __forceinline__ void operator()(const f32x4 (&acc)[2][2][4][2], const Unit& u, int wr, int wc, int fr, int fq) const {
        const int col0 = u.pn * BM + wc * 32 + 4 * fq;
#pragma unroll
        for (int ai = 0; ai < 2; ++ai)
#pragma unroll
            for (int m = 0; m < 4; ++m) { const int row = u.pm * BM + ai * HALF + wr * 64 + m * 16 + fr; const size_t off = (size_t)row * DM + col0; float s = 0.f;
#pragma unroll
                for (int bj = 0; bj < 2; ++bj)
#pragma unroll
                    for (int n = 0; n < 2; ++n) { const size_t o2 = off + bj * HALF + n * 16; const f32x4 v = *(const f32x4*)(base + o2) + acc[ai][bj][m][n];
                        *(f32x4*)(out + o2) = v; u32x2 w; w.x = pk2(v[0], v[1]); w.y = pk2(v[2], v[3]); *(u32x2*)(xb + o2) = w;
                        s += (v[0] * v[0] + v[1] * v[1]) + (v[2] * v[2] + v[3] * v[3]); }
                s += __shfl_xor(s, 16); s += __shfl_xor(s, 32);
                if (fq == 0) ssq[(size_t)row * 16 + u.pn * 4 + wc] = s; }
    }
};
__device__ __forceinline__ int map_row(int mode, int n) {
    if (mode == 1) return n >= 4112 ? n + 240 : n;
    if (mode == 2) { const int m = n < DFF ? n : n - DFF; return (m >> 7) * 256 + (n < DFF ? 0 : 128) + (m & 127); }
    return n;
}
__device__ __forceinline__ void tr_item(const float* W, int K, int N, bf16_t* WT, int mode, const float* g, LAS float* scr, int item, int lane) {
    const int nblk = (N + 63) / 64, kb = item / nblk, nb = item % nblk, k0 = 64 * kb, n0 = 64 * nb;
    const int nl = n0 + 4 * (lane & 15), kr = lane >> 4;
    f32x4 v[16];
#pragma unroll
    for (int i = 0; i < 16; ++i) { const int kk = 4 * i + kr; v[i] = (nl < N) ? *(const f32x4*)(W + (size_t)(k0 + kk) * N + nl) : (f32x4){0.f, 0.f, 0.f, 0.f}; }
#pragma unroll
    for (int i = 0; i < 16; ++i) { const int kk = 4 * i + kr; f32x4 x = v[i]; if (g) x = x * g[k0 + kk]; *(LAS f32x4*)(scr + kk * 68 + 4 * (lane & 15)) = x; }
    asm volatile("s_waitcnt lgkmcnt(0)" ::: "memory");
    const int c = lane & 7;
#pragma unroll
    for (int j = 0; j < 8; ++j) { const int nn = (lane >> 3) + 8 * j, n = n0 + nn;
        if (n < N) { float sc = 1.f; if (mode == 1 && n >= 4112 && n < 5136) sc = QB_SCALE; if (mode == 3) sc = QM_SCALE;
            const LAS float* s = scr + (8 * c) * 68 + nn;
            u32x4 o; o.x = pk2(s[0 * 68] * sc, s[1 * 68] * sc); o.y = pk2(s[2 * 68] * sc, s[3 * 68] * sc); o.z = pk2(s[4 * 68] * sc, s[5 * 68] * sc); o.w = pk2(s[6 * 68] * sc, s[7 * 68] * sc);
            *(u32x4*)(WT + (size_t)map_row(mode, n) * K + k0 + 8 * c) = o; } }
    asm volatile("s_waitcnt lgkmcnt(0)" ::: "memory");
}
struct Inputs { const float* p[21]; };
__device__ __forceinline__ void convert_phase(LAS unsigned char* lds, const Inputs& in, bf16_t* Wt, int l, int gw, int NGW, int wid, int lane) {
    LAS float* scr = (LAS float*)(lds + wid * 18432);
    constexpr int I_IN = 16 * 145, I_SQ = 16 * 16, I_MKV = 16 * 32, I_GU = 16 * 88, I_DN = 44 * 16;
    constexpr int NITEMS = I_IN + 5 * I_SQ + I_MKV + I_GU + I_DN;
    for (int it = gw; it < NITEMS; it += NGW) {
        int r = it;
        if (r < I_IN) { tr_item(as_global(in.p[3]) + (size_t)l * 1024 * NIN, 1024, NIN, Wt + WO_IN, 1, as_global(in.p[2]) + l * 1024, scr, r, lane); continue; } r -= I_IN;
        if (r < I_SQ) { tr_item(as_global(in.p[8]) + (size_t)l * 1048576, 1024, 1024, Wt + WO_A, 0, nullptr, scr, r, lane); continue; } r -= I_SQ;
        if (r < I_SQ) { tr_item(as_global(in.p[9]) + (size_t)l * 1048576, 1024, 1024, Wt + WO_B, 0, nullptr, scr, r, lane); continue; } r -= I_SQ;
        if (r < I_SQ) { tr_item(as_global(in.p[11]) + (size_t)l * 1048576, 1024, 1024, Wt + WO_O, 0, nullptr, scr, r, lane); continue; } r -= I_SQ;
        if (r < I_SQ) { tr_item(as_global(in.p[14]) + (size_t)l * 1048576, 1024, 1024, Wt + WO_MQ, 3, as_global(in.p[12]) + l * 1024, scr, r, lane); continue; } r -= I_SQ;
        if (r < I_SQ) { tr_item(as_global(in.p[16]) + (size_t)l * 1048576, 1024, 1024, Wt + WO_MO, 0, nullptr, scr, r, lane); continue; } r -= I_SQ;
        if (r < I_MKV) { tr_item(as_global(in.p[15]) + (size_t)l * 2097152, 1024, 2048, Wt + WO_MKV, 0, as_global(in.p[13]) + l * 1024, scr, r, lane); continue; } r -= I_MKV;
        if (r < I_GU) { tr_item(as_global(in.p[18]) + (size_t)l * 1024 * 2 * DFF, 1024, 2 * DFF, Wt + WO_GU, 2, as_global(in.p[17]) + l * 1024, scr, r, lane); continue; } r -= I_GU;
        tr_item(as_global(in.p[19]) + (size_t)l * DFF * 1024, DFF, 1024, Wt + WO_DN, 0, nullptr, scr, r, lane);
    }
    for (int i = gw * 64 + lane; i < 240 * 128; i += NGW * 64) *(u32x4*)(Wt + WO_IN + (size_t)4112 * 1024 + (size_t)i * 8) = (u32x4){0u, 0u, 0u, 0u};
}
__device__ __forceinline__ void rows_to_bf16(const float* x, bf16_t* xb, float* ssq, int nrows, int gw, int NGW, int lane) {
    for (int m = gw; m < nrows; m += NGW) {
        const f32x4* xr = (const f32x4*)(x + (size_t)m * DM) + lane; f32x4 v[4]; float s = 0.f;
#pragma unroll
        for (int j = 0; j < 4; ++j) { v[j] = xr[64 * j]; s += (v[j].x * v[j].x + v[j].y * v[j].y) + (v[j].z * v[j].z + v[j].w * v[j].w); }
        s = wave_sum(s);
        u32x2* o8 = (u32x2*)(xb + (size_t)m * DM) + lane;
#pragma unroll
        for (int j = 0; j < 4; ++j) { u32x2 w; w.x = pk2(v[j].x, v[j].y); w.y = pk2(v[j].z, v[j].w); o8[64 * j] = w; }
        if (lane < 16) ssq[(size_t)m * 16 + lane] = (lane == 0) ? s : 0.f;
    }
}
__device__ __forceinline__ void final_norm(float* out, const float* ssq, const float* g, int gw, int NGW, int lane) {
    for (int m = gw; m < MROWS; m += NGW) {
        const float rs = row_rstd(ssq, m); f32x4* xr = (f32x4*)(out + (size_t)m * DM) + lane; const f32x4* gr = (const f32x4*)g + lane;
#pragma unroll
        for (int j = 0; j < 4; ++j) xr[64 * j] = xr[64 * j] * rs * gr[64 * j];
    }
}
__device__ __forceinline__ void oa_norm(const bf16_t* o, bf16_t* za, const float* hn, int gw, int NGW, int lane) {
    for (int m = gw; m < MROWS; m += NGW) {
        const size_t off = (size_t)m * DM + lane * 16; const u32x4 a0 = *(const u32x4*)(o + off), a1 = *(const u32x4*)(o + off + 8); const u32x4 z0 = *(const u32x4*)(za + off), z1 = *(const u32x4*)(za + off + 8);
        float v[16] = {bflo(a0.x), bfhi(a0.x), bflo(a0.y), bfhi(a0.y), bflo(a0.z), bfhi(a0.z), bflo(a0.w), bfhi(a0.w), bflo(a1.x), bfhi(a1.x), bflo(a1.y), bfhi(a1.y), bflo(a1.z), bfhi(a1.z), bflo(a1.w), bfhi(a1.w)};
        float z[16] = {bflo(z0.x), bfhi(z0.x), bflo(z0.y), bfhi(z0.y), bflo(z0.z), bfhi(z0.z), bflo(z0.w), bfhi(z0.w), bflo(z1.x), bfhi(z1.x), bflo(z1.y), bfhi(z1.y), bflo(z1.z), bfhi(z1.z), bflo(z1.w), bfhi(z1.w)};
        float s = 0.f;
#pragma unroll
        for (int j = 0; j < 16; ++j) s += v[j] * v[j];
        s += __shfl_xor(s, 1); s += __shfl_xor(s, 2); s += __shfl_xor(s, 4);
        const float rs = rsqrtf(s * (1.f / 128.f) + EPS); const float* h = hn + (lane & 7) * 16;
#pragma unroll
        for (int j = 0; j < 16; ++j) v[j] = v[j] * rs * h[j] * z[j];
        u32x4 w0, w1; w0.x = pk2(v[0], v[1]); w0.y = pk2(v[2], v[3]); w0.z = pk2(v[4], v[5]); w0.w = pk2(v[6], v[7]); w1.x = pk2(v[8], v[9]); w1.y = pk2(v[10], v[11]); w1.z = pk2(v[12], v[13]); w1.w = pk2(v[14], v[15]);
        *(u32x4*)(za + off) = w0; *(u32x4*)(za + off + 8) = w1;
    }
}

#define MFMA16(a, b, c) __builtin_amdgcn_mfma_f32_16x16x32_bf16((a), (b), (c), 0, 0, 0)
#define MFMA32(a, b, c) __builtin_amdgcn_mfma_f32_32x32x16_bf16((a), (b), (c), 0, 0, 0)
constexpr int RP = 272, LP = 68;
constexpr int PR_QS = 0, PR_KS = 17408, PR_RHS = 34816, PR_LM = 104448, PR_G = 121856, PR_B = 122112, PR_CW = 122368, PR_DP = 128512;
#define LBAR() asm volatile("s_waitcnt lgkmcnt(0)\n\ts_barrier" ::: "memory")
__device__ __forceinline__ void prep_phase(LAS unsigned char* lds, bf16_t* R0, const float* ab, const bf16_t* halo, const float* convw, const float* a_log, const float* dt_bias,
                                           bf16_t* KT, bf16_t* PT, float* Eg, bf16_t* Oq, bf16_t* Ow, bf16_t* Ou, int tid, int wid, int lane) {
    LAS unsigned char* qs = lds + PR_QS; LAS unsigned char* ks = lds + PR_KS; LAS float* rhs = (LAS float*)(lds + PR_RHS); LAS float* Lm = (LAS float*)(lds + PR_LM);
    LAS float* Gs = (LAS float*)(lds + PR_G); LAS float* Bs = (LAS float*)(lds + PR_B); LAS float* cw = (LAS float*)(lds + PR_CW);
    int cw_head = -1;
    float pa, pb; { const int u0 = (int)blockIdx.x < BATCH * NCH * 8 ? (int)blockIdx.x : 0; pa = ab[(size_t)((u0 >> 3) * 64 + lane) * 16 + (u0 & 7)]; pb = ab[(size_t)((u0 >> 3) * 64 + lane) * 16 + 8 + (u0 & 7)]; }
#pragma unroll 1
    for (int unit = blockIdx.x; unit < BATCH * NCH * 8; unit += gridDim.x) {
        const int h = unit & 7, row0 = (unit >> 3) * 64, nchunk = (unit >> 3) & 31;
        const bool restaged = (h != cw_head);
        if (h != cw_head) {
            for (int i = tid; i < 4 * 3 * 128; i += 512) { const int tap = i / 384, rem = i % 384; cw[i] = convw[(size_t)tap * 3072 + (rem >> 7) * 1024 + h * 128 + (rem & 127)]; }
            cw_head = h;
        }
        {
            const float a = pa, bt = pb;
            { const int un = unit + (int)gridDim.x < BATCH * NCH * 8 ? unit + (int)gridDim.x : unit; pa = ab[(size_t)((un >> 3) * 64 + lane) * 16 + (un & 7)]; pb = ab[(size_t)((un >> 3) * 64 + lane) * 16 + 8 + (un & 7)]; }
            const float x = a + dt_bias[h]; const float sp = x > 20.f ? x : __logf(1.f + __expf(x)); float g = -__expf(a_log[h]) * sp;
#pragma unroll
            for (int o = 1; o < 64; o <<= 1) { const float y = __shfl_up(g, o); if (lane >= o) g += y; }
            Gs[lane] = g; Bs[lane] = 1.f / (1.f + __expf(-bt)); if (wid == 0 && lane == 63) Eg[unit] = __expf(g);
        }
        if (restaged) LBAR(); else asm volatile("s_waitcnt lgkmcnt(0)" ::: "memory");
        {
            const int t = tid >> 3, c0 = (tid & 7) * 16; const float beta = Bs[t], eg = __expf(Gs[t]);
#pragma unroll
            for (int mat = 0; mat < 3; ++mat) {
                const bf16_t* src = R0 + (size_t)mat * SLOTE; float acc[16];
#pragma unroll
                for (int j = 0; j < 16; ++j) acc[j] = 0.f;
#pragma unroll
                for (int i = 0; i < 4; ++i) { const int tt = t - 3 + i; u32x4 x0 = {0u, 0u, 0u, 0u}, x1 = {0u, 0u, 0u, 0u};
                    if (tt >= 0) { const bf16_t* p = src + (size_t)(row0 + tt) * DM + h * 128 + c0; x0 = *(const u32x4*)p; x1 = *(const u32x4*)(p + 8); }
                    else if (nchunk > 0) { const bf16_t* p = halo + (size_t)(((row0 >> 6) - 1) * 3 + (3 + tt)) * 3072 + mat * 1024 + h * 128 + c0; x0 = *(const u32x4*)p; x1 = *(const u32x4*)(p + 8); }
                    const LAS f32x4* wp = (const LAS f32x4*)(cw + i * 384 + mat * 128 + c0); const f32x4 w0 = wp[0], w1 = wp[1], w2 = wp[2], w3 = wp[3];
                    acc[0] += w0.x * bflo(x0.x); acc[1] += w0.y * bfhi(x0.x); acc[2] += w0.z * bflo(x0.y); acc[3] += w0.w * bfhi(x0.y);
                    acc[4] += w1.x * bflo(x0.z); acc[5] += w1.y * bfhi(x0.z); acc[6] += w1.z * bflo(x0.w); acc[7] += w1.w * bfhi(x0.w);
                    acc[8] += w2.x * bflo(x1.x); acc[9] += w2.y * bfhi(x1.x); acc[10] += w2.z * bflo(x1.y); acc[11] += w2.w * bfhi(x1.y);
                    acc[12] += w3.x * bflo(x1.z); acc[13] += w3.y * bfhi(x1.z); acc[14] += w3.z * bflo(x1.w); acc[15] += w3.w * bfhi(x1.w); }
                float ss = 0.f;
#pragma unroll
                for (int j = 0; j < 16; ++j) { acc[j] = siluf_(acc[j]); ss += acc[j] * acc[j]; }
                if (mat < 2) {
                    ss += __shfl_xor(ss, 1); ss += __shfl_xor(ss, 2); ss += __shfl_xor(ss, 4);
                    const float rn = rsqrtf(ss + EPS) * (mat == 0 ? 0.08838834764831845f : 1.f);
#pragma unroll
                    for (int j = 0; j < 16; ++j) acc[j] *= rn;
                    u32x4 w0, w1; w0.x = pk2(acc[0], acc[1]); w0.y = pk2(acc[2], acc[3]); w0.z = pk2(acc[4], acc[5]); w0.w = pk2(acc[6], acc[7]);
                    w1.x = pk2(acc[8], acc[9]); w1.y = pk2(acc[10], acc[11]); w1.z = pk2(acc[12], acc[13]); w1.w = pk2(acc[14], acc[15]);
                    LAS unsigned char* d = (mat == 0 ? qs : ks) + t * 272 + c0 * 2; *(LAS u32x4*)d = w0; *(LAS u32x4*)(d + 16) = w1;
                }
                if (mat >= 1) { const float sc = (mat == 1) ? beta * eg : beta; LAS float* d = rhs + t * RP + (mat == 1 ? 128 : 0) + c0;
#pragma unroll
                    for (int j4 = 0; j4 < 4; ++j4) *(LAS f32x4*)(d + 4 * j4) = (f32x4){acc[4 * j4] * sc, acc[4 * j4 + 1] * sc, acc[4 * j4 + 2] * sc, acc[4 * j4 + 3] * sc}; }
            }
        }
        LBAR();
        {
            const int mtx = wid >> 2, ti = wid & 3, r = lane & 15, quad = lane >> 4; const LAS unsigned char* Ab = mtx ? qs : ks;
#pragma unroll
            for (int tj = 0; tj < 4; ++tj) { f32x4 c = {0.f, 0.f, 0.f, 0.f};
                if (tj > ti) {
                    if (mtx == 1) {
#pragma unroll
                        for (int jj = 0; jj < 4; ++jj) PT[(size_t)unit * 4096 + (16 * ti + quad * 4 + jj) * 64 + 16 * tj + r] = (bf16_t)0; }
                    continue; }
#pragma unroll
                for (int s = 0; s < 4; ++s) { const bf16x8 a = *(const LAS bf16x8*)(Ab + (16 * ti + r) * 272 + (32 * s + quad * 8) * 2); const bf16x8 b = *(const LAS bf16x8*)(ks + (16 * tj + r) * 272 + (32 * s + quad * 8) * 2); c = MFMA16(a, b, c); }
#pragma unroll
                for (int jj = 0; jj < 4; ++jj) { const int t = 16 * ti + quad * 4 + jj, col = 16 * tj + r; const float dec = (col <= t) ? __expf(Gs[t] - Gs[col]) : 0.f;
                    if (mtx == 0) Lm[t * LP + col] = (col < t) ? -(Bs[t] * c[jj] * dec) : 0.f;
                    else PT[(size_t)unit * 4096 + t * 64 + col] = (bf16_t)(pk2(c[jj] * dec, 0.f) & 0xffffu); }
            }
            if (mtx == 0 && lane < 16) {
                float d[16]; const LAS float* Lb = Lm + (16 * ti) * LP + 16 * ti; LAS float* DP = (LAS float*)(lds + PR_DP) + ti * 256 + (lane & 3) * 64 + (lane >> 2) * 16;
                f32x4 rc[4], rn[4];
#pragma unroll
                for (int q = 0; q < 4; ++q) { rc[q] = *(const LAS f32x4*)(Lb + 1 * LP + 4 * q); rn[q] = rc[q]; }
                d[0] = (lane == 0) ? 1.f : 0.f; DP[0] = d[0];
#pragma unroll
                for (int rr = 1; rr < 16; ++rr) {
                    if (rr < 15) {
#pragma unroll
                        for (int q = 0; q < 4; ++q) if (4 * q < rr + 1) rn[q] = *(const LAS f32x4*)(Lb + (rr + 1) * LP + 4 * q); }
                    float a0 = (rr == lane) ? 1.f : 0.f, a1 = 0.f;
#pragma unroll
                    for (int k = 0; k < rr; ++k) { if (k & 1) a1 += rc[k >> 2][k & 3] * d[k]; else a0 += rc[k >> 2][k & 3] * d[k]; }
                    d[rr] = a0 + a1; DP[rr] = d[rr];
#pragma unroll
                    for (int q = 0; q < 4; ++q) rc[q] = rn[q];
                }
            }
        }
        LBAR();
        {
            const int r = lane & 15, quad = lane >> 4; const LAS float* DPb = (const LAS float*)(lds + PR_DP);
#pragma unroll 1
            for (int I = 0; I < 4; ++I) {
                f32x4 C0, C1; LAS float* x0 = rhs + (16 * I + 4 * quad) * RP + wid * 32 + r; LAS float* x1 = x0 + 16;
#pragma unroll
                for (int jj = 0; jj < 4; ++jj) { C0[jj] = x0[jj * RP]; C1[jj] = x1[jj * RP]; }
#pragma unroll 2
                for (int j0 = 0; j0 < 16 * I; j0 += 4) { const float a = Lm[(16 * I + r) * LP + j0 + quad]; const LAS float* bp = rhs + (j0 + quad) * RP + wid * 32 + r;
                    C0 = __builtin_amdgcn_mfma_f32_16x16x4f32(a, bp[0], C0, 0, 0, 0); C1 = __builtin_amdgcn_mfma_f32_16x16x4f32(a, bp[16], C1, 0, 0, 0); }
                f32x4 X0 = {0.f, 0.f, 0.f, 0.f}, X1 = {0.f, 0.f, 0.f, 0.f};
#pragma unroll
                for (int sx = 0; sx < 4; ++sx) { const float a = DPb[I * 256 + sx * 64 + quad * 16 + r];
                    X0 = __builtin_amdgcn_mfma_f32_16x16x4f32(a, C0[sx], X0, 0, 0, 0); X1 = __builtin_amdgcn_mfma_f32_16x16x4f32(a, C1[sx], X1, 0, 0, 0); }
#pragma unroll
                for (int jj = 0; jj < 4; ++jj) { x0[jj * RP] = X0[jj]; x1[jj * RP] = X1[jj]; }
            }
        }
        {
#pragma unroll
            for (int k = 0; k < 2; ++k) { const int p = tid + 512 * k, t = p >> 4, c8 = (p & 15) * 8; const u32x4 v = *(const LAS u32x4*)(qs + t * 272 + c8 * 2); const float eg = __expf(Gs[t]);
                u32x4 w; w.x = pk2(bflo(v.x) * eg, bfhi(v.x) * eg); w.y = pk2(bflo(v.y) * eg, bfhi(v.y) * eg); w.z = pk2(bflo(v.z) * eg, bfhi(v.z) * eg); w.w = pk2(bflo(v.w) * eg, bfhi(v.w) * eg);
                *(u32x4*)(Oq + (size_t)(row0 + t) * DM + h * 128 + c8) = w; }
            const int dk = tid & 127, qtr = tid >> 7; const float g63 = Gs[63];
#pragma unroll
            for (int tg = 0; tg < 2; ++tg) { float v[8];
#pragma unroll
                for (int i = 0; i < 8; ++i) { const int t = 16 * qtr + 8 * tg + i; v[i] = bf2f(*(const LAS unsigned short*)(ks + t * 272 + dk * 2)) * __expf(g63 - Gs[t]); }
                u32x4 w; w.x = pk2(v[0], v[1]); w.y = pk2(v[2], v[3]); w.z = pk2(v[4], v[5]); w.w = pk2(v[6], v[7]);
                *(u32x4*)(KT + (size_t)unit * 8192 + dk * 64 + 16 * qtr + 8 * tg) = w; }
        }
        LBAR();
#pragma unroll
        for (int k = 0; k < 4; ++k) { const int p = tid + 512 * k, t = p >> 5, c8 = (p & 31) * 8; const f32x4 v0 = *(const LAS f32x4*)(rhs + t * RP + c8), v1 = *(const LAS f32x4*)(rhs + t * RP + c8 + 4);
            const float sg = (c8 < 128) ? 1.f : -1.f; u32x4 w; w.x = pk2(v0.x * sg, v0.y * sg); w.y = pk2(v0.z * sg, v0.w * sg); w.z = pk2(v1.x * sg, v1.y * sg); w.w = pk2(v1.z * sg, v1.w * sg);
            bf16_t* dst = (c8 < 128) ? (Ou + (size_t)(row0 + t) * DM + h * 128 + c8) : (Ow + (size_t)(row0 + t) * DM + h * 128 + (c8 - 128));
            *(u32x4*)dst = w; }
        LBAR();
    }
}
constexpr int SC_W = 0, SC_Q = 17408, SC_P = 34816, SC_K = 44032, SC_U = 62464, SC_BUF = 66560;
__device__ __forceinline__ bf16x8 afrag(const LAS unsigned char* p) { const u32x2 lo = *(const LAS u32x2*)p; const u32x2 hi = *(const LAS u32x2*)(p + 32); const u32x4 v = {lo.x, lo.y, hi.x, hi.y}; return __builtin_bit_cast(bf16x8, v); }
__device__ __forceinline__ bf16x8 packB(const f32x4 a, const f32x4 b) { const u32x4 v = {pk2(a.x, a.y), pk2(a.z, a.w), pk2(b.x, b.y), pk2(b.z, b.w)}; return __builtin_bit_cast(bf16x8, v); }
__device__ __forceinline__ void scan_phase(LAS unsigned char* lds, bf16_t* R0, const bf16_t* KT, const bf16_t* PT, const float* Eg, bf16_t* Odst, int tid, int wid, int lane) {
    const int r = lane & 15, quad = lane >> 4;
    const int vcu = (gridDim.x % 8 == 0) ? (int)((blockIdx.x & 7) * (gridDim.x >> 3) + (blockIdx.x >> 3)) : (int)blockIdx.x;
    for (int task = vcu; task < 256; task += gridDim.x) {
        const int bh = task >> 2, dvq = task & 3, b = bh >> 3, h = bh & 7, dv16 = dvq * 32 + (wid & 1) * 16;
        const bf16_t* Wsrc = R0 + SLOTE; const bf16_t* Qsrc = R0; const bf16_t* Usrc = R0 + 2 * SLOTE;
        if (wid < 2) {
            f32x4 S[8];
#pragma unroll
            for (int d = 0; d < 8; ++d) S[d] = (f32x4){0.f, 0.f, 0.f, 0.f};
            float en = Eg[(size_t)((b * NCH + 0) * 8 + h)];
            __syncthreads();
#pragma unroll 1
            for (int n = 0; n < NCH; ++n) {
                f32x4 U[4], O[4]; const float ec = en; int rq = quad * 4 * DM + h * 128 + dv16 + r; asm volatile("" : "+v"(rq));
                const LAS unsigned char* B_ = lds + (n & 1) * SC_BUF; const int row0 = (b * NCH + n) * 64;
#pragma unroll
                for (int m = 0; m < 4; ++m) { const LAS unsigned short* up = (const LAS unsigned short*)(B_ + SC_U + (16 * m + quad * 4) * 64 + ((wid & 1) * 16 + r) * 2);
                    U[m] = (f32x4){bf2f(up[0]), bf2f(up[32]), bf2f(up[64]), bf2f(up[96])}; }
                if (n + 1 < NCH) en = Eg[(size_t)((b * NCH + n + 1) * 8 + h)];
                bf16x8 Sb[4];
#pragma unroll
                for (int s = 0; s < 4; ++s) Sb[s] = packB(S[2 * s], S[2 * s + 1]);
#pragma unroll
                for (int m = 0; m < 4; ++m) O[m] = (f32x4){0.f, 0.f, 0.f, 0.f};
#define SBAR_ __builtin_amdgcn_sched_barrier(0)
#define LM(m, fw, fq) do { _Pragma("unroll") for (int s = 0; s < 4; ++s) { fw[s] = afrag(B_ + SC_W + (16 * (m) + r) * 272 + (32 * s + quad * 4) * 2); fq[s] = afrag(B_ + SC_Q + (16 * (m) + r) * 272 + (32 * s + quad * 4) * 2); } } while (0)
#define MM(m, fw, fq) do { _Pragma("unroll") for (int s = 0; s < 4; ++s) { U[m] = MFMA16(fw[s], Sb[s], U[m]); O[m] = MFMA16(fq[s], Sb[s], O[m]); } } while (0)
                bf16x8 fwa[4], fqa[4], fwb[4], fqb[4], fp[8], fk[8];
                LM(0, fwa, fqa);
                LM(1, fwb, fqb); SBAR_; MM(0, fwa, fqa); SBAR_;
                LM(2, fwa, fqa); SBAR_; MM(1, fwb, fqb); SBAR_;
                LM(3, fwb, fqb); SBAR_; MM(2, fwa, fqa); SBAR_;
#pragma unroll
                for (int m = 0; m < 4; ++m)
#pragma unroll
                    for (int s = 0; s < 2; ++s) fp[m * 2 + s] = afrag(B_ + SC_P + (16 * m + r) * 144 + (32 * s + quad * 4) * 2);
                SBAR_; MM(3, fwb, fqb); SBAR_;
                bf16x8 Ub[2]; Ub[0] = packB(U[0], U[1]); Ub[1] = packB(U[2], U[3]);
#pragma unroll
                for (int d = 0; d < 4; ++d)
#pragma unroll
                    for (int s = 0; s < 2; ++s) fk[d * 2 + s] = afrag(B_ + SC_K + (16 * d + r) * 144 + (32 * s + quad * 4) * 2);
                SBAR_;
#pragma unroll
                for (int m = 0; m < 4; ++m)
#pragma unroll
                    for (int s = 0; s < 2; ++s) O[m] = MFMA16(fp[m * 2 + s], Ub[s], O[m]);
                SBAR_;
#pragma unroll
                for (int d = 0; d < 4; ++d)
#pragma unroll
                    for (int s = 0; s < 2; ++s) fp[d * 2 + s] = afrag(B_ + SC_K + (16 * (d + 4) + r) * 144 + (32 * s + quad * 4) * 2);
                SBAR_;
#pragma unroll
                for (int d = 0; d < 4; ++d) { S[d] = S[d] * ec;
#pragma unroll
                    for (int s = 0; s < 2; ++s) S[d] = MFMA16(fk[d * 2 + s], Ub[s], S[d]); }
                SBAR_;
#pragma unroll
                for (int d = 0; d < 4; ++d) { S[d + 4] = S[d + 4] * ec;
#pragma unroll
                    for (int s = 0; s < 2; ++s) S[d + 4] = MFMA16(fp[d * 2 + s], Ub[s], S[d + 4]); }
#undef LM
#undef MM
#undef SBAR_
#pragma unroll
                for (int m = 0; m < 4; ++m)
#pragma unroll
                    for (int jj = 0; jj < 4; ++jj) Odst[(size_t)(row0 + 16 * m + jj) * DM + rq] = (bf16_t)(pk2(O[m][jj], 0.f) & 0xffffu);
                __syncthreads();
            }
        } else {
            const int lt = tid - 128;
            u32x4 pfa[10], pfb[10];
#define SC_LOAD(n, pf) do { const int row0_ = (b * NCH + (n)) * 64; const size_t unit_ = (size_t)((b * NCH + (n)) * 8 + h); \
                int lt_ = lt; asm volatile("" : "+v"(lt_)); _Pragma("unroll") for (int k = 0; k < 10; ++k) { const int p = lt_ + 384 * k; const bf16_t* src; \
                    if (p < 2048) { const int q = p & 1023; src = (p < 1024 ? Wsrc : Qsrc) + (size_t)(row0_ + (q >> 4)) * DM + h * 128 + (q & 15) * 8; } \
                    else if (p < 2560) src = PT + unit_ * 4096 + (size_t)(p - 2048) * 8; \
                    else if (p < 3584) src = KT + unit_ * 8192 + (size_t)(p - 2560) * 8; \
                    else { const int q = p - 3584; src = Usrc + (size_t)(row0_ + (q >> 2)) * DM + h * 128 + dvq * 32 + (q & 3) * 8; } \
                    pf[k] = *(const u32x4*)src; } } while (0)
#define SC_STORE(buf, pf) do { LAS unsigned char* B_ = lds + (buf) * SC_BUF; \
                int lt_ = lt; asm volatile("" : "+v"(lt_)); _Pragma("unroll") for (int k = 0; k < 10; ++k) { const int p = lt_ + 384 * k; int off; \
                    if (p < 2048) { const int q = p & 1023; off = (p < 1024 ? SC_W : SC_Q) + (q >> 4) * 272 + (q & 15) * 16; } \
                    else if (p < 2560) { const int q = p - 2048; off = SC_P + (q >> 3) * 144 + (q & 7) * 16; } \
                    else if (p < 3584) { const int q = p - 2560; off = SC_K + (q >> 3) * 144 + (q & 7) * 16; } \
                    else { const int q = p - 3584; off = SC_U + (q >> 2) * 64 + (q & 3) * 16; } \
                    *(LAS u32x4*)(B_ + off) = pf[k]; } } while (0)
            SC_LOAD(0, pfa); SC_STORE(0, pfa); SC_LOAD(1, pfb);
            __syncthreads();
#pragma unroll 1
            for (int n = 0; n < NCH; n += 2) {
                if (n + 2 < NCH) SC_LOAD(n + 2, pfa);
                SC_STORE(1, pfb);
                __syncthreads();
                if (n + 3 < NCH) SC_LOAD(n + 3, pfb);
                if (n + 2 < NCH) SC_STORE(0, pfa);
                __syncthreads();
            }
#undef SC_LOAD
#undef SC_STORE
        }
    }
}

__device__ __forceinline__ int crow(int reg, int h) { return (reg & 3) + 8 * (reg >> 2) + 4 * h; }
__device__ __forceinline__ bf16x8 pack8(const f32x16& p, int s) { const u32x4 v = {pk2(p[8 * s], p[8 * s + 1]), pk2(p[8 * s + 2], p[8 * s + 3]), pk2(p[8 * s + 4], p[8 * s + 5]), pk2(p[8 * s + 6], p[8 * s + 7])}; return __builtin_bit_cast(bf16x8, v); }
__device__ __forceinline__ bf16x8 vfrag(const LAS unsigned char* p) { const u32x2 lo = *(const LAS u32x2*)p; const u32x2 hi = *(const LAS u32x2*)(p + 16); const u32x4 v = {lo.x, lo.y, hi.x, hi.y}; return __builtin_bit_cast(bf16x8, v); }
constexpr int BA_K = 0, BA_V = 18432, BA_T = 36864;
__device__ __forceinline__ void band_phase(LAS unsigned char* lds, const bf16_t* Qb, const bf16_t* Kb, const bf16_t* Vb, bf16_t* Ob, const float* rel_bias, int tid, int wid, int lane) {
    const int r = lane & 31, h5 = lane >> 5; LAS float* btab = (LAS float*)(lds + BA_T);
    const int vcu = (gridDim.x % 8 == 0) ? (int)((blockIdx.x & 7) * (gridDim.x >> 3) + (blockIdx.x >> 3)) : (int)blockIdx.x;
    for (int uu = vcu * 4; uu < 1024; uu += gridDim.x * 4)
    for (int ui = 0; ui < 4; ++ui) {
        const int bhh = uu >> 3, b = bhh >> 4, h = bhh & 15, odd = (uu >> 2) & 1; const int qblk = odd ? ((ui == 0) ? 1 : (ui == 1) ? 2 : (ui == 2) ? 5 : 6) : ((ui == 0) ? 0 : (ui == 1) ? 3 : (ui == 2) ? 4 : 7);
        const int rowb = b * SEQ, c_first = (4 * qblk - 8) > 0 ? (4 * qblk - 8) : 0, ntile = 4 * qblk + 4 - c_first;
        const int nq = 4 * qblk + (wid >> 1), qi = 32 * (wid & 1) + r; const int q0 = rowb + 256 * qblk + 32 * wid;
        if (tid < 384) { int rel = 319 - tid; rel = rel < -63 ? -63 : (rel > 256 ? 256 : rel); btab[tid] = rel_bias[h * 320 + rel + 63] * LOG2E; }
        bf16x8 qf[4];
#pragma unroll
        for (int d0 = 0; d0 < 4; ++d0) qf[d0] = *(const bf16x8*)(Qb + (size_t)(q0 + r) * DM + h * 64 + 16 * d0 + 8 * h5);
        u32x4 kreg, vreg; const int skey = tid >> 3, sc8 = tid & 7;
#define BA_LOAD(c) do { const size_t o_ = (size_t)(rowb + 64 * (c) + skey) * DM + h * 64 + sc8 * 8; kreg = *(const u32x4*)(Kb + o_); vreg = *(const u32x4*)(Vb + o_); } while (0)
#define BA_STORE(buf) do { *(LAS u32x4*)(lds + BA_K + (buf) * 9216 + skey * 144 + sc8 * 16) = kreg; LAS unsigned char* v_ = lds + BA_V + (buf) * 9216 + (sc8 * 8) * 136 + skey * 2; \
            *(LAS unsigned short*)(v_) = (unsigned short)kregv(vreg.x, 0); *(LAS unsigned short*)(v_ + 136) = (unsigned short)kregv(vreg.x, 1); *(LAS unsigned short*)(v_ + 272) = (unsigned short)kregv(vreg.y, 0); *(LAS unsigned short*)(v_ + 408) = (unsigned short)kregv(vreg.y, 1); \
            *(LAS unsigned short*)(v_ + 544) = (unsigned short)kregv(vreg.z, 0); *(LAS unsigned short*)(v_ + 680) = (unsigned short)kregv(vreg.z, 1); *(LAS unsigned short*)(v_ + 816) = (unsigned short)kregv(vreg.w, 0); *(LAS unsigned short*)(v_ + 952) = (unsigned short)kregv(vreg.w, 1); } while (0)
#define kregv(w, hi) ((hi) ? ((w) >> 16) : ((w) & 0xffffu))
        BA_LOAD(c_first); BA_STORE(0);
        float m_run = -1e30f, l_run = 0.f; f32x16 O[2];
#pragma unroll
        for (int i = 0; i < 16; ++i) { O[0][i] = 0.f; O[1][i] = 0.f; }
        __syncthreads();
        for (int ti = 0; ti < ntile; ++ti) {
            const int c = c_first + ti;
            if (ti + 1 < ntile) BA_LOAD(c + 1);
            if (c >= nq - 8 && c <= nq) {
                const LAS unsigned char* Kt = lds + BA_K + (ti & 1) * 9216; const LAS unsigned char* Vt = lds + BA_V + (ti & 1) * 9216;
                f32x16 P0, P1;
#pragma unroll
                for (int i = 0; i < 16; ++i) { P0[i] = 0.f; P1[i] = 0.f; }
#pragma unroll
                for (int d0 = 0; d0 < 4; ++d0) { const bf16x8 a0 = *(const LAS bf16x8*)(Kt + r * 144 + (16 * d0 + 8 * h5) * 2); const bf16x8 a1 = *(const LAS bf16x8*)(Kt + (32 + r) * 144 + (16 * d0 + 8 * h5) * 2);
                    P0 = MFMA32(a0, qf[d0], P0); P1 = MFMA32(a1, qf[d0], P1); }
                const int dch = nq - c;
                if (dch >= 5) { const float bc = btab[0];
#pragma unroll
                    for (int i = 0; i < 16; ++i) { P0[i] += bc; P1[i] += bc; } }
                else {
                    const LAS float* bp = btab + (319 - dch * 64 - qi + 4 * h5);
#pragma unroll
                    for (int i = 0; i < 16; ++i) { P0[i] += bp[(i & 3) + 8 * (i >> 2)]; P1[i] += bp[(i & 3) + 8 * (i >> 2) + 32]; } }
                float mx = P0[0];
#pragma unroll
                for (int i = 0; i < 16; ++i) { mx = fmaxf(mx, P0[i]); mx = fmaxf(mx, P1[i]); }
                mx = fmaxf(mx, __shfl_xor(mx, 32));
                const float m_new = fmaxf(m_run, mx), alpha = __builtin_amdgcn_exp2f(m_run - m_new); m_run = m_new;
                float ls = 0.f;
#pragma unroll
                for (int i = 0; i < 16; ++i) { P0[i] = __builtin_amdgcn_exp2f(P0[i] - m_new); P1[i] = __builtin_amdgcn_exp2f(P1[i] - m_new); ls += P0[i] + P1[i]; }
                l_run = l_run * alpha + ls;
#pragma unroll
                for (int i = 0; i < 16; ++i) { O[0][i] *= alpha; O[1][i] *= alpha; }
#pragma unroll
                for (int p = 0; p < 2; ++p)
#pragma unroll
                    for (int s = 0; s < 2; ++s) { const bf16x8 pb = pack8(p ? P1 : P0, s);
#pragma unroll
                        for (int dt = 0; dt < 2; ++dt) O[dt] = MFMA32(vfrag(Vt + (32 * dt + r) * 136 + (32 * p + 16 * s + 4 * h5) * 2), pb, O[dt]); }
            }
            if (ti + 1 < ntile) BA_STORE((ti + 1) & 1);
            __syncthreads();
        }
        l_run += __shfl_xor(l_run, 32); const float inv = 1.f / l_run;
#pragma unroll
        for (int dt = 0; dt < 2; ++dt)
#pragma unroll
            for (int g = 0; g < 4; ++g) { u32x2 w; w.x = pk2(O[dt][4 * g] * inv, O[dt][4 * g + 1] * inv); w.y = pk2(O[dt][4 * g + 2] * inv, O[dt][4 * g + 3] * inv);
                *(u32x2*)(Ob + (size_t)(q0 + r) * DM + h * 64 + 32 * dt + 8 * g + 4 * h5) = w; }
#undef BA_LOAD
#undef BA_STORE
#undef kregv
    }
}

__device__ __forceinline__ void xattn_phase(LAS unsigned char* lds, const bf16_t* Qm, const bf16_t* KV, bf16_t* Om, int tid, int wid, int lane) {
    const int r = lane & 31, h5 = lane >> 5;
    const int vcu = (gridDim.x % 8 == 0) ? (int)((blockIdx.x & 7) * (gridDim.x >> 3) + (blockIdx.x >> 3)) : (int)blockIdx.x;
#define SBAR_ __builtin_amdgcn_sched_barrier(0)
    for (int unit = vcu; unit < 256; unit += gridDim.x) {
        const int b = unit >> 5, mh = (unit >> 3) & 3, qblk = unit & 7; const int q0 = b * SEQ + qblk * 256 + 32 * wid;
        const bf16_t* Kg = KV + (size_t)(b * 256) * 2048 + mh * 256; const bf16_t* Vg = Kg + 1024;
#pragma unroll 1
        for (int kb = 0; kb < 16; kb += 8) { u32x4 kst[8];
#pragma unroll
          for (int k = 0; k < 8; ++k) { const int p = tid + 512 * (kb + k), key = p >> 5, c = p & 31; kst[k] = *(const u32x4*)(Kg + (size_t)key * 2048 + c * 8); }
#pragma unroll
          for (int k = 0; k < 8; ++k) { const int p = tid + 512 * (kb + k), key = p >> 5, c = p & 31; *(LAS u32x4*)(lds + key * 528 + c * 16) = kst[k]; } }
        const bf16_t* qp = Qm + (size_t)(q0 + r) * DM + mh * 256 + 8 * h5;
        bf16x8 qa = *(const bf16x8*)(qp), qb = *(const bf16x8*)(qp + 16);
        __syncthreads();
        f32x16 Sx[8];
#pragma unroll
        for (int kt = 0; kt < 8; ++kt)
#pragma unroll
            for (int i = 0; i < 16; ++i) Sx[kt][i] = 0.f;
#define LK(d0, hf, kf) do { _Pragma("unroll") for (int kt = 0; kt < 4; ++kt) kf[kt] = *(const LAS bf16x8*)(lds + (32 * ((hf) * 4 + kt) + r) * 528 + (16 * (d0) + 8 * h5) * 2); } while (0)
#define MK(kf, hf, q) do { _Pragma("unroll") for (int kt = 0; kt < 4; ++kt) Sx[(hf) * 4 + kt] = MFMA32(kf[kt], q, Sx[(hf) * 4 + kt]); } while (0)
        bf16x8 kfa[4], kfb[4];
        LK(0, 0, kfa);
#pragma unroll 1
        for (int d0 = 0; d0 < 16; d0 += 2) {
            LK(d0, 1, kfb); SBAR_; MK(kfa, 0, qa); SBAR_;
            LK(d0 + 1, 0, kfa); SBAR_; MK(kfb, 1, qa); SBAR_;
            if (d0 + 2 < 16) qa = *(const bf16x8*)(qp + 16 * (d0 + 2));
            LK(d0 + 1, 1, kfb); SBAR_; MK(kfa, 0, qb); SBAR_;
            if (d0 + 2 < 16) LK(d0 + 2, 0, kfa);
            SBAR_; MK(kfb, 1, qb); SBAR_;
            if (d0 + 3 < 16) qb = *(const bf16x8*)(qp + 16 * (d0 + 3));
        }
#undef LK
#undef MK
        float mx = Sx[0][0];
#pragma unroll
        for (int kt = 0; kt < 8; ++kt)
#pragma unroll
            for (int i = 0; i < 16; ++i) mx = fmaxf(mx, Sx[kt][i]);
        mx = fmaxf(mx, __shfl_xor(mx, 32));
        float ls = 0.f;
#pragma unroll
        for (int kt = 0; kt < 8; ++kt)
#pragma unroll
            for (int i = 0; i < 16; ++i) { Sx[kt][i] = __builtin_amdgcn_exp2f(Sx[kt][i] - mx); ls += Sx[kt][i]; }
        ls += __shfl_xor(ls, 32); const float inv = 1.f / ls;
        bf16x8 Pb[16];
#pragma unroll
        for (int kt = 0; kt < 8; ++kt) { Pb[2 * kt] = pack8(Sx[kt], 0); Pb[2 * kt + 1] = pack8(Sx[kt], 1); }
        __syncthreads();
        {
            const int kh = wid & 1, cg4 = wid >> 1, k0 = 128 * kh + 2 * lane;
#pragma unroll 1
            for (int ib = 0; ib < 8; ib += 4) { u32x4 vsa[4], vsb[4];
#pragma unroll
              for (int i = 0; i < 4; ++i) { const int c = cg4 + 4 * (ib + i); vsa[i] = *(const u32x4*)(Vg + (size_t)k0 * 2048 + c * 8); vsb[i] = *(const u32x4*)(Vg + (size_t)(k0 + 1) * 2048 + c * 8); }
#pragma unroll
              for (int i = 0; i < 4; ++i) { const int c = cg4 + 4 * (ib + i); const u32x4 va = vsa[i], vb = vsb[i];
                LAS unsigned char* d = lds + (c * 8) * 536 + k0 * 2;
                *(LAS unsigned*)(d) = (va.x & 0xffffu) | (vb.x << 16); *(LAS unsigned*)(d + 536) = (va.x >> 16) | (vb.x & 0xffff0000u);
                *(LAS unsigned*)(d + 1072) = (va.y & 0xffffu) | (vb.y << 16); *(LAS unsigned*)(d + 1608) = (va.y >> 16) | (vb.y & 0xffff0000u);
                *(LAS unsigned*)(d + 2144) = (va.z & 0xffffu) | (vb.z << 16); *(LAS unsigned*)(d + 2680) = (va.z >> 16) | (vb.z & 0xffff0000u);
                *(LAS unsigned*)(d + 3216) = (va.w & 0xffffu) | (vb.w << 16); *(LAS unsigned*)(d + 3752) = (va.w >> 16) | (vb.w & 0xffff0000u); } }
        }
        __syncthreads();
#define LV(dt, k8, vf) do { _Pragma("unroll") for (int ks = 0; ks < 8; ++ks) vf[ks] = vfrag(lds + (32 * (dt) + r) * 536 + (16 * ((k8) * 8 + ks) + 4 * h5) * 2); } while (0)
        bf16x8 vfa[8], vfb[8];
        LV(0, 0, vfa);
#pragma unroll 1
        for (int dt = 0; dt < 8; ++dt) {
            f32x16 Oa;
#pragma unroll
            for (int i = 0; i < 16; ++i) Oa[i] = 0.f;
            LV(dt, 1, vfb); SBAR_;
#pragma unroll
            for (int ks = 0; ks < 8; ++ks) Oa = MFMA32(vfa[ks], Pb[ks], Oa);
            SBAR_;
            if (dt + 1 < 8) LV(dt + 1, 0, vfa);
            SBAR_;
#pragma unroll
            for (int ks = 0; ks < 8; ++ks) Oa = MFMA32(vfb[ks], Pb[8 + ks], Oa);
            SBAR_;
#pragma unroll
            for (int g = 0; g < 4; ++g) { u32x2 w; w.x = pk2(Oa[4 * g] * inv, Oa[4 * g + 1] * inv); w.y = pk2(Oa[4 * g + 2] * inv, Oa[4 * g + 3] * inv);
                *(u32x2*)(Om + (size_t)(q0 + r) * DM + mh * 256 + 32 * dt + 8 * g + 4 * h5) = w; }
        }
#undef LV
        __syncthreads();
    }
#undef SBAR_
}
#define XB_TMO      128
#define XB_XCNT(j)  (256  + 64 * (j))
#define XB_XSUB(j)  (1280 + 64 * (j))
#define XB_XGEN(j)  (2304 + 64 * (j))
#define XB_TOP      3328
#define XB_TOPGEN   3392
#define XCD_BAR_WORDS 3456
#define XB_SPIN_CAP (1u << 18)

__device__ __forceinline__ unsigned xb_ld(unsigned* p)              { return __hip_atomic_load(p, __ATOMIC_RELAXED, __HIP_MEMORY_SCOPE_AGENT); }
__device__ __forceinline__ unsigned xb_add(unsigned* p, unsigned v) { return __hip_atomic_fetch_add(p, v, __ATOMIC_RELAXED, __HIP_MEMORY_SCOPE_AGENT); }
__device__ __forceinline__ unsigned xb_xcc_id() { return (unsigned)__builtin_amdgcn_s_getreg((3 << 11) | 20) & 0xFu; }
#define XB_SPIN(cond, bar) do { unsigned _sp = 0; while (cond) { __builtin_amdgcn_s_sleep(1); \
    if ((++_sp & 255u) == 0u) { if (xb_ld(&(bar)[XB_TMO])) break; if (_sp > XB_SPIN_CAP) { atomicAdd(&(bar)[XB_TMO], 1u); break; } } } } while (0)

struct XcdBarrier {
    unsigned* bar; unsigned x;
    volatile LAS unsigned* st;
};

__device__ __forceinline__ XcdBarrier xcd_barrier_post(unsigned* bar, volatile LAS unsigned* st) {
    XcdBarrier b; b.bar = bar; b.x = xb_xcc_id(); b.st = st;
    if (threadIdx.x == 0) (void)xb_add(&bar[XB_XCNT(b.x)], 1u);
    return b;
}
__device__ __forceinline__ void xcd_barrier_complete(unsigned* bar, unsigned x, unsigned& nloc, unsigned& nx) {
    const unsigned G = gridDim.x * gridDim.y * gridDim.z;
    unsigned sum, cnt, mine, sp = 0u;
    for (;;) {
        sum = 0u; cnt = 0u; mine = 0u;
#pragma unroll
        for (unsigned j = 0; j < 16; ++j) { const unsigned c = xb_ld(&bar[XB_XCNT(j)]); sum += c; cnt += (c > 0u) ? 1u : 0u; mine = (j == x) ? c : mine; }
        if (sum == G) break;
        __builtin_amdgcn_s_sleep(1);
        if ((++sp & 255u) == 0u) { if (xb_ld(&bar[XB_TMO])) break; if (sp > XB_SPIN_CAP) { atomicAdd(&bar[XB_TMO], 1u); break; } }
    }
    nloc = mine > 0u ? mine : 1u; nx = cnt > 0u ? cnt : 1u;
}

__device__ __forceinline__ void xcd_barrier(const XcdBarrier& b) {
    asm volatile("s_waitcnt vmcnt(0)" ::: "memory");
    __syncthreads();
    if (threadIdx.x == 0) {
        unsigned* bar = b.bar;
        __builtin_amdgcn_s_waitcnt(0);
        unsigned nloc = b.st[0], nx = b.st[1];
        if (nloc == 0u) { xcd_barrier_complete(bar, b.x, nloc, nx); b.st[0] = nloc; b.st[1] = nx; }
        const unsigned old = xb_add(&bar[XB_XSUB(b.x)], 1u);
        const unsigned gen = old / nloc;
        if (old + 1u == (gen + 1u) * nloc) {
            __builtin_amdgcn_fence(__ATOMIC_RELEASE, "agent");
            asm volatile("s_waitcnt vmcnt(0)" ::: "memory");
            const unsigned og = xb_add(&bar[XB_TOP], 1u);
            const unsigned tg = og / nx;
            if (og + 1u == (tg + 1u) * nx) xb_add(&bar[XB_TOPGEN], 1u);
            else XB_SPIN(xb_ld(&bar[XB_TOPGEN]) == tg, bar);
            __builtin_amdgcn_fence(__ATOMIC_ACQUIRE, "agent");
            xb_add(&bar[XB_XGEN(b.x)], 1u);
            asm volatile("s_waitcnt vmcnt(0)" ::: "memory");
        } else {
            XB_SPIN(xb_ld(&bar[XB_XGEN(b.x)]) == gen, bar);
            __builtin_amdgcn_fence(__ATOMIC_ACQUIRE, "agent");
            asm volatile("s_waitcnt vmcnt(0)" ::: "memory");
        }
    }
    __syncthreads();
}
#ifndef PROBE_DUP_MASK
#define PROBE_DUP_MASK 0
#endif
#ifndef PROBE_EXTRA_SYNC
#define PROBE_EXTRA_SYNC 0
#endif
struct Args { Inputs in; float* out; unsigned char* ws; };
enum { PH_IN_A = 0, PH_MEMKV, PH_PREP, PH_SCAN, PH_IN_B, PH_BAND, PH_GA, PH_T, PH_GB, PH_Y, PH_WO, PH_QM, PH_XATTN, PH_WMO, PH_FFN, PH_DOWN, PH_CONV, PH_COUNT };
__global__ void __launch_bounds__(512, 2) fwd_megakernel(Args args) {
    extern __shared__ __attribute__((aligned(16))) unsigned char lds_raw[];
    cg::grid_group grid = cg::this_grid();
    LAS unsigned char* lds = (LAS unsigned char*)lds_raw;
    const int tid = threadIdx.x, lane = tid & 63, wid = __builtin_amdgcn_readfirstlane(tid >> 6);
    const int G = gridDim.x, gw = blockIdx.x * 8 + wid, NGW = G * 8;
    unsigned char* ws = as_global(args.ws); const Inputs& in = args.in;
    float* ssq = (float*)(ws + WS_SSQ); float* ab = (float*)(ws + WS_AB); bf16_t* halo = (bf16_t*)(ws + WS_HALO); float* Eg = (float*)(ws + WS_E); float* mssq = (float*)(ws + WS_MSSQ);
    bf16_t* memb = (bf16_t*)(ws + WS_MEMB); bf16_t* memkv = (bf16_t*)(ws + WS_MEMKV); bf16_t* Wt = (bf16_t*)(ws + WS_W); bf16_t* xb = (bf16_t*)(ws + WS_XB);
    bf16_t* R0 = (bf16_t*)(ws + WS_BIG); bf16_t* R1 = R0 + SLOTE; bf16_t* R2 = R0 + 2 * SLOTE; bf16_t* R3 = R0 + 3 * SLOTE; bf16_t* R4 = R0 + 4 * SLOTE; bf16_t* R5 = R0 + 5 * SLOTE;
    float* out = as_global(args.out);
    volatile LAS unsigned* bst = (volatile LAS unsigned*)(lds + LDS_BYTES - 64);
    if (threadIdx.x < 16) bst[threadIdx.x] = 0u;
    __syncthreads();
    XcdBarrier xbar = xcd_barrier_post((unsigned*)ws, bst);

    convert_phase(lds, in, Wt, 0, gw, NGW, wid, lane);
    rows_to_bf16(as_global(in.p[0]), xb, ssq, MROWS, gw, NGW, lane);
    rows_to_bf16(as_global(in.p[1]), memb, mssq, MEMROWS, gw, NGW, lane);
    grid.sync();

    for (int l = 0; l < DEPTH; ++l) {
        int rep_ = 0;
        for (int ph = 0; ph < PH_COUNT; ++ph) {
            if (ph == PH_CONV && l == DEPTH - 1) continue;
            const bool dupl = ((PROBE_DUP_MASK >> ph) & 1) && !((ph == PH_PREP || ph == PH_SCAN || ph == PH_BAND) && l != 0);
            unsigned char* ws = as_global(args.ws);
            float* ssq = (float*)(ws + WS_SSQ); float* ab = (float*)(ws + WS_AB); bf16_t* halo = (bf16_t*)(ws + WS_HALO); float* Eg = (float*)(ws + WS_E); float* mssq = (float*)(ws + WS_MSSQ);
            bf16_t* memb = (bf16_t*)(ws + WS_MEMB); bf16_t* memkv = (bf16_t*)(ws + WS_MEMKV); bf16_t* Wt = (bf16_t*)(ws + WS_W); bf16_t* xb = (bf16_t*)(ws + WS_XB);
            bf16_t* R0 = (bf16_t*)(ws + WS_BIG); bf16_t* R1 = R0 + SLOTE; bf16_t* R2 = R0 + 2 * SLOTE; bf16_t* R3 = R0 + 3 * SLOTE; bf16_t* R4 = R0 + 4 * SLOTE; bf16_t* R5 = R0 + 5 * SLOTE;
            int tid = threadIdx.x; asm volatile("" : "+v"(tid)); const int lane = tid & 63, wid = __builtin_amdgcn_readfirstlane(tid >> 6), gw = blockIdx.x * 8 + wid;
            int kind = -1;
            Gemm g{nullptr, nullptr, MROWS, 1024, 1024}; int cshift = 0;
            EpiIn ei{R0, -1, -1, ab, nullptr, ssq, 2}; EpiB eb{nullptr, DM, ssq, nullptr, nullptr, 0}; EpiRes er{out, out, xb, ssq};
            bool sync_after = true;
            switch (ph) {
                case PH_IN_A: kind = 0; g.A = xb; g.Bt = Wt + WO_IN; g.N = 4352; ei.act_slot = 3; ei.ab_tile = 16; ei.halo = halo; sync_after = false; break;
                case PH_MEMKV: kind = 1; g.A = memb; g.Bt = Wt + WO_MKV; g.M = MEMROWS; g.N = 2048; eb.O = memkv; eb.ldc = 2048; eb.ssq = mssq; eb.mode = 0; cshift = 192; break;
                case PH_IN_B: kind = 0; g.A = xb; g.Bt = Wt + WO_IN + (size_t)4352 * 1024; g.N = 3072; ei.slot2 = 4; break;
                case PH_GA: kind = 1; g.A = xb; g.Bt = Wt + WO_IN + (size_t)7424 * 1024; eb.O = R1; eb.mode = 1; sync_after = false; break;
                case PH_T: kind = 1; g.A = R3; g.Bt = Wt + WO_A; eb.O = R2; eb.g1 = R1; eb.mode = 2; sync_after = false; break;
                case PH_GB: kind = 1; g.A = xb; g.Bt = Wt + WO_IN + (size_t)8448 * 1024; eb.O = R1; eb.mode = 1; sync_after = false; break;
                case PH_Y: kind = 1; g.A = R0; g.Bt = Wt + WO_B; eb.O = R4; eb.g1 = R1; eb.t = R2; eb.mode = 3; break;
                case PH_WO: kind = 3; g.A = R4; g.Bt = Wt + WO_O; er.base = (l == 0) ? as_global(in.p[0]) : out; break;
                case PH_QM: kind = 1; g.A = xb; g.Bt = Wt + WO_MQ; eb.O = R0; eb.mode = 0; break;
                case PH_WMO: kind = 3; g.A = R1; g.Bt = Wt + WO_MO; break;
                case PH_FFN: kind = 2; g.A = xb; g.Bt = Wt + WO_GU; g.N = 2 * DFF; break;
                case PH_DOWN: kind = 3; g.A = R0; g.Bt = Wt + WO_DN; g.K = DFF; break;
                default: break;
            }
            if (kind >= 0) {
#ifndef SKIP_GEMM
                StaticOrder S; S.init(g.M, g.N, G, (int)((blockIdx.x + cshift) % G));
#ifndef SKIP_G0
                if (kind == 0) gemm_phase<EpiIn, StaticOrder, true, true>(lds, g, S, ei);
#endif
#ifndef SKIP_G1
                if (kind == 1) gemm_phase<EpiB, StaticOrder, true, true>(lds, g, S, eb);
#endif
#ifndef SKIP_G2
                if (kind == 2) { EpiFfn ef{R0, ssq}; gemm_phase<EpiFfn, StaticOrder, true, true>(lds, g, S, ef); }
#endif
#ifndef SKIP_G3
                if (kind == 3) gemm_phase<EpiRes, StaticOrder, true, true>(lds, g, S, er);
#endif
#endif
            } else if (ph == PH_PREP) {
#ifndef SKIP_PREP
                prep_phase(lds, R0, ab, halo, as_global(in.p[4]) + (size_t)l * 4 * 3072, as_global(in.p[5]) + l * 8, as_global(in.p[6]) + l * 8, R4, R5, Eg, (rep_ == 0 && dupl) ? (bf16_t*)out : R0, (rep_ == 0 && dupl) ? (bf16_t*)out + SLOTE : R1, (rep_ == 0 && dupl) ? (bf16_t*)out : R2, tid, wid, lane);
#endif
            } else if (ph == PH_SCAN) {
#ifndef SKIP_SCAN
                scan_phase(lds, R0, R4, R5, Eg, (rep_ == 0 && dupl) ? (bf16_t*)out : R2, tid, wid, lane);
#endif
            } else if (ph == PH_BAND) {
                if (!(rep_ == 1)) oa_norm(R2, R3, as_global(in.p[7]) + l * 128, gw, NGW, lane);
#ifndef SKIP_BAND
                band_phase(lds, R0, R1, R4, (rep_ == 0 && dupl) ? (bf16_t*)out : R0, as_global(in.p[10]), tid, wid, lane);
#endif
            } else if (ph == PH_XATTN) {
#ifndef SKIP_XATTN
                xattn_phase(lds, R0, memkv, R1, tid, wid, lane);
#endif
            } else if (ph == PH_CONV) {
                convert_phase(lds, in, Wt, l + 1, gw, NGW, wid, lane);
            }
            if (dupl && rep_ == 0) { rep_ = 1; --ph; continue; }
            rep_ = 0;
            if (sync_after) { xcd_barrier(xbar); for (int e_ = 0; e_ < PROBE_EXTRA_SYNC; ++e_) xcd_barrier(xbar); }
        }
    }
    final_norm(out, ssq, as_global(in.p[20]), gw, NGW, lane);
}

extern "C" void kernel_launch(void* const* d_in, const int* in_sizes, int n_in, void* d_out, int out_size, void* d_ws, size_t ws_size, hipStream_t stream) {
    static int grid = 0;
    if (grid == 0) {
        if (n_in != 21 || out_size != MROWS * DM || ws_size < WS_END) { fprintf(stderr, "kernel_launch: unexpected shapes (n_in %d out %d ws %zu)\n", n_in, out_size, ws_size); grid = -1; return; }
        int dev = 0, cus = 0, per_cu = 0;
        hipGetDevice(&dev); hipDeviceGetAttribute(&cus, hipDeviceAttributeMultiprocessorCount, dev);
        if (hipFuncSetAttribute((const void*)fwd_megakernel, hipFuncAttributeMaxDynamicSharedMemorySize, LDS_BYTES) != hipSuccess) { fprintf(stderr, "kernel_launch: hipFuncSetAttribute failed\n"); grid = -1; return; }
        if (hipOccupancyMaxActiveBlocksPerMultiprocessor(&per_cu, (const void*)fwd_megakernel, 512, LDS_BYTES) != hipSuccess || per_cu < 1) { fprintf(stderr, "kernel_launch: occupancy query says %d\n", per_cu); per_cu = 1; }
        (void)hipGetLastError();
        grid = cus * 1;
        if (grid > 256) grid = 256;
    }
    if (grid < 0) return;
    if (hipMemsetAsync(d_ws, 0, 16384, stream) != hipSuccess) { fprintf(stderr, "kernel_launch: memset failed\n"); return; }
    Args a{};
    for (int i = 0; i < 21; ++i) a.in.p[i] = (const float*)d_in[i];
    a.out = (float*)d_out; a.ws = (unsigned char*)d_ws;
    void* kargs[] = {&a};
    hipError_t e = hipLaunchCooperativeKernel((const void*)fwd_megakernel, dim3(grid), dim3(512), kargs, LDS_BYTES, stream);
    if (e != hipSuccess) fprintf(stderr, "cooperative launch failed: %s (grid %d)\n", hipGetErrorString(e), grid);
}
```

```cpp
#include <hip/hip_runtime.h>
#include <hip/hip_cooperative_groups.h>
#include <cstdio>
#include <cstdint>
namespace cg = cooperative_groups;
namespace pg8 {
#define PG8_LAS __attribute__((address_space(3)))
typedef unsigned short bf16_t;
typedef short bf16x8 __attribute__((ext_vector_type(8)));
typedef float f32x4 __attribute__((ext_vector_type(4)));
typedef unsigned u32x4 __attribute__((ext_vector_type(4)));
constexpr int BM = 256, BK = 64, HALF = 128, HTB = HALF * BK * 2  , STAGE_BYTES = 8 * HTB, NXCD = 8, WGM = 8;

__host__ __device__ __forceinline__ int lds_byte(int r, int c) { const int st = (r >> 4) * 2 + (c >> 5), rr = r & 15, cc = c & 31, ob = rr * 64 + cc * 2; return st * 1024 + (ob ^ (((ob >> 9) & 1) << 5)); }
__host__ __device__ __forceinline__ void stage_rc(int b, int& R, int& C) { const int st = b / 1024, sb = b % 1024, swz = sb ^ (((sb >> 9) & 1) << 5); R = (st >> 1) * 16 + swz / 64; C = (st & 1) * 32 + (swz % 64) / 2; }
__host__ __device__ __forceinline__ int perm32(int rho) { const int n = rho >> 4, i = rho & 15; return 8 * (i >> 2) + 4 * n + (i & 3); }

struct Unit { int pm, pn; };
struct Gemm { const bf16_t* A; const bf16_t* Bt; int M, N, K; };

struct StaticOrder {
    int nM, nN, nwg, G, c;
    __host__ __device__ void init(int M, int N, int G_, int c_) { nM = M / BM; nN = N / BM; nwg = nM * nN; G = G_; c = c_; }
    __host__ __device__ bool next(int i, Unit& u) const {
        const long L = (long)i * G + c; if (L >= nwg) return false;
        int wgid = (int)L; { const int q = nwg / NXCD, r = nwg % NXCD, xcd = wgid % NXCD, off = wgid / NXCD; wgid = (xcd < r ? xcd * (q + 1) : r * (q + 1) + (xcd - r) * q) + off; }
        const int nig = WGM * nN, gid = wgid / nig, fm = gid * WGM, gsz = (nM - fm) < WGM ? (nM - fm) : WGM;
        u.pm = fm + ((wgid % nig) % gsz); u.pn = (wgid % nig) / gsz; return true;
    }
    __device__ __forceinline__ void a_ready(const Unit&) const {}
    __device__ __forceinline__ void done(const Unit&) const {}
};

typedef float f32x2 __attribute__((ext_vector_type(2)));
typedef __bf16 bf16x2_t __attribute__((ext_vector_type(2)));
typedef unsigned u32x2 __attribute__((ext_vector_type(2)));
__device__ __forceinline__ unsigned pk2(float lo, float hi) { f32x2 v = {lo, hi}; bf16x2_t b = __builtin_convertvector(v, bf16x2_t); return __builtin_bit_cast(unsigned, b); }
template <class Epi, class Sched, bool ALIGN_EPI = false, bool SP2 = false>
__device__ __forceinline__ void gemm_phase(PG8_LAS unsigned char* lds, const Gemm g, const Sched& S, const Epi& E) {
    int tid_ = threadIdx.x; asm volatile("" : "+v"(tid_));
    const int tid = tid_, wid = __builtin_amdgcn_readfirstlane(tid >> 6), lane = tid & 63, wr = wid >> 2, wc = wid & 3, fr = lane & 15, fq = lane >> 4;
    const int K = g.K, nt = K / BK;
    unsigned voffA[2], voffB[2];
#pragma unroll
    for (int i = 0; i < 2; ++i) { int R, C; stage_rc(tid * 16 + i * 8192, R, C); const int Rb = Epi::PERM ? ((R & ~31) + perm32(R & 31)) : R;
        voffA[i] = (unsigned)(R * K + C) * 2u; voffB[i] = (unsigned)(Rb * K + C) * 2u; }
    const size_t kstep = (size_t)(BK * 2);
    const size_t hstep = (size_t)HALF * K * 2;
    const size_t tstep = 2 * hstep;
    const unsigned ldsw = (unsigned)wid * 1024u;
    const int aoff = lds_byte(wr * 64 + fr, fq * 8), boff = lds_byte(wc * 32 + fr, fq * 8);
#define PG8_SA(b, h) (((b) * 2 + (h)) * HTB)
#define PG8_SB(b, h) ((4 + (b) * 2 + (h)) * HTB)
#define PG8_STAGE(bufoff, gbase, voff) do { _Pragma("unroll") for (int _i = 0; _i < 2; ++_i) \
        __builtin_amdgcn_global_load_lds((const unsigned*)((const char*)(gbase) + (voff)[_i]), (PG8_LAS unsigned*)(lds + (bufoff) + ldsw + _i * 8192), 16, 0, 0); } while (0)
#define PG8_LDA(dst, b, h) do { _Pragma("unroll") for (int m = 0; m < 4; ++m) _Pragma("unroll") for (int k = 0; k < 2; ++k) dst[m][k] = *(const PG8_LAS bf16x8*)(lds + PG8_SA(b, h) + aoff + m * 2048 + k * 1024); } while (0)
#define PG8_LDB(dst, b, h) do { _Pragma("unroll") for (int n = 0; n < 2; ++n) _Pragma("unroll") for (int k = 0; k < 2; ++k) dst[n][k] = *(const PG8_LAS bf16x8*)(lds + PG8_SB(b, h) + boff + n * 2048 + k * 1024); } while (0)
#define PG8_MMA(ai, bj, At, Bt) do { __builtin_amdgcn_s_setprio(1); _Pragma("unroll") for (int m = 0; m < 4; ++m) _Pragma("unroll") for (int n = 0; n < 2; ++n) _Pragma("unroll") for (int k = 0; k < 2; ++k) \
        acc[ai][bj][m][n] = __builtin_amdgcn_mfma_f32_16x16x32_bf16(Bt[n][k], At[m][k], acc[ai][bj][m][n], 0, 0, 0); __builtin_amdgcn_s_setprio(0); } while (0)
#define PG8_WAIT_V(n) asm volatile("s_waitcnt vmcnt(" #n ")" ::: "memory")
#define PG8_WAIT_L(n) asm volatile("s_waitcnt lgkmcnt(" #n ")" ::: "memory")
#define PG8_BAR __builtin_amdgcn_s_barrier()
#define PG8_SCHED __builtin_amdgcn_sched_barrier(0)
    Unit cur, nxt; int ui = 0;
    if (!S.next(0, cur)) return;
    f32x4 acc[2][2][4][2];
#pragma unroll
    for (int a = 0; a < 2; ++a)
#pragma unroll
        for (int b = 0; b < 2; ++b)
#pragma unroll
            for (int m = 0; m < 4; ++m)
#pragma unroll
                for (int n = 0; n < 2; ++n) acc[a][b][m][n] = (f32x4){0.f, 0.f, 0.f, 0.f};
    bf16x8 At[4][2], B0[2][2], B1[2][2];
    const char* cA = (const char*)g.A + (size_t)cur.pm * tstep; const char* cB = (const char*)g.Bt + (size_t)cur.pn * tstep;
    S.a_ready(cur);
    if constexpr (SP2) {
        PG8_STAGE(PG8_SB(0, 0), cB, voffB); PG8_STAGE(PG8_SB(0, 1), cB + hstep, voffB); PG8_STAGE(PG8_SA(0, 0), cA, voffA); PG8_STAGE(PG8_SA(0, 1), cA + hstep, voffA);
        if (wr == 1) PG8_BAR;
        PG8_WAIT_V(2); PG8_BAR;
        PG8_STAGE(PG8_SB(1, 0), cB + kstep, voffB); PG8_STAGE(PG8_SA(1, 0), cA + kstep, voffA); PG8_STAGE(PG8_SB(1, 1), cB + hstep + kstep, voffB);
        PG8_WAIT_V(6); PG8_BAR;
    } else {
        PG8_STAGE(PG8_SB(0, 0), cB, voffB); PG8_STAGE(PG8_SA(0, 0), cA, voffA); PG8_STAGE(PG8_SB(0, 1), cB + hstep, voffB); PG8_STAGE(PG8_SA(0, 1), cA + hstep, voffA);
        if (wr == 1) PG8_BAR;
        PG8_WAIT_V(4); PG8_BAR;
        PG8_STAGE(PG8_SB(1, 0), cB + kstep, voffB); PG8_STAGE(PG8_SA(1, 0), cA + kstep, voffA); PG8_STAGE(PG8_SB(1, 1), cB + hstep + kstep, voffB);
        PG8_WAIT_V(6); PG8_BAR;
    }
    for (;;) {
        const bool has_next = S.next(ui + 1, nxt);
        const char* nA = has_next ? (const char*)g.A + (size_t)nxt.pm * tstep : cA; const char* nB = has_next ? (const char*)g.Bt + (size_t)nxt.pn * tstep : cB;
        for (int t = 0; t < nt; t += 2) {
            const bool last = (t == nt - 2);
            const char* a1 = cA + (size_t)(t + 1) * kstep;
            const char* a2 = last ? nA : cA + (size_t)(t + 2) * kstep; const char* b2 = last ? nB : cB + (size_t)(t + 2) * kstep;
            const char* a3 = a2 + kstep; const char* b3 = b2 + kstep;
            if (last && has_next) S.a_ready(nxt);
            if constexpr (SP2) {
            PG8_LDB(B0, 0, 0); PG8_LDB(B1, 0, 1); PG8_SCHED; PG8_LDA(At, 0, 0); PG8_STAGE(PG8_SA(1, 1), a1 + hstep, voffA);
            PG8_WAIT_V(8); PG8_WAIT_L(0); PG8_BAR; PG8_MMA(0, 0, At, B0); PG8_MMA(0, 1, At, B1); PG8_BAR; PG8_SCHED;
            PG8_LDA(At, 0, 1); PG8_STAGE(PG8_SB(0, 0), b2, voffB); PG8_STAGE(PG8_SB(0, 1), b2 + hstep, voffB); PG8_STAGE(PG8_SA(0, 0), a2, voffA);
            PG8_WAIT_V(8); PG8_WAIT_L(0); PG8_BAR; PG8_MMA(1, 0, At, B0); PG8_MMA(1, 1, At, B1); PG8_BAR; PG8_SCHED;
            PG8_LDB(B0, 1, 0); PG8_LDB(B1, 1, 1); PG8_SCHED; PG8_LDA(At, 1, 0); PG8_STAGE(PG8_SA(0, 1), a2 + hstep, voffA);
            PG8_WAIT_V(8); PG8_WAIT_L(0); PG8_BAR; PG8_MMA(0, 0, At, B0); PG8_MMA(0, 1, At, B1); PG8_BAR; PG8_SCHED;
            PG8_LDA(At, 1, 1); PG8_STAGE(PG8_SB(1, 0), b3, voffB); PG8_STAGE(PG8_SB(1, 1), b3 + hstep, voffB); PG8_STAGE(PG8_SA(1, 0), a3, voffA);
            PG8_WAIT_V(8); PG8_WAIT_L(0); PG8_BAR; PG8_MMA(1, 0, At, B0); PG8_MMA(1, 1, At, B1); PG8_BAR; PG8_SCHED;
            } else {
            PG8_LDB(B0, 0, 0); PG8_SCHED; PG8_LDA(At, 0, 0); PG8_STAGE(PG8_SA(1, 1), a1 + hstep, voffA);
            PG8_WAIT_L(8); PG8_BAR; PG8_WAIT_L(0); PG8_MMA(0, 0, At, B0); PG8_BAR; PG8_SCHED;
            PG8_LDB(B1, 0, 1); PG8_STAGE(PG8_SB(0, 0), b2, voffB);
            PG8_BAR; PG8_WAIT_L(0); PG8_MMA(0, 1, At, B1); PG8_BAR;
            PG8_LDA(At, 0, 1); PG8_STAGE(PG8_SA(0, 0), a2, voffA);
            PG8_BAR; PG8_WAIT_L(0); PG8_MMA(1, 0, At, B0); PG8_BAR; PG8_SCHED;
            PG8_STAGE(PG8_SB(0, 1), b2 + hstep, voffB);
            PG8_WAIT_V(6); PG8_BAR; PG8_MMA(1, 1, At, B1); PG8_BAR;
            PG8_LDB(B0, 1, 0); PG8_SCHED; PG8_LDA(At, 1, 0); PG8_STAGE(PG8_SA(0, 1), a2 + hstep, voffA);
            PG8_WAIT_L(8); PG8_BAR; PG8_WAIT_L(0); PG8_MMA(0, 0, At, B0); PG8_BAR; PG8_SCHED;
            PG8_LDB(B1, 1, 1); PG8_STAGE(PG8_SB(1, 0), b3, voffB);
            PG8_BAR; PG8_WAIT_L(0); PG8_MMA(0, 1, At, B1); PG8_BAR;
            PG8_LDA(At, 1, 1); PG8_STAGE(PG8_SA(1, 0), a3, voffA);
            PG8_BAR; PG8_WAIT_L(0); PG8_MMA(1, 0, At, B0); PG8_BAR; PG8_SCHED;
            PG8_STAGE(PG8_SB(1, 1), b3 + hstep, voffB);
            PG8_WAIT_V(6); PG8_BAR; PG8_MMA(1, 1, At, B1); PG8_BAR;
            }
        }
        if constexpr (ALIGN_EPI) { if (wr == 0) PG8_BAR; }
        if constexpr (!Epi::AFTER_DRAIN) { E(acc, cur, wr, wc, fr, fq); S.done(cur); }
        if (!has_next) break;
#pragma unroll
        for (int a = 0; a < 2; ++a)
#pragma unroll
            for (int b = 0; b < 2; ++b)
#pragma unroll
                for (int m = 0; m < 4; ++m)
#pragma unroll
                    for (int n = 0; n < 2; ++n) acc[a][b][m][n] = (f32x4){0.f, 0.f, 0.f, 0.f};
        cur = nxt; cA = nA; cB = nB; ++ui;
        if constexpr (ALIGN_EPI) { if (wr == 1) PG8_BAR; }
    }
    PG8_WAIT_V(0);
    if constexpr (!ALIGN_EPI) { if (wr == 0) PG8_BAR; }
    PG8_BAR;
    if constexpr (Epi::AFTER_DRAIN) { E.fused(acc, cur, wr, wc, fr, fq, lds, wid, lane); S.done(cur); }
#undef PG8_SA
#undef PG8_SB
#undef PG8_STAGE
#undef PG8_LDA
#undef PG8_LDB
#undef PG8_MMA
#undef PG8_WAIT_V
#undef PG8_WAIT_L
#undef PG8_BAR
#undef PG8_SCHED
}
}
using namespace pg8;
#define LAS __attribute__((address_space(3)))
#define GAS __attribute__((address_space(1)))
template <class T> __device__ __forceinline__ T* as_global(T* p) { return (T*)(GAS T*)p; }
typedef short s16x4 __attribute__((ext_vector_type(4)));
typedef float f32x16 __attribute__((ext_vector_type(16)));

constexpr int BATCH = 8, SEQ = 2048, DM = 1024, MROWS = BATCH * SEQ, DEPTH = 2, NCH = 32;
constexpr int DFF = 2816, NIN = 9232, NIN_PAD = 9472, MEMROWS = BATCH * 256;
constexpr float EPS = 1e-6f, LOG2E = 1.4426950408889634f;
constexpr float QB_SCALE = 0.125f * LOG2E, QM_SCALE = 0.0625f * LOG2E;
constexpr size_t MiB = 1u << 20, SLOTB = 32 * MiB, SLOTE = (size_t)MROWS * DM;
constexpr size_t WS_SSQ = 1 * MiB, WS_AB = 2 * MiB, WS_HALO = 3 * MiB, WS_E = 8 * MiB, WS_MSSQ = 8 * MiB + 65536;
constexpr size_t WS_MEMB = 12 * MiB, WS_MEMKV = 16 * MiB, WS_W = 24 * MiB, WS_XB = 76 * MiB, WS_BIG = 108 * MiB, WS_END = 284 * MiB;
constexpr size_t WO_IN = 0, WO_A = WO_IN + (size_t)NIN_PAD * 1024, WO_B = WO_A + 1048576, WO_O = WO_B + 1048576, WO_MQ = WO_O + 1048576,
                 WO_MKV = WO_MQ + 1048576, WO_MO = WO_MKV + 2097152, WO_GU = WO_MO + 1048576, WO_DN = WO_GU + (size_t)2 * DFF * 1024, WO_END = WO_DN + (size_t)DFF * 1024;
static_assert(WS_W + WO_END * 2 <= WS_XB, "weights fit");
constexpr int LDS_BYTES = 147456;

__device__ __forceinline__ float bf2f(unsigned short b) { return __uint_as_float((unsigned)b << 16); }
__device__ __forceinline__ float bflo(unsigned w) { return __uint_as_float(w << 16); }
__device__ __forceinline__ float bfhi(unsigned w) { return __uint_as_float(w & 0xffff0000u); }
__device__ __forceinline__ float sigmoidf_(float x) { return __builtin_amdgcn_rcpf(1.f + __expf(-x)); }
__device__ __forceinline__ float siluf_(float x) { return x * __builtin_amdgcn_rcpf(1.f + __expf(-x)); }
__device__ __forceinline__ float row_rstd(const float* ssq, int row) {
    const f32x4* p = (const f32x4*)(ssq + (size_t)row * 16); const f32x4 a = p[0], b = p[1], c = p[2], d = p[3];
    const float s = ((a.x + a.y) + (a.z + a.w)) + ((b.x + b.y) + (b.z + b.w)) + ((c.x + c.y) + (c.z + c.w)) + ((d.x + d.y) + (d.z + d.w));
    return rsqrtf(s * (1.f / 1024.f) + EPS);
}
__device__ __forceinline__ float wave_sum(float v) {
#pragma unroll
    for (int o = 1; o < 64; o <<= 1) v += __shfl_xor(v, o);
    return v;
}

struct EpiIn {
    static constexpr bool PERM = true, AFTER_DRAIN = false;
    bf16_t* slot0; int act_slot, ab_tile; float* ab; bf16_t* halo; const float* ssq; int slot2;
    __device__ __forceinline__ void operator()(const f32x4 (&acc)[2][2][4][2], const Unit& u, int wr, int wc, int fr, int fq) const {
        float rs[2][4];
#pragma unroll
        for (int ai = 0; ai < 2; ++ai)
#pragma unroll
            for (int m = 0; m < 4; ++m) rs[ai][m] = row_rstd(ssq, u.pm * BM + ai * HALF + wr * 64 + m * 16 + fr);
        if (u.pn == ab_tile) {
            if (wc == 0 && fq < 2) {
#pragma unroll
                for (int ai = 0; ai < 2; ++ai)
#pragma unroll
                    for (int m = 0; m < 4; ++m) { const int row = u.pm * BM + ai * HALF + wr * 64 + m * 16 + fr;
#pragma unroll
                        for (int n = 0; n < 2; ++n) *(f32x4*)(ab + (size_t)row * 16 + 8 * fq + 4 * n) = acc[ai][0][m][n] * rs[ai][m]; }
            }
            return;
        }
        const int slot = u.pn >> 2; bf16_t* base = slot0 + (size_t)(slot == 2 ? slot2 : slot) * SLOTE; const bool act = (slot == act_slot);
        const int col0 = (u.pn & 3) * BM + wc * 32 + 8 * fq;
#pragma unroll
        for (int ai = 0; ai < 2; ++ai)
#pragma unroll
            for (int m = 0; m < 4; ++m) { const int row = u.pm * BM + ai * HALF + wr * 64 + m * 16 + fr; bf16_t* rowp = base + (size_t)row * DM + col0;
#pragma unroll
                for (int bj = 0; bj < 2; ++bj) { f32x4 v0 = acc[ai][bj][m][0] * rs[ai][m], v1 = acc[ai][bj][m][1] * rs[ai][m];
                    if (act) { v0 = (f32x4){siluf_(v0[0]), siluf_(v0[1]), siluf_(v0[2]), siluf_(v0[3])}; v1 = (f32x4){siluf_(v1[0]), siluf_(v1[1]), siluf_(v1[2]), siluf_(v1[3])}; }
                    u32x4 w; w.x = pk2(v0[0], v0[1]); w.y = pk2(v0[2], v0[3]); w.z = pk2(v1[0], v1[1]); w.w = pk2(v1[2], v1[3]);
                    *(u32x4*)(rowp + bj * HALF) = w;
                    if (halo && slot < 3 && m == 3 && fr >= 13) { const int hrow = (row >> 6) * 3 + (fr - 13); *(u32x4*)(halo + (size_t)hrow * 3072 + slot * 1024 + col0 + bj * HALF) = w; }
                } }
    }
};
struct EpiB {
    static constexpr bool PERM = true, AFTER_DRAIN = false;
    bf16_t* O; int ldc; const float* ssq; const bf16_t* g1; const bf16_t* t; int mode;
    __device__ __forceinline__ void operator()(const f32x4 (&acc)[2][2][4][2], const Unit& u, int wr, int wc, int fr, int fq) const {
        const int col0 = u.pn * BM + wc * 32 + 8 * fq;
#pragma unroll
        for (int ai = 0; ai < 2; ++ai)
#pragma unroll
            for (int m = 0; m < 4; ++m) { const int row = u.pm * BM + ai * HALF + wr * 64 + m * 16 + fr; const size_t off = (size_t)row * ldc + col0;
                float rs = 1.f; if (mode < 2) rs = row_rstd(ssq, row);
#pragma unroll
                for (int bj = 0; bj < 2; ++bj) { f32x4 v0 = acc[ai][bj][m][0] * rs, v1 = acc[ai][bj][m][1] * rs;
                    if (mode == 1) { v0 = (f32x4){sigmoidf_(v0[0]), sigmoidf_(v0[1]), sigmoidf_(v0[2]), sigmoidf_(v0[3])}; v1 = (f32x4){sigmoidf_(v1[0]), sigmoidf_(v1[1]), sigmoidf_(v1[2]), sigmoidf_(v1[3])}; }
                    if (mode >= 2) { const u32x4 g = *(const u32x4*)(g1 + off + bj * HALF);
                        v0 = v0 * (f32x4){bflo(g.x), bfhi(g.x), bflo(g.y), bfhi(g.y)}; v1 = v1 * (f32x4){bflo(g.z), bfhi(g.z), bflo(g.w), bfhi(g.w)};
                        if (mode == 3) { const u32x4 tt = *(const u32x4*)(t + off + bj * HALF);
                            v0 = v0 + (f32x4){bflo(tt.x), bfhi(tt.x), bflo(tt.y), bfhi(tt.y)}; v1 = v1 + (f32x4){bflo(tt.z), bfhi(tt.z), bflo(tt.w), bfhi(tt.w)}; } }
                    u32x4 w; w.x = pk2(v0[0], v0[1]); w.y = pk2(v0[2], v0[3]); w.z = pk2(v1[0], v1[1]); w.w = pk2(v1[2], v1[3]);
                    *(u32x4*)(O + off + bj * HALF) = w; } }
    }
};
struct EpiFfn {
    static constexpr bool PERM = true, AFTER_DRAIN = false;
    bf16_t* O; const float* ssq;
    __device__ __forceinline__ void operator()(const f32x4 (&acc)[2][2][4][2], const Unit& u, int wr, int wc, int fr, int fq) const {
        const int col0 = u.pn * HALF + wc * 32 + 8 * fq;
#pragma unroll
        for (int ai = 0; ai < 2; ++ai)
#pragma unroll
            for (int m = 0; m < 4; ++m) { const int row = u.pm * BM + ai * HALF + wr * 64 + m * 16 + fr; const float rs = row_rstd(ssq, row);
                const f32x4 g0 = acc[ai][0][m][0] * rs, g1 = acc[ai][0][m][1] * rs, u0 = acc[ai][1][m][0] * rs, u1 = acc[ai][1][m][1] * rs;
                u32x4 w; w.x = pk2(siluf_(g0[0]) * u0[0], siluf_(g0[1]) * u0[1]); w.y = pk2(siluf_(g0[2]) * u0[2], siluf_(g0[3]) * u0[3]);
                w.z = pk2(siluf_(g1[0]) * u1[0], siluf_(g1[1]) * u1[1]); w.w = pk2(siluf_(g1[2]) * u1[2], siluf_(g1[3]) * u1[3]);
                *(u32x4*)(O + (size_t)row * DFF + col0) = w; }
    }
};
struct EpiRes {
    static constexpr bool PERM = false, AFTER_DRAIN = false;
    const float* base; float* out; bf16_t* xb; float* ssq;
    __device__ __forceinline__ void operator()(const f32x4 (&acc)[2][2][4][2], const Unit& u, int wr, int wc, int fr, int fq) const {
        const int col0 = u.pn * BM + wc * 32 + 4 * fq;
#pragma unroll
        for (int ai = 0; ai < 2; ++ai)
#pragma unroll
            for (int m = 0; m < 4; ++m) { const int row = u.pm * BM + ai * HALF + wr * 64 + m * 16 + fr; const size_t off = (size_t)row * DM + col0; float s = 0.f;
#pragma unroll
                for (int bj = 0; bj < 2; ++bj)
#pragma unroll
                    for (int n = 0; n < 2; ++n) { const size_t o2 = off + bj * HALF + n * 16; const f32x4 v = *(const f32x4*)(base + o2) + acc[ai][bj][m][n];
                        *(f32x4*)(out + o2) = v; u32x2 w; w.x = pk2(v[0], v[1]); w.y = pk2(v[2], v[3]); *(u32x2*)(xb + o2) = w;
                        s += (v[0] * v[0] + v[1] * v[1]) + (v[2] * v[2] + v[3] * v[3]); }
                s += __shfl_xor(s, 16); s += __shfl_xor(s, 32);
                if (fq == 0) ssq[(size_t)row * 16 + u.pn * 4 + wc] = s; }
    }
};
__device__ __forceinline__ int map_row(int mode, int n) {
    if (mode == 1) return n >= 4112 ? n + 240 : n;
    if (mode == 2) { const int m = n < DFF ? n : n - DFF; return (m >> 7) * 256 + (n < DFF ? 0 : 128) + (m & 127); }
    return n;
}
__device__ __forceinline__ void tr_item(const float* W, int K, int N, bf16_t* WT, int mode, const float* g, LAS float* scr, int item, int lane) {
    const int nblk = (N + 63) / 64, kb = item / nblk, nb = item % nblk, k0 = 64 * kb, n0 = 64 * nb;
    const int nl = n0 + 4 * (lane & 15), kr = lane >> 4;
    f32x4 v[16];
#pragma unroll
    for (int i = 0; i < 16; ++i) { const int kk = 4 * i + kr; v[i] = (nl < N) ? *(const f32x4*)(W + (size_t)(k0 + kk) * N + nl) : (f32x4){0.f, 0.f, 0.f, 0.f}; }
#pragma unroll
    for (int i = 0; i < 16; ++i) { const int kk = 4 * i + kr; f32x4 x = v[i]; if (g) x = x * g[k0 + kk]; *(LAS f32x4*)(scr + kk * 68 + 4 * (lane & 15)) = x; }
    asm volatile("s_waitcnt lgkmcnt(0)" ::: "memory");
    const int c = lane & 7;
#pragma unroll
    for (int j = 0; j < 8; ++j) { const int nn = (lane >> 3) + 8 * j, n = n0 + nn;
        if (n < N) { float sc = 1.f; if (mode == 1 && n >= 4112 && n < 5136) sc = QB_SCALE; if (mode == 3) sc = QM_SCALE;
            const LAS float* s = scr + (8 * c) * 68 + nn;
            u32x4 o; o.x = pk2(s[0 * 68] * sc, s[1 * 68] * sc); o.y = pk2(s[2 * 68] * sc, s[3 * 68] * sc); o.z = pk2(s[4 * 68] * sc, s[5 * 68] * sc); o.w = pk2(s[6 * 68] * sc, s[7 * 68] * sc);
            *(u32x4*)(WT + (size_t)map_row(mode, n) * K + k0 + 8 * c) = o; } }
    asm volatile("s_waitcnt lgkmcnt(0)" ::: "memory");
}
struct Inputs { const float* p[21]; };
__device__ __forceinline__ void convert_phase(LAS unsigned char* lds, const Inputs& in, bf16_t* Wt, int l, int gw, int NGW, int wid, int lane) {
    LAS float* scr = (LAS float*)(lds + wid * 18432);
    constexpr int I_IN = 16 * 145, I_SQ = 16 * 16, I_MKV = 16 * 32, I_GU = 16 * 88, I_DN = 44 * 16;
    constexpr int NITEMS = I_IN + 5 * I_SQ + I_MKV + I_GU + I_DN;
    for (int it = gw; it < NITEMS; it += NGW) {
        int r = it;
        if (r < I_IN) { tr_item(as_global(in.p[3]) + (size_t)l * 1024 * NIN, 1024, NIN, Wt + WO_IN, 1, as_global(in.p[2]) + l * 1024, scr, r, lane); continue; } r -= I_IN;
        if (r < I_SQ) { tr_item(as_global(in.p[8]) + (size_t)l * 1048576, 1024, 1024, Wt + WO_A, 0, nullptr, scr, r, lane); continue; } r -= I_SQ;
        if (r < I_SQ) { tr_item(as_global(in.p[9]) + (size_t)l * 1048576, 1024, 1024, Wt + WO_B, 0, nullptr, scr, r, lane); continue; } r -= I_SQ;
        if (r < I_SQ) { tr_item(as_global(in.p[11]) + (size_t)l * 1048576, 1024, 1024, Wt + WO_O, 0, nullptr, scr, r, lane); continue; } r -= I_SQ;
        if (r < I_SQ) { tr_item(as_global(in.p[14]) + (size_t)l * 1048576, 1024, 1024, Wt + WO_MQ, 3, as_global(in.p[12]) + l * 1024, scr, r, lane); continue; } r -= I_SQ;
        if (r < I_SQ) { tr_item(as_global(in.p[16]) + (size_t)l * 1048576, 1024, 1024, Wt + WO_MO, 0, nullptr, scr, r, lane); continue; } r -= I_SQ;
        if (r < I_MKV) { tr_item(as_global(in.p[15]) + (size_t)l * 2097152, 1024, 2048, Wt + WO_MKV, 0, as_global(in.p[13]) + l * 1024, scr, r, lane); continue; } r -= I_MKV;
        if (r < I_GU) { tr_item(as_global(in.p[18]) + (size_t)l * 1024 * 2 * DFF, 1024, 2 * DFF, Wt + WO_GU, 2, as_global(in.p[17]) + l * 1024, scr, r, lane); continue; } r -= I_GU;
        tr_item(as_global(in.p[19]) + (size_t)l * DFF * 1024, DFF, 1024, Wt + WO_DN, 0, nullptr, scr, r, lane);
    }
    for (int i = gw * 64 + lane; i < 240 * 128; i += NGW * 64) *(u32x4*)(Wt + WO_IN + (size_t)4112 * 1024 + (size_t)i * 8) = (u32x4){0u, 0u, 0u, 0u};
}
__device__ __forceinline__ void rows_to_bf16(const float* x, bf16_t* xb, float* ssq, int nrows, int gw, int NGW, int lane) {
    for (int m = gw; m < nrows; m += NGW) {
        const f32x4* xr = (const f32x4*)(x + (size_t)m * DM) + lane; f32x4 v[4]; float s = 0.f;
#pragma unroll
        for (int j = 0; j < 4; ++j) { v[j] = xr[64 * j]; s += (v[j].x * v[j].x + v[j].y * v[j].y) + (v[j].z * v[j].z + v[j].w * v[j].w); }
        s = wave_sum(s);
        u32x2* o8 = (u32x2*)(xb + (size_t)m * DM) + lane;
#pragma unroll
        for (int j = 0; j < 4; ++j) { u32x2 w; w.x = pk2(v[j].x, v[j].y); w.y = pk2(v[j].z, v[j].w); o8[64 * j] = w; }
        if (lane < 16) ssq[(size_t)m * 16 + lane] = (lane == 0) ? s : 0.f;
    }
}
__device__ __forceinline__ void final_norm(float* out, const float* ssq, const float* g, int gw, int NGW, int lane) {
    for (int m = gw; m < MROWS; m += NGW) {
        const float rs = row_rstd(ssq, m); f32x4* xr = (f32x4*)(out + (size_t)m * DM) + lane; const f32x4* gr = (const f32x4*)g + lane;
#pragma unroll
        for (int j = 0; j < 4; ++j) xr[64 * j] = xr[64 * j] * rs * gr[64 * j];
    }
}
__device__ __forceinline__ void oa_norm(const bf16_t* o, bf16_t* za, const float* hn, int gw, int NGW, int lane) {
    for (int m = gw; m < MROWS; m += NGW) {
        const size_t off = (size_t)m * DM + lane * 16; const u32x4 a0 = *(const u32x4*)(o + off), a1 = *(const u32x4*)(o + off + 8); const u32x4 z0 = *(const u32x4*)(za + off), z1 = *(const u32x4*)(za + off + 8);
        float v[16] = {bflo(a0.x), bfhi(a0.x), bflo(a0.y), bfhi(a0.y), bflo(a0.z), bfhi(a0.z), bflo(a0.w), bfhi(a0.w), bflo(a1.x), bfhi(a1.x), bflo(a1.y), bfhi(a1.y), bflo(a1.z), bfhi(a1.z), bflo(a1.w), bfhi(a1.w)};
        float z[16] = {bflo(z0.x), bfhi(z0.x), bflo(z0.y), bfhi(z0.y), bflo(z0.z), bfhi(z0.z), bflo(z0.w), bfhi(z0.w), bflo(z1.x), bfhi(z1.x), bflo(z1.y), bfhi(z1.y), bflo(z1.z), bfhi(z1.z), bflo(z1.w), bfhi(z1.w)};
        float s = 0.f;
#pragma unroll
        for (int j = 0; j < 16; ++j) s += v[j] * v[j];
        s += __shfl_xor(s, 1); s += __shfl_xor(s, 2); s += __shfl_xor(s, 4);
        const float rs = rsqrtf(s * (1.f / 128.f) + EPS); const float* h = hn + (lane & 7) * 16;
#pragma unroll
        for (int j = 0; j < 16; ++j) v[j] = v[j] * rs * h[j] * z[j];
        u32x4 w0, w1; w0.x = pk2(v[0], v[1]); w0.y = pk2(v[2], v[3]); w0.z = pk2(v[4], v[5]); w0.w = pk2(v[6], v[7]); w1.x = pk2(v[8], v[9]); w1.y = pk2(v[10], v[11]); w1.z = pk2(v[12], v[13]); w1.w = pk2(v[14], v[15]);
        *(u32x4*)(za + off) = w0; *(u32x4*)(za + off + 8) = w1;
    }
}

#define MFMA16(a, b, c) __builtin_amdgcn_mfma_f32_16x16x32_bf16((a), (b), (c), 0, 0, 0)
#define MFMA32(a, b, c) __builtin_amdgcn_mfma_f32_32x32x16_bf16((a), (b), (c), 0, 0, 0)
constexpr int RP = 272, LP = 68;
constexpr int PR_QS = 0, PR_KS = 17408, PR_RHS = 34816, PR_LM = 104448, PR_G = 121856, PR_B = 122112, PR_CW = 122368, PR_DP = 128512;
#define LBAR() asm volatile("s_waitcnt lgkmcnt(0)\n\ts_barrier" ::: "memory")
__device__ __forceinline__ void prep_phase(LAS unsigned char* lds, bf16_t* R0, const float* ab, const bf16_t* halo, const float* convw, const float* a_log, const float* dt_bias,
                                           bf16_t* KT, bf16_t* PT, float* Eg, bf16_t* Oq, bf16_t* Ow, bf16_t* Ou, int tid, int wid, int lane) {
    LAS unsigned char* qs = lds + PR_QS; LAS unsigned char* ks = lds + PR_KS; LAS float* rhs = (LAS float*)(lds + PR_RHS); LAS float* Lm = (LAS float*)(lds + PR_LM);
    LAS float* Gs = (LAS float*)(lds + PR_G); LAS float* Bs = (LAS float*)(lds + PR_B); LAS float* cw = (LAS float*)(lds + PR_CW);
    int cw_head = -1;
    float pa, pb; { const int u0 = (int)blockIdx.x < BATCH * NCH * 8 ? (int)blockIdx.x : 0; pa = ab[(size_t)((u0 >> 3) * 64 + lane) * 16 + (u0 & 7)]; pb = ab[(size_t)((u0 >> 3) * 64 + lane) * 16 + 8 + (u0 & 7)]; }
#pragma unroll 1
    for (int unit = blockIdx.x; unit < BATCH * NCH * 8; unit += gridDim.x) {
        const int h = unit & 7, row0 = (unit >> 3) * 64, nchunk = (unit >> 3) & 31;
        const bool restaged = (h != cw_head);
        if (h != cw_head) {
            for (int i = tid; i < 4 * 3 * 128; i += 512) { const int tap = i / 384, rem = i % 384; cw[i] = convw[(size_t)tap * 3072 + (rem >> 7) * 1024 + h * 128 + (rem & 127)]; }
            cw_head = h;
        }
        {
            const float a = pa, bt = pb;
            { const int un = unit + (int)gridDim.x < BATCH * NCH * 8 ? unit + (int)gridDim.x : unit; pa = ab[(size_t)((un >> 3) * 64 + lane) * 16 + (un & 7)]; pb = ab[(size_t)((un >> 3) * 64 + lane) * 16 + 8 + (un & 7)]; }
            const float x = a + dt_bias[h]; const float sp = x > 20.f ? x : __logf(1.f + __expf(x)); float g = -__expf(a_log[h]) * sp;
#pragma unroll
            for (int o = 1; o < 64; o <<= 1) { const float y = __shfl_up(g, o); if (lane >= o) g += y; }
            Gs[lane] = g; Bs[lane] = 1.f / (1.f + __expf(-bt)); if (wid == 0 && lane == 63) Eg[unit] = __expf(g);
        }
        if (restaged) LBAR(); else asm volatile("s_waitcnt lgkmcnt(0)" ::: "memory");
        {
            const int t = tid >> 3, c0 = (tid & 7) * 16; const float beta = Bs[t], eg = __expf(Gs[t]);
#pragma unroll
            for (int mat = 0; mat < 3; ++mat) {
                const bf16_t* src = R0 + (size_t)mat * SLOTE; float acc[16];
#pragma unroll
                for (int j = 0; j < 16; ++j) acc[j] = 0.f;
#pragma unroll
                for (int i = 0; i < 4; ++i) { const int tt = t - 3 + i; u32x4 x0 = {0u, 0u, 0u, 0u}, x1 = {0u, 0u, 0u, 0u};
                    if (tt >= 0) { const bf16_t* p = src + (size_t)(row0 + tt) * DM + h * 128 + c0; x0 = *(const u32x4*)p; x1 = *(const u32x4*)(p + 8); }
                    else if (nchunk > 0) { const bf16_t* p = halo + (size_t)(((row0 >> 6) - 1) * 3 + (3 + tt)) * 3072 + mat * 1024 + h * 128 + c0; x0 = *(const u32x4*)p; x1 = *(const u32x4*)(p + 8); }
                    const LAS f32x4* wp = (const LAS f32x4*)(cw + i * 384 + mat * 128 + c0); const f32x4 w0 = wp[0], w1 = wp[1], w2 = wp[2], w3 = wp[3];
                    acc[0] += w0.x * bflo(x0.x); acc[1] += w0.y * bfhi(x0.x); acc[2] += w0.z * bflo(x0.y); acc[3] += w0.w * bfhi(x0.y);
                    acc[4] += w1.x * bflo(x0.z); acc[5] += w1.y * bfhi(x0.z); acc[6] += w1.z * bflo(x0.w); acc[7] += w1.w * bfhi(x0.w);
                    acc[8] += w2.x * bflo(x1.x); acc[9] += w2.y * bfhi(x1.x); acc[10] += w2.z * bflo(x1.y); acc[11] += w2.w * bfhi(x1.y);
                    acc[12] += w3.x * bflo(x1.z); acc[13] += w3.y * bfhi(x1.z); acc[14] += w3.z * bflo(x1.w); acc[15] += w3.w * bfhi(x1.w); }
                float ss = 0.f;
#pragma unroll
                for (int j = 0; j < 16; ++j) { acc[j] = siluf_(acc[j]); ss += acc[j] * acc[j]; }
                if (mat < 2) {
                    ss += __shfl_xor(ss, 1); ss += __shfl_xor(ss, 2); ss += __shfl_xor(ss, 4);
                    const float rn = rsqrtf(ss + EPS) * (mat == 0 ? 0.08838834764831845f : 1.f);
#pragma unroll
                    for (int j = 0; j < 16; ++j) acc[j] *= rn;
                    u32x4 w0, w1; w0.x = pk2(acc[0], acc[1]); w0.y = pk2(acc[2], acc[3]); w0.z = pk2(acc[4], acc[5]); w0.w = pk2(acc[6], acc[7]);
                    w1.x = pk2(acc[8], acc[9]); w1.y = pk2(acc[10], acc[11]); w1.z = pk2(acc[12], acc[13]); w1.w = pk2(acc[14], acc[15]);
                    LAS unsigned char* d = (mat == 0 ? qs : ks) + t * 272 + c0 * 2; *(LAS u32x4*)d = w0; *(LAS u32x4*)(d + 16) = w1;
                }
                if (mat >= 1) { const float sc = (mat == 1) ? beta * eg : beta; LAS float* d = rhs + t * RP + (mat == 1 ? 128 : 0) + c0;
#pragma unroll
                    for (int j4 = 0; j4 < 4; ++j4) *(LAS f32x4*)(d + 4 * j4) = (f32x4){acc[4 * j4] * sc, acc[4 * j4 + 1] * sc, acc[4 * j4 + 2] * sc, acc[4 * j4 + 3] * sc}; }
            }
        }
        LBAR();
        {
            const int mtx = wid >> 2, ti = wid & 3, r = lane & 15, quad = lane >> 4; const LAS unsigned char* Ab = mtx ? qs : ks;
#pragma unroll
            for (int tj = 0; tj < 4; ++tj) { f32x4 c = {0.f, 0.f, 0.f, 0.f};
#pragma unroll
                for (int s = 0; s < 4; ++s) { const bf16x8 a = *(const LAS bf16x8*)(Ab + (16 * ti + r) * 272 + (32 * s + quad * 8) * 2); const bf16x8 b = *(const LAS bf16x8*)(ks + (16 * tj + r) * 272 + (32 * s + quad * 8) * 2); c = MFMA16(a, b, c); }
#pragma unroll
                for (int jj = 0; jj < 4; ++jj) { const int t = 16 * ti + quad * 4 + jj, col = 16 * tj + r; const float dec = (col <= t) ? __expf(Gs[t] - Gs[col]) : 0.f;
                    if (mtx == 0) Lm[t * LP + col] = (col < t) ? -(Bs[t] * c[jj] * dec) : 0.f;
                    else PT[(size_t)unit * 4096 + t * 64 + col] = (bf16_t)(pk2(c[jj] * dec, 0.f) & 0xffffu); }
            }
            if (mtx == 0 && lane < 16) {
                float d[16]; const LAS float* Lb = Lm + (16 * ti) * LP + 16 * ti; LAS float* DP = (LAS float*)(lds + PR_DP) + ti * 256 + (lane & 3) * 64 + (lane >> 2) * 16;
                f32x4 rc[4], rn[4];
#pragma unroll
                for (int q = 0; q < 4; ++q) { rc[q] = *(const LAS f32x4*)(Lb + 1 * LP + 4 * q); rn[q] = rc[q]; }
                d[0] = (lane == 0) ? 1.f : 0.f; DP[0] = d[0];
#pragma unroll
                for (int rr = 1; rr < 16; ++rr) {
                    if (rr < 15) {
#pragma unroll
                        for (int q = 0; q < 4; ++q) if (4 * q < rr + 1) rn[q] = *(const LAS f32x4*)(Lb + (rr + 1) * LP + 4 * q); }
                    float a0 = (rr == lane) ? 1.f : 0.f, a1 = 0.f;
#pragma unroll
                    for (int k = 0; k < rr; ++k) { if (k & 1) a1 += rc[k >> 2][k & 3] * d[k]; else a0 += rc[k >> 2][k & 3] * d[k]; }
                    d[rr] = a0 + a1; DP[rr] = d[rr];
#pragma unroll
                    for (int q = 0; q < 4; ++q) rc[q] = rn[q];
                }
            }
        }
        LBAR();
        {
            const int r = lane & 15, quad = lane >> 4; const LAS float* DPb = (const LAS float*)(lds + PR_DP);
#pragma unroll 1
            for (int I = 0; I < 4; ++I) {
                f32x4 C0, C1; LAS float* x0 = rhs + (16 * I + 4 * quad) * RP + wid * 32 + r; LAS float* x1 = x0 + 16;
#pragma unroll
                for (int jj = 0; jj < 4; ++jj) { C0[jj] = x0[jj * RP]; C1[jj] = x1[jj * RP]; }
#pragma unroll 2
                for (int j0 = 0; j0 < 16 * I; j0 += 4) { const float a = Lm[(16 * I + r) * LP + j0 + quad]; const LAS float* bp = rhs + (j0 + quad) * RP + wid * 32 + r;
                    C0 = __builtin_amdgcn_mfma_f32_16x16x4f32(a, bp[0], C0, 0, 0, 0); C1 = __builtin_amdgcn_mfma_f32_16x16x4f32(a, bp[16], C1, 0, 0, 0); }
                f32x4 X0 = {0.f, 0.f, 0.f, 0.f}, X1 = {0.f, 0.f, 0.f, 0.f};
#pragma unroll
                for (int sx = 0; sx < 4; ++sx) { const float a = DPb[I * 256 + sx * 64 + quad * 16 + r];
                    X0 = __builtin_amdgcn_mfma_f32_16x16x4f32(a, C0[sx], X0, 0, 0, 0); X1 = __builtin_amdgcn_mfma_f32_16x16x4f32(a, C1[sx], X1, 0, 0, 0); }
#pragma unroll
                for (int jj = 0; jj < 4; ++jj) { x0[jj * RP] = X0[jj]; x1[jj * RP] = X1[jj]; }
            }
        }
        {
#pragma unroll
            for (int k = 0; k < 2; ++k) { const int p = tid + 512 * k, t = p >> 4, c8 = (p & 15) * 8; const u32x4 v = *(const LAS u32x4*)(qs + t * 272 + c8 * 2); const float eg = __expf(Gs[t]);
                u32x4 w; w.x = pk2(bflo(v.x) * eg, bfhi(v.x) * eg); w.y = pk2(bflo(v.y) * eg, bfhi(v.y) * eg); w.z = pk2(bflo(v.z) * eg, bfhi(v.z) * eg); w.w = pk2(bflo(v.w) * eg, bfhi(v.w) * eg);
                *(u32x4*)(Oq + (size_t)(row0 + t) * DM + h * 128 + c8) = w; }
            const int dk = tid & 127, qtr = tid >> 7; const float g63 = Gs[63];
#pragma unroll
            for (int tg = 0; tg < 2; ++tg) { float v[8];
#pragma unroll
                for (int i = 0; i < 8; ++i) { const int t = 16 * qtr + 8 * tg + i; v[i] = bf2f(*(const LAS unsigned short*)(ks + t * 272 + dk * 2)) * __expf(g63 - Gs[t]); }
                u32x4 w; w.x = pk2(v[0], v[1]); w.y = pk2(v[2], v[3]); w.z = pk2(v[4], v[5]); w.w = pk2(v[6], v[7]);
                *(u32x4*)(KT + (size_t)unit * 8192 + dk * 64 + 16 * qtr + 8 * tg) = w; }
        }
        LBAR();
#pragma unroll
        for (int k = 0; k < 4; ++k) { const int p = tid + 512 * k, t = p >> 5, c8 = (p & 31) * 8; const f32x4 v0 = *(const LAS f32x4*)(rhs + t * RP + c8), v1 = *(const LAS f32x4*)(rhs + t * RP + c8 + 4);
            const float sg = (c8 < 128) ? 1.f : -1.f; u32x4 w; w.x = pk2(v0.x * sg, v0.y * sg); w.y = pk2(v0.z * sg, v0.w * sg); w.z = pk2(v1.x * sg, v1.y * sg); w.w = pk2(v1.z * sg, v1.w * sg);
            bf16_t* dst = (c8 < 128) ? (Ou + (size_t)(row0 + t) * DM + h * 128 + c8) : (Ow + (size_t)(row0 + t) * DM + h * 128 + (c8 - 128));
            *(u32x4*)dst = w; }
        LBAR();
    }
}
constexpr int SC_W = 0, SC_Q = 17408, SC_P = 34816, SC_K = 44032, SC_U = 62464, SC_BUF = 66560;
__device__ __forceinline__ bf16x8 afrag(const LAS unsigned char* p) { const u32x2 lo = *(const LAS u32x2*)p; const u32x2 hi = *(const LAS u32x2*)(p + 32); const u32x4 v = {lo.x, lo.y, hi.x, hi.y}; return __builtin_bit_cast(bf16x8, v); }
__device__ __forceinline__ bf16x8 packB(const f32x4 a, const f32x4 b) { const u32x4 v = {pk2(a.x, a.y), pk2(a.z, a.w), pk2(b.x, b.y), pk2(b.z, b.w)}; return __builtin_bit_cast(bf16x8, v); }
__device__ __forceinline__ void scan_phase(LAS unsigned char* lds, bf16_t* R0, const bf16_t* KT, const bf16_t* PT, const float* Eg, bf16_t* Odst, int tid, int wid, int lane) {
    const int r = lane & 15, quad = lane >> 4;
    const int vcu = (gridDim.x % 8 == 0) ? (int)((blockIdx.x & 7) * (gridDim.x >> 3) + (blockIdx.x >> 3)) : (int)blockIdx.x;
    for (int task = vcu; task < 256; task += gridDim.x) {
        const int bh = task >> 2, dvq = task & 3, b = bh >> 3, h = bh & 7, dv16 = dvq * 32 + (wid & 1) * 16;
        const bf16_t* Wsrc = R0 + SLOTE; const bf16_t* Qsrc = R0; const bf16_t* Usrc = R0 + 2 * SLOTE;
        if (wid < 2) {
            f32x4 S[8];
#pragma unroll
            for (int d = 0; d < 8; ++d) S[d] = (f32x4){0.f, 0.f, 0.f, 0.f};
            float en = Eg[(size_t)((b * NCH + 0) * 8 + h)];
            __syncthreads();
#pragma unroll 1
            for (int n = 0; n < NCH; ++n) {
                f32x4 U[4], O[4]; const float ec = en; int rq = quad * 4 * DM + h * 128 + dv16 + r; asm volatile("" : "+v"(rq));
                const LAS unsigned char* B_ = lds + (n & 1) * SC_BUF; const int row0 = (b * NCH + n) * 64;
#pragma unroll
                for (int m = 0; m < 4; ++m) { const LAS unsigned short* up = (const LAS unsigned short*)(B_ + SC_U + (16 * m + quad * 4) * 64 + ((wid & 1) * 16 + r) * 2);
                    U[m] = (f32x4){bf2f(up[0]), bf2f(up[32]), bf2f(up[64]), bf2f(up[96])}; }
                if (n + 1 < NCH) en = Eg[(size_t)((b * NCH + n + 1) * 8 + h)];
                bf16x8 Sb[4];
#pragma unroll
                for (int s = 0; s < 4; ++s) Sb[s] = packB(S[2 * s], S[2 * s + 1]);
#pragma unroll
                for (int m = 0; m < 4; ++m) O[m] = (f32x4){0.f, 0.f, 0.f, 0.f};
#define SBAR_ __builtin_amdgcn_sched_barrier(0)
#define LM(m, fw, fq) do { _Pragma("unroll") for (int s = 0; s < 4; ++s) { fw[s] = afrag(B_ + SC_W + (16 * (m) + r) * 272 + (32 * s + quad * 4) * 2); fq[s] = afrag(B_ + SC_Q + (16 * (m) + r) * 272 + (32 * s + quad * 4) * 2); } } while (0)
#define MM(m, fw, fq) do { _Pragma("unroll") for (int s = 0; s < 4; ++s) { U[m] = MFMA16(fw[s], Sb[s], U[m]); O[m] = MFMA16(fq[s], Sb[s], O[m]); } } while (0)
                bf16x8 fwa[4], fqa[4], fwb[4], fqb[4], fp[8], fk[8];
                LM(0, fwa, fqa);
                LM(1, fwb, fqb); SBAR_; MM(0, fwa, fqa); SBAR_;
                LM(2, fwa, fqa); SBAR_; MM(1, fwb, fqb); SBAR_;
                LM(3, fwb, fqb); SBAR_; MM(2, fwa, fqa); SBAR_;
#pragma unroll
                for (int m = 0; m < 4; ++m)
#pragma unroll
                    for (int s = 0; s < 2; ++s) fp[m * 2 + s] = afrag(B_ + SC_P + (16 * m + r) * 144 + (32 * s + quad * 4) * 2);
                SBAR_; MM(3, fwb, fqb); SBAR_;
                bf16x8 Ub[2]; Ub[0] = packB(U[0], U[1]); Ub[1] = packB(U[2], U[3]);
#pragma unroll
                for (int d = 0; d < 4; ++d)
#pragma unroll
                    for (int s = 0; s < 2; ++s) fk[d * 2 + s] = afrag(B_ + SC_K + (16 * d + r) * 144 + (32 * s + quad * 4) * 2);
                SBAR_;
#pragma unroll
                for (int m = 0; m < 4; ++m)
#pragma unroll
                    for (int s = 0; s < 2; ++s) O[m] = MFMA16(fp[m * 2 + s], Ub[s], O[m]);
                SBAR_;
#pragma unroll
                for (int d = 0; d < 4; ++d)
#pragma unroll
                    for (int s = 0; s < 2; ++s) fp[d * 2 + s] = afrag(B_ + SC_K + (16 * (d + 4) + r) * 144 + (32 * s + quad * 4) * 2);
                SBAR_;
#pragma unroll
                for (int d = 0; d < 4; ++d) { S[d] = S[d] * ec;
#pragma unroll
                    for (int s = 0; s < 2; ++s) S[d] = MFMA16(fk[d * 2 + s], Ub[s], S[d]); }
                SBAR_;
#pragma unroll
                for (int d = 0; d < 4; ++d) { S[d + 4] = S[d + 4] * ec;
#pragma unroll
                    for (int s = 0; s < 2; ++s) S[d + 4] = MFMA16(fp[d * 2 + s], Ub[s], S[d + 4]); }
#undef LM
#undef MM
#undef SBAR_
#pragma unroll
                for (int m = 0; m < 4; ++m)
#pragma unroll
                    for (int jj = 0; jj < 4; ++jj) Odst[(size_t)(row0 + 16 * m + jj) * DM + rq] = (bf16_t)(pk2(O[m][jj], 0.f) & 0xffffu);
                __syncthreads();
            }
        } else {
            const int lt = tid - 128;
            u32x4 pfa[10], pfb[10];
#define SC_LOAD(n, pf) do { const int row0_ = (b * NCH + (n)) * 64; const size_t unit_ = (size_t)((b * NCH + (n)) * 8 + h); \
                int lt_ = lt; asm volatile("" : "+v"(lt_)); _Pragma("unroll") for (int k = 0; k < 10; ++k) { const int p = lt_ + 384 * k; const bf16_t* src; \
                    if (p < 2048) { const int q = p & 1023; src = (p < 1024 ? Wsrc : Qsrc) + (size_t)(row0_ + (q >> 4)) * DM + h * 128 + (q & 15) * 8; } \
                    else if (p < 2560) src = PT + unit_ * 4096 + (size_t)(p - 2048) * 8; \
                    else if (p < 3584) src = KT + unit_ * 8192 + (size_t)(p - 2560) * 8; \
                    else { const int q = p - 3584; src = Usrc + (size_t)(row0_ + (q >> 2)) * DM + h * 128 + dvq * 32 + (q & 3) * 8; } \
                    pf[k] = *(const u32x4*)src; } } while (0)
#define SC_STORE(buf, pf) do { LAS unsigned char* B_ = lds + (buf) * SC_BUF; \
                int lt_ = lt; asm volatile("" : "+v"(lt_)); _Pragma("unroll") for (int k = 0; k < 10; ++k) { const int p = lt_ + 384 * k; int off; \
                    if (p < 2048) { const int q = p & 1023; off = (p < 1024 ? SC_W : SC_Q) + (q >> 4) * 272 + (q & 15) * 16; } \
                    else if (p < 2560) { const int q = p - 2048; off = SC_P + (q >> 3) * 144 + (q & 7) * 16; } \
                    else if (p < 3584) { const int q = p - 2560; off = SC_K + (q >> 3) * 144 + (q & 7) * 16; } \
                    else { const int q = p - 3584; off = SC_U + (q >> 2) * 64 + (q & 3) * 16; } \
                    *(LAS u32x4*)(B_ + off) = pf[k]; } } while (0)
            SC_LOAD(0, pfa); SC_STORE(0, pfa); SC_LOAD(1, pfb);
            __syncthreads();
#pragma unroll 1
            for (int n = 0; n < NCH; n += 2) {
                if (n + 2 < NCH) SC_LOAD(n + 2, pfa);
                SC_STORE(1, pfb);
                __syncthreads();
                if (n + 3 < NCH) SC_LOAD(n + 3, pfb);
                if (n + 2 < NCH) SC_STORE(0, pfa);
                __syncthreads();
            }
#undef SC_LOAD
#undef SC_STORE
        }
    }
}

__device__ __forceinline__ int crow(int reg, int h) { return (reg & 3) + 8 * (reg >> 2) + 4 * h; }
__device__ __forceinline__ bf16x8 pack8(const f32x16& p, int s) { const u32x4 v = {pk2(p[8 * s], p[8 * s + 1]), pk2(p[8 * s + 2], p[8 * s + 3]), pk2(p[8 * s + 4], p[8 * s + 5]), pk2(p[8 * s + 6], p[8 * s + 7])}; return __builtin_bit_cast(bf16x8, v); }
__device__ __forceinline__ bf16x8 vfrag(const LAS unsigned char* p) { const u32x2 lo = *(const LAS u32x2*)p; const u32x2 hi = *(const LAS u32x2*)(p + 16); const u32x4 v = {lo.x, lo.y, hi.x, hi.y}; return __builtin_bit_cast(bf16x8, v); }
constexpr int BA_K = 0, BA_V = 18432, BA_T = 36864;
__device__ __forceinline__ void band_phase(LAS unsigned char* lds, const bf16_t* Qb, const bf16_t* Kb, const bf16_t* Vb, bf16_t* Ob, const float* rel_bias, int tid, int wid, int lane) {
    const int r = lane & 31, h5 = lane >> 5; LAS float* btab = (LAS float*)(lds + BA_T);
    const int vcu = (gridDim.x % 8 == 0) ? (int)((blockIdx.x & 7) * (gridDim.x >> 3) + (blockIdx.x >> 3)) : (int)blockIdx.x;
    for (int uu = vcu * 4; uu < 1024; uu += gridDim.x * 4)
    for (int ui = 0; ui < 4; ++ui) {
        const int bhh = uu >> 3, b = bhh >> 4, h = bhh & 15, odd = (uu >> 2) & 1; const int qblk = odd ? ((ui == 0) ? 1 : (ui == 1) ? 2 : (ui == 2) ? 5 : 6) : ((ui == 0) ? 0 : (ui == 1) ? 3 : (ui == 2) ? 4 : 7);
        const int rowb = b * SEQ, c_first = (4 * qblk - 8) > 0 ? (4 * qblk - 8) : 0, ntile = 4 * qblk + 4 - c_first;
        const int nq = 4 * qblk + (wid >> 1), qi = 32 * (wid & 1) + r; const int q0 = rowb + 256 * qblk + 32 * wid;
        if (tid < 384) { int rel = 319 - tid; rel = rel < -63 ? -63 : (rel > 256 ? 256 : rel); btab[tid] = rel_bias[h * 320 + rel + 63] * LOG2E; }
        bf16x8 qf[4];
#pragma unroll
        for (int d0 = 0; d0 < 4; ++d0) qf[d0] = *(const bf16x8*)(Qb + (size_t)(q0 + r) * DM + h * 64 + 16 * d0 + 8 * h5);
        u32x4 kreg, vreg; const int skey = tid >> 3, sc8 = tid & 7;
#define BA_LOAD(c) do { const size_t o_ = (size_t)(rowb + 64 * (c) + skey) * DM + h * 64 + sc8 * 8; kreg = *(const u32x4*)(Kb + o_); vreg = *(const u32x4*)(Vb + o_); } while (0)
#define BA_STORE(buf) do { *(LAS u32x4*)(lds + BA_K + (buf) * 9216 + skey * 144 + sc8 * 16) = kreg; LAS unsigned char* v_ = lds + BA_V + (buf) * 9216 + (sc8 * 8) * 136 + skey * 2; \
            *(LAS unsigned short*)(v_) = (unsigned short)kregv(vreg.x, 0); *(LAS unsigned short*)(v_ + 136) = (unsigned short)kregv(vreg.x, 1); *(LAS unsigned short*)(v_ + 272) = (unsigned short)kregv(vreg.y, 0); *(LAS unsigned short*)(v_ + 408) = (unsigned short)kregv(vreg.y, 1); \
            *(LAS unsigned short*)(v_ + 544) = (unsigned short)kregv(vreg.z, 0); *(LAS unsigned short*)(v_ + 680) = (unsigned short)kregv(vreg.z, 1); *(LAS unsigned short*)(v_ + 816) = (unsigned short)kregv(vreg.w, 0); *(LAS unsigned short*)(v_ + 952) = (unsigned short)kregv(vreg.w, 1); } while (0)
#define kregv(w, hi) ((hi) ? ((w) >> 16) : ((w) & 0xffffu))
        BA_LOAD(c_first); BA_STORE(0);
        float m_run = -1e30f, l_run = 0.f; f32x16 O[2];
#pragma unroll
        for (int i = 0; i < 16; ++i) { O[0][i] = 0.f; O[1][i] = 0.f; }
        __syncthreads();
        for (int ti = 0; ti < ntile; ++ti) {
            const int c = c_first + ti;
            if (ti + 1 < ntile) BA_LOAD(c + 1);
            if (c >= nq - 8 && c <= nq) {
                const LAS unsigned char* Kt = lds + BA_K + (ti & 1) * 9216; const LAS unsigned char* Vt = lds + BA_V + (ti & 1) * 9216;
                f32x16 P0, P1;
#pragma unroll
                for (int i = 0; i < 16; ++i) { P0[i] = 0.f; P1[i] = 0.f; }
#pragma unroll
                for (int d0 = 0; d0 < 4; ++d0) { const bf16x8 a0 = *(const LAS bf16x8*)(Kt + r * 144 + (16 * d0 + 8 * h5) * 2); const bf16x8 a1 = *(const LAS bf16x8*)(Kt + (32 + r) * 144 + (16 * d0 + 8 * h5) * 2);
                    P0 = MFMA32(a0, qf[d0], P0); P1 = MFMA32(a1, qf[d0], P1); }
                const int dch = nq - c;
                if (dch >= 5) { const float bc = btab[0];
#pragma unroll
                    for (int i = 0; i < 16; ++i) { P0[i] += bc; P1[i] += bc; } }
                else {
                    const LAS float* bp = btab + (319 - dch * 64 - qi + 4 * h5);
#pragma unroll
                    for (int i = 0; i < 16; ++i) { P0[i] += bp[(i & 3) + 8 * (i >> 2)]; P1[i] += bp[(i & 3) + 8 * (i >> 2) + 32]; } }
                float mx = P0[0];
#pragma unroll
                for (int i = 0; i < 16; ++i) { mx = fmaxf(mx, P0[i]); mx = fmaxf(mx, P1[i]); }
                mx = fmaxf(mx, __shfl_xor(mx, 32));
                const float m_new = fmaxf(m_run, mx), alpha = __builtin_amdgcn_exp2f(m_run - m_new); m_run = m_new;
                float ls = 0.f;
#pragma unroll
                for (int i = 0; i < 16; ++i) { P0[i] = __builtin_amdgcn_exp2f(P0[i] - m_new); P1[i] = __builtin_amdgcn_exp2f(P1[i] - m_new); ls += P0[i] + P1[i]; }
                l_run = l_run * alpha + ls;
#pragma unroll
                for (int i = 0; i < 16; ++i) { O[0][i] *= alpha; O[1][i] *= alpha; }
#pragma unroll
                for (int p = 0; p < 2; ++p)
#pragma unroll
                    for (int s = 0; s < 2; ++s) { const bf16x8 pb = pack8(p ? P1 : P0, s);
#pragma unroll
                        for (int dt = 0; dt < 2; ++dt) O[dt] = MFMA32(vfrag(Vt + (32 * dt + r) * 136 + (32 * p + 16 * s + 4 * h5) * 2), pb, O[dt]); }
            }
            if (ti + 1 < ntile) BA_STORE((ti + 1) & 1);
            __syncthreads();
        }
        l_run += __shfl_xor(l_run, 32); const float inv = 1.f / l_run;
#pragma unroll
        for (int dt = 0; dt < 2; ++dt)
#pragma unroll
            for (int g = 0; g < 4; ++g) { u32x2 w; w.x = pk2(O[dt][4 * g] * inv, O[dt][4 * g + 1] * inv); w.y = pk2(O[dt][4 * g + 2] * inv, O[dt][4 * g + 3] * inv);
                *(u32x2*)(Ob + (size_t)(q0 + r) * DM + h * 64 + 32 * dt + 8 * g + 4 * h5) = w; }
#undef BA_LOAD
#undef BA_STORE
#undef kregv
    }
}

__device__ __forceinline__ void xattn_phase(LAS unsigned char* lds, const bf16_t* Qm, const bf16_t* KV, bf16_t* Om, int tid, int wid, int lane) {
    const int r = lane & 31, h5 = lane >> 5;
    const int vcu = (gridDim.x % 8 == 0) ? (int)((blockIdx.x & 7) * (gridDim.x >> 3) + (blockIdx.x >> 3)) : (int)blockIdx.x;
#define SBAR_ __builtin_amdgcn_sched_barrier(0)
    for (int unit = vcu; unit < 256; unit += gridDim.x) {
        const int b = unit >> 5, mh = (unit >> 3) & 3, qblk = unit & 7; const int q0 = b * SEQ + qblk * 256 + 32 * wid;
        const bf16_t* Kg = KV + (size_t)(b * 256) * 2048 + mh * 256; const bf16_t* Vg = Kg + 1024;
#pragma unroll 1
        for (int kb = 0; kb < 16; kb += 8) { u32x4 kst[8];
#pragma unroll
          for (int k = 0; k < 8; ++k) { const int p = tid + 512 * (kb + k), key = p >> 5, c = p & 31; kst[k] = *(const u32x4*)(Kg + (size_t)key * 2048 + c * 8); }
#pragma unroll
          for (int k = 0; k < 8; ++k) { const int p = tid + 512 * (kb + k), key = p >> 5, c = p & 31; *(LAS u32x4*)(lds + key * 528 + c * 16) = kst[k]; } }
        const bf16_t* qp = Qm + (size_t)(q0 + r) * DM + mh * 256 + 8 * h5;
        bf16x8 qa = *(const bf16x8*)(qp), qb = *(const bf16x8*)(qp + 16);
        __syncthreads();
        f32x16 Sx[8];
#pragma unroll
        for (int kt = 0; kt < 8; ++kt)
#pragma unroll
            for (int i = 0; i < 16; ++i) Sx[kt][i] = 0.f;
#define LK(d0, hf, kf) do { _Pragma("unroll") for (int kt = 0; kt < 4; ++kt) kf[kt] = *(const LAS bf16x8*)(lds + (32 * ((hf) * 4 + kt) + r) * 528 + (16 * (d0) + 8 * h5) * 2); } while (0)
#define MK(kf, hf, q) do { _Pragma("unroll") for (int kt = 0; kt < 4; ++kt) Sx[(hf) * 4 + kt] = MFMA32(kf[kt], q, Sx[(hf) * 4 + kt]); } while (0)
        bf16x8 kfa[4], kfb[4];
        LK(0, 0, kfa);
#pragma unroll 1
        for (int d0 = 0; d0 < 16; d0 += 2) {
            LK(d0, 1, kfb); SBAR_; MK(kfa, 0, qa); SBAR_;
            LK(d0 + 1, 0, kfa); SBAR_; MK(kfb, 1, qa); SBAR_;
            if (d0 + 2 < 16) qa = *(const bf16x8*)(qp + 16 * (d0 + 2));
            LK(d0 + 1, 1, kfb); SBAR_; MK(kfa, 0, qb); SBAR_;
            if (d0 + 2 < 16) LK(d0 + 2, 0, kfa);
            SBAR_; MK(kfb, 1, qb); SBAR_;
            if (d0 + 3 < 16) qb = *(const bf16x8*)(qp + 16 * (d0 + 3));
        }
#undef LK
#undef MK
        float mx = Sx[0][0];
#pragma unroll
        for (int kt = 0; kt < 8; ++kt)
#pragma unroll
            for (int i = 0; i < 16; ++i) mx = fmaxf(mx, Sx[kt][i]);
        mx = fmaxf(mx, __shfl_xor(mx, 32));
        float ls = 0.f;
#pragma unroll
        for (int kt = 0; kt < 8; ++kt)
#pragma unroll
            for (int i = 0; i < 16; ++i) { Sx[kt][i] = __builtin_amdgcn_exp2f(Sx[kt][i] - mx); ls += Sx[kt][i]; }
        ls += __shfl_xor(ls, 32); const float inv = 1.f / ls;
        bf16x8 Pb[16];
#pragma unroll
        for (int kt = 0; kt < 8; ++kt) { Pb[2 * kt] = pack8(Sx[kt], 0); Pb[2 * kt + 1] = pack8(Sx[kt], 1); }
        __syncthreads();
        {
            const int kh = wid & 1, cg4 = wid >> 1, k0 = 128 * kh + 2 * lane;
#pragma unroll 1
            for (int ib = 0; ib < 8; ib += 4) { u32x4 vsa[4], vsb[4];
#pragma unroll
              for (int i = 0; i < 4; ++i) { const int c = cg4 + 4 * (ib + i); vsa[i] = *(const u32x4*)(Vg + (size_t)k0 * 2048 + c * 8); vsb[i] = *(const u32x4*)(Vg + (size_t)(k0 + 1) * 2048 + c * 8); }
#pragma unroll
              for (int i = 0; i < 4; ++i) { const int c = cg4 + 4 * (ib + i); const u32x4 va = vsa[i], vb = vsb[i];
                LAS unsigned char* d = lds + (c * 8) * 536 + k0 * 2;
                *(LAS unsigned*)(d) = (va.x & 0xffffu) | (vb.x << 16); *(LAS unsigned*)(d + 536) = (va.x >> 16) | (vb.x & 0xffff0000u);
                *(LAS unsigned*)(d + 1072) = (va.y & 0xffffu) | (vb.y << 16); *(LAS unsigned*)(d + 1608) = (va.y >> 16) | (vb.y & 0xffff0000u);
                *(LAS unsigned*)(d + 2144) = (va.z & 0xffffu) | (vb.z << 16); *(LAS unsigned*)(d + 2680) = (va.z >> 16) | (vb.z & 0xffff0000u);
                *(LAS unsigned*)(d + 3216) = (va.w & 0xffffu) | (vb.w << 16); *(LAS unsigned*)(d + 3752) = (va.w >> 16) | (vb.w & 0xffff0000u); } }
        }
        __syncthreads();
#define LV(dt, k8, vf) do { _Pragma("unroll") for (int ks = 0; ks < 8; ++ks) vf[ks] = vfrag(lds + (32 * (dt) + r) * 536 + (16 * ((k8) * 8 + ks) + 4 * h5) * 2); } while (0)
        bf16x8 vfa[8], vfb[8];
        LV(0, 0, vfa);
#pragma unroll 1
        for (int dt = 0; dt < 8; ++dt) {
            f32x16 Oa;
#pragma unroll
            for (int i = 0; i < 16; ++i) Oa[i] = 0.f;
            LV(dt, 1, vfb); SBAR_;
#pragma unroll
            for (int ks = 0; ks < 8; ++ks) Oa = MFMA32(vfa[ks], Pb[ks], Oa);
            SBAR_;
            if (dt + 1 < 8) LV(dt + 1, 0, vfa);
            SBAR_;
#pragma unroll
            for (int ks = 0; ks < 8; ++ks) Oa = MFMA32(vfb[ks], Pb[8 + ks], Oa);
            SBAR_;
#pragma unroll
            for (int g = 0; g < 4; ++g) { u32x2 w; w.x = pk2(Oa[4 * g] * inv, Oa[4 * g + 1] * inv); w.y = pk2(Oa[4 * g + 2] * inv, Oa[4 * g + 3] * inv);
                *(u32x2*)(Om + (size_t)(q0 + r) * DM + mh * 256 + 32 * dt + 8 * g + 4 * h5) = w; }
        }
#undef LV
        __syncthreads();
    }
#undef SBAR_
}
#define XB_TMO      128
#define XB_XCNT(j)  (256  + 64 * (j))
#define XB_XSUB(j)  (1280 + 64 * (j))
#define XB_XGEN(j)  (2304 + 64 * (j))
#define XB_TOP      3328
#define XB_TOPGEN   3392
#define XCD_BAR_WORDS 3456
#define XB_SPIN_CAP (1u << 18)

__device__ __forceinline__ unsigned xb_ld(unsigned* p)              { return __hip_atomic_load(p, __ATOMIC_RELAXED, __HIP_MEMORY_SCOPE_AGENT); }
__device__ __forceinline__ unsigned xb_add(unsigned* p, unsigned v) { return __hip_atomic_fetch_add(p, v, __ATOMIC_RELAXED, __HIP_MEMORY_SCOPE_AGENT); }
__device__ __forceinline__ unsigned xb_xcc_id() { return (unsigned)__builtin_amdgcn_s_getreg((3 << 11) | 20) & 0xFu; }
#define XB_SPIN(cond, bar) do { unsigned _sp = 0; while (cond) { __builtin_amdgcn_s_sleep(1); \
    if ((++_sp & 255u) == 0u) { if (xb_ld(&(bar)[XB_TMO])) break; if (_sp > XB_SPIN_CAP) { atomicAdd(&(bar)[XB_TMO], 1u); break; } } } } while (0)

struct XcdBarrier {
    unsigned* bar; unsigned x;
    volatile LAS unsigned* st;
};

__device__ __forceinline__ XcdBarrier xcd_barrier_post(unsigned* bar, volatile LAS unsigned* st) {
    XcdBarrier b; b.bar = bar; b.x = xb_xcc_id(); b.st = st;
    if (threadIdx.x == 0) (void)xb_add(&bar[XB_XCNT(b.x)], 1u);
    return b;
}
__device__ __forceinline__ void xcd_barrier_complete(unsigned* bar, unsigned x, unsigned& nloc, unsigned& nx) {
    const unsigned G = gridDim.x * gridDim.y * gridDim.z;
    unsigned sum, cnt, mine, sp = 0u;
    for (;;) {
        sum = 0u; cnt = 0u; mine = 0u;
#pragma unroll
        for (unsigned j = 0; j < 16; ++j) { const unsigned c = xb_ld(&bar[XB_XCNT(j)]); sum += c; cnt += (c > 0u) ? 1u : 0u; mine = (j == x) ? c : mine; }
        if (sum == G) break;
        __builtin_amdgcn_s_sleep(1);
        if ((++sp & 255u) == 0u) { if (xb_ld(&bar[XB_TMO])) break; if (sp > XB_SPIN_CAP) { atomicAdd(&bar[XB_TMO], 1u); break; } }
    }
    nloc = mine > 0u ? mine : 1u; nx = cnt > 0u ? cnt : 1u;
}

__device__ __forceinline__ void xcd_barrier(const XcdBarrier& b) {
    asm volatile("s_waitcnt vmcnt(0)" ::: "memory");
    __syncthreads();
    if (threadIdx.x == 0) {
        unsigned* bar = b.bar;
        __builtin_amdgcn_s_waitcnt(0);
        unsigned nloc = b.st[0], nx = b.st[1];
        if (nloc == 0u) { xcd_barrier_complete(bar, b.x, nloc, nx); b.st[0] = nloc; b.st[1] = nx; }
        const unsigned old = xb_add(&bar[XB_XSUB(b.x)], 1u);
        const unsigned gen = old / nloc;
        if (old + 1u == (gen + 1u) * nloc) {
            __builtin_amdgcn_fence(__ATOMIC_RELEASE, "agent");
            asm volatile("s_waitcnt vmcnt(0)" ::: "memory");
            const unsigned og = xb_add(&bar[XB_TOP], 1u);
            const unsigned tg = og / nx;
            if (og + 1u == (tg + 1u) * nx) xb_add(&bar[XB_TOPGEN], 1u);
            else XB_SPIN(xb_ld(&bar[XB_TOPGEN]) == tg, bar);
            __builtin_amdgcn_fence(__ATOMIC_ACQUIRE, "agent");
            xb_add(&bar[XB_XGEN(b.x)], 1u);
            asm volatile("s_waitcnt vmcnt(0)" ::: "memory");
        } else {
            XB_SPIN(xb_ld(&bar[XB_XGEN(b.x)]) == gen, bar);
            __builtin_amdgcn_fence(__ATOMIC_ACQUIRE, "agent");
            asm volatile("s_waitcnt vmcnt(0)" ::: "memory");
        }
    }
    __syncthreads();
}
#ifndef PROBE_DUP_MASK
#define PROBE_DUP_MASK 0
#endif
#ifndef PROBE_EXTRA_SYNC
#define PROBE_EXTRA_SYNC 0
#endif
struct Args { Inputs in; float* out; unsigned char* ws; };
enum { PH_IN_A = 0, PH_MEMKV, PH_PREP, PH_SCAN, PH_IN_B, PH_BAND, PH_GA, PH_T, PH_GB, PH_Y, PH_WO, PH_QM, PH_XATTN, PH_WMO, PH_FFN, PH_DOWN, PH_CONV, PH_COUNT };
__global__ void __launch_bounds__(512, 2) fwd_megakernel(Args args) {
    extern __shared__ __attribute__((aligned(16))) unsigned char lds_raw[];
    cg::grid_group grid = cg::this_grid();
    LAS unsigned char* lds = (LAS unsigned char*)lds_raw;
    const int tid = threadIdx.x, lane = tid & 63, wid = __builtin_amdgcn_readfirstlane(tid >> 6);
    const int G = gridDim.x, gw = blockIdx.x * 8 + wid, NGW = G * 8;
    unsigned char* ws = as_global(args.ws); const Inputs& in = args.in;
    float* ssq = (float*)(ws + WS_SSQ); float* ab = (float*)(ws + WS_AB); bf16_t* halo = (bf16_t*)(ws + WS_HALO); float* Eg = (float*)(ws + WS_E); float* mssq = (float*)(ws + WS_MSSQ);
    bf16_t* memb = (bf16_t*)(ws + WS_MEMB); bf16_t* memkv = (bf16_t*)(ws + WS_MEMKV); bf16_t* Wt = (bf16_t*)(ws + WS_W); bf16_t* xb = (bf16_t*)(ws + WS_XB);
    bf16_t* R0 = (bf16_t*)(ws + WS_BIG); bf16_t* R1 = R0 + SLOTE; bf16_t* R2 = R0 + 2 * SLOTE; bf16_t* R3 = R0 + 3 * SLOTE; bf16_t* R4 = R0 + 4 * SLOTE; bf16_t* R5 = R0 + 5 * SLOTE;
    float* out = as_global(args.out);
    volatile LAS unsigned* bst = (volatile LAS unsigned*)(lds + LDS_BYTES - 64);
    if (threadIdx.x < 16) bst[threadIdx.x] = 0u;
    __syncthreads();
    XcdBarrier xbar = xcd_barrier_post((unsigned*)ws, bst);

    convert_phase(lds, in, Wt, 0, gw, NGW, wid, lane);
    rows_to_bf16(as_global(in.p[0]), xb, ssq, MROWS, gw, NGW, lane);
    rows_to_bf16(as_global(in.p[1]), memb, mssq, MEMROWS, gw, NGW, lane);
    grid.sync();

    for (int l = 0; l < DEPTH; ++l) {
        int rep_ = 0;
        for (int ph = 0; ph < PH_COUNT; ++ph) {
            if (ph == PH_CONV && l == DEPTH - 1) continue;
            const bool dupl = ((PROBE_DUP_MASK >> ph) & 1) && !((ph == PH_PREP || ph == PH_SCAN || ph == PH_BAND) && l != 0);
            unsigned char* ws = as_global(args.ws);
            float* ssq = (float*)(ws + WS_SSQ); float* ab = (float*)(ws + WS_AB); bf16_t* halo = (bf16_t*)(ws + WS_HALO); float* Eg = (float*)(ws + WS_E); float* mssq = (float*)(ws + WS_MSSQ);
            bf16_t* memb = (bf16_t*)(ws + WS_MEMB); bf16_t* memkv = (bf16_t*)(ws + WS_MEMKV); bf16_t* Wt = (bf16_t*)(ws + WS_W); bf16_t* xb = (bf16_t*)(ws + WS_XB);
            bf16_t* R0 = (bf16_t*)(ws + WS_BIG); bf16_t* R1 = R0 + SLOTE; bf16_t* R2 = R0 + 2 * SLOTE; bf16_t* R3 = R0 + 3 * SLOTE; bf16_t* R4 = R0 + 4 * SLOTE; bf16_t* R5 = R0 + 5 * SLOTE;
            int tid = threadIdx.x; asm volatile("" : "+v"(tid)); const int lane = tid & 63, wid = __builtin_amdgcn_readfirstlane(tid >> 6), gw = blockIdx.x * 8 + wid;
            int kind = -1;
            Gemm g{nullptr, nullptr, MROWS, 1024, 1024}; int cshift = 0;
            EpiIn ei{R0, -1, -1, ab, nullptr, ssq, 2}; EpiB eb{nullptr, DM, ssq, nullptr, nullptr, 0}; EpiRes er{out, out, xb, ssq};
            bool sync_after = true;
            switch (ph) {
                case PH_IN_A: kind = 0; g.A = xb; g.Bt = Wt + WO_IN; g.N = 4352; ei.act_slot = 3; ei.ab_tile = 16; ei.halo = halo; sync_after = false; break;
                case PH_MEMKV: kind = 1; g.A = memb; g.Bt = Wt + WO_MKV; g.M = MEMROWS; g.N = 2048; eb.O = memkv; eb.ldc = 2048; eb.ssq = mssq; eb.mode = 0; cshift = 192; break;
                case PH_IN_B: kind = 0; g.A = xb; g.Bt = Wt + WO_IN + (size_t)4352 * 1024; g.N = 3072; ei.slot2 = 4; break;
                case PH_GA: kind = 1; g.A = xb; g.Bt = Wt + WO_IN + (size_t)7424 * 1024; eb.O = R1; eb.mode = 1; sync_after = false; break;
                case PH_T: kind = 1; g.A = R3; g.Bt = Wt + WO_A; eb.O = R2; eb.g1 = R1; eb.mode = 2; sync_after = false; break;
                case PH_GB: kind = 1; g.A = xb; g.Bt = Wt + WO_IN + (size_t)8448 * 1024; eb.O = R1; eb.mode = 1; sync_after = false; break;
                case PH_Y: kind = 1; g.A = R0; g.Bt = Wt + WO_B; eb.O = R4; eb.g1 = R1; eb.t = R2; eb.mode = 3; break;
                case PH_WO: kind = 3; g.A = R4; g.Bt = Wt + WO_O; er.base = (l == 0) ? as_global(in.p[0]) : out; break;
                case PH_QM: kind = 1; g.A = xb; g.Bt = Wt + WO_MQ; eb.O = R0; eb.mode = 0; break;
                case PH_WMO: kind = 3; g.A = R1; g.Bt = Wt + WO_MO; break;
                case PH_FFN: kind = 2; g.A = xb; g.Bt = Wt + WO_GU; g.N = 2 * DFF; break;
                case PH_DOWN: kind = 3; g.A = R0; g.Bt = Wt + WO_DN; g.K = DFF; break;
                default: break;
            }
            if (kind >= 0) {
#ifndef SKIP_GEMM
                StaticOrder S; S.init(g.M, g.N, G, (int)((blockIdx.x + cshift) % G));
#ifndef SKIP_G0
                if (kind == 0) gemm_phase<EpiIn, StaticOrder, true, true>(lds, g, S, ei);
#endif
#ifndef SKIP_G1
                if (kind == 1) gemm_phase<EpiB, StaticOrder, true, true>(lds, g, S, eb);
#endif
#ifndef SKIP_G2
                if (kind == 2) { EpiFfn ef{R0, ssq}; gemm_phase<EpiFfn, StaticOrder, true, true>(lds, g, S, ef); }
#endif
#ifndef SKIP_G3
                if (kind == 3) gemm_phase<EpiRes, StaticOrder, true, true>(lds, g, S, er);
#endif
#endif
            } else if (ph == PH_PREP) {
                if (wid >= 4) __builtin_amdgcn_s_setprio(1);
#ifndef SKIP_PREP
                prep_phase(lds, R0, ab, halo, as_global(in.p[4]) + (size_t)l * 4 * 3072, as_global(in.p[5]) + l * 8, as_global(in.p[6]) + l * 8, R4, R5, Eg, (rep_ == 0 && dupl) ? (bf16_t*)out : R0, (rep_ == 0 && dupl) ? (bf16_t*)out + SLOTE : R1, (rep_ == 0 && dupl) ? (bf16_t*)out : R2, tid, wid, lane);
#endif
            } else if (ph == PH_SCAN) {
                if (wid < 2) __builtin_amdgcn_s_setprio(1);
#ifndef SKIP_SCAN
                scan_phase(lds, R0, R4, R5, Eg, (rep_ == 0 && dupl) ? (bf16_t*)out : R2, tid, wid, lane);
#endif
            } else if (ph == PH_BAND) {
                if (wid >= 4) __builtin_amdgcn_s_setprio(1);
                if (!(rep_ == 1)) oa_norm(R2, R3, as_global(in.p[7]) + l * 128, gw, NGW, lane);
#ifndef SKIP_BAND
                band_phase(lds, R0, R1, R4, (rep_ == 0 && dupl) ? (bf16_t*)out : R0, as_global(in.p[10]), tid, wid, lane);
#endif
            } else if (ph == PH_XATTN) {
#ifndef SKIP_XATTN
                xattn_phase(lds, R0, memkv, R1, tid, wid, lane);
#endif
            } else if (ph == PH_CONV) {
                convert_phase(lds, in, Wt, l + 1, gw, NGW, wid, lane);
            }
            if (kind < 0) __builtin_amdgcn_s_setprio(0);
            if (dupl && rep_ == 0) { rep_ = 1; --ph; continue; }
            rep_ = 0;
            if (sync_after) { xcd_barrier(xbar); for (int e_ = 0; e_ < PROBE_EXTRA_SYNC; ++e_) xcd_barrier(xbar); }
        }
    }
    final_norm(out, ssq, as_global(in.p[20]), gw, NGW, lane);
}

extern "C" void kernel_launch(void* const* d_in, const int* in_sizes, int n_in, void* d_out, int out_size, void* d_ws, size_t ws_size, hipStream_t stream) {
    static int grid = 0;
    if (grid == 0) {
        if (n_in != 21 || out_size != MROWS * DM || ws_size < WS_END) { fprintf(stderr, "kernel_launch: unexpected shapes (n_in %d out %d ws %zu)\n", n_in, out_size, ws_size); grid = -1; return; }
        int dev = 0, cus = 0, per_cu = 0;
        hipGetDevice(&dev); hipDeviceGetAttribute(&cus, hipDeviceAttributeMultiprocessorCount, dev);
        if (hipFuncSetAttribute((const void*)fwd_megakernel, hipFuncAttributeMaxDynamicSharedMemorySize, LDS_BYTES) != hipSuccess) { fprintf(stderr, "kernel_launch: hipFuncSetAttribute failed\n"); grid = -1; return; }
        if (hipOccupancyMaxActiveBlocksPerMultiprocessor(&per_cu, (const void*)fwd_megakernel, 512, LDS_BYTES) != hipSuccess || per_cu < 1) { fprintf(stderr, "kernel_launch: occupancy query says %d\n", per_cu); per_cu = 1; }
        (void)hipGetLastError();
        grid = cus * 1;
        if (grid > 256) grid = 256;
    }
    if (grid < 0) return;
    if (hipMemsetAsync(d_ws, 0, 16384, stream) != hipSuccess) { fprintf(stderr, "kernel_launch: memset failed\n"); return; }
    Args a{};
    for (int i = 0; i < 21; ++i) a.in.p[i] = (const float*)d_in[i];
    a.out = (float*)d_out; a.ws = (unsigned char*)d_ws;
    void* kargs[] = {&a};
    hipError_t e = hipLaunchCooperativeKernel((const void*)fwd_megakernel, dim3(grid), dim3(512), kargs, LDS_BYTES, stream);
    if (e != hipSuccess) fprintf(stderr, "cooperative launch failed: %s (grid %d)\n", hipGetErrorString(e), grid);
}
```

```cpp
#include <hip/hip_runtime.h>
#include <hip/hip_cooperative_groups.h>
#include <cstdio>
#include <cstdint>
namespace cg = cooperative_groups;
namespace pg8 {
#define PG8_LAS __attribute__((address_space(3)))
typedef unsigned short bf16_t;
typedef short bf16x8 __attribute__((ext_vector_type(8)));
typedef float f32x4 __attribute__((ext_vector_type(4)));
typedef unsigned u32x4 __attribute__((ext_vector_type(4)));
constexpr int BM = 256, BK = 64, HALF = 128, HTB = HALF * BK * 2  , STAGE_BYTES = 8 * HTB, NXCD = 8, WGM = 8;

__host__ __device__ __forceinline__ int lds_byte(int r, int c) { const int st = (r >> 4) * 2 + (c >> 5), rr = r & 15, cc = c & 31, ob = rr * 64 + cc * 2; return st * 1024 + (ob ^ (((ob >> 9) & 1) << 5)); }
__host__ __device__ __forceinline__ void stage_rc(int b, int& R, int& C) { const int st = b / 1024, sb = b % 1024, swz = sb ^ (((sb >> 9) & 1) << 5); R = (st >> 1) * 16 + swz / 64; C = (st & 1) * 32 + (swz % 64) / 2; }
__host__ __device__ __forceinline__ int perm32(int rho) { const int n = rho >> 4, i = rho & 15; return 8 * (i >> 2) + 4 * n + (i & 3); }

struct Unit { int pm, pn; };
struct Gemm { const bf16_t* A; const bf16_t* Bt; int M, N, K; };

struct StaticOrder {
    int nM, nN, nwg, G, c;
    __host__ __device__ void init(int M, int N, int G_, int c_) { nM = M / BM; nN = N / BM; nwg = nM * nN; G = G_; c = c_; }
    __host__ __device__ bool next(int i, Unit& u) const {
        const long L = (long)i * G + c; if (L >= nwg) return false;
        int wgid = (int)L; { const int q = nwg / NXCD, r = nwg % NXCD, xcd = wgid % NXCD, off = wgid / NXCD; wgid = (xcd < r ? xcd * (q + 1) : r * (q + 1) + (xcd - r) * q) + off; }
        const int nig = WGM * nN, gid = wgid / nig, fm = gid * WGM, gsz = (nM - fm) < WGM ? (nM - fm) : WGM;
        u.pm = fm + ((wgid % nig) % gsz); u.pn = (wgid % nig) / gsz; return true;
    }
    __device__ __forceinline__ void a_ready(const Unit&) const {}
    __device__ __forceinline__ void done(const Unit&) const {}
};

typedef float f32x2 __attribute__((ext_vector_type(2)));
typedef __bf16 bf16x2_t __attribute__((ext_vector_type(2)));
typedef unsigned u32x2 __attribute__((ext_vector_type(2)));
__device__ __forceinline__ unsigned pk2(float lo, float hi) { f32x2 v = {lo, hi}; bf16x2_t b = __builtin_convertvector(v, bf16x2_t); return __builtin_bit_cast(unsigned, b); }
template <class Epi, class Sched, bool ALIGN_EPI = false, bool SP2 = false>
__device__ __forceinline__ void gemm_phase(PG8_LAS unsigned char* lds, const Gemm g, const Sched& S, const Epi& E) {
    int tid_ = threadIdx.x; asm volatile("" : "+v"(tid_));
    const int tid = tid_, wid = __builtin_amdgcn_readfirstlane(tid >> 6), lane = tid & 63, wr = wid >> 2, wc = wid & 3, fr = lane & 15, fq = lane >> 4;
    const int K = g.K, nt = K / BK;
    unsigned voffA[2], voffB[2];
#pragma unroll
    for (int i = 0; i < 2; ++i) { int R, C; stage_rc(tid * 16 + i * 8192, R, C); const int Rb = Epi::PERM ? ((R & ~31) + perm32(R & 31)) : R;
        voffA[i] = (unsigned)(R * K + C) * 2u; voffB[i] = (unsigned)(Rb * K + C) * 2u; }
    const size_t kstep = (size_t)(BK * 2);
    const size_t hstep = (size_t)HALF * K * 2;
    const size_t tstep = 2 * hstep;
    const unsigned ldsw = (unsigned)wid * 1024u;
    const int aoff = lds_byte(wr * 64 + fr, fq * 8), boff = lds_byte(wc * 32 + fr, fq * 8);
#define PG8_SA(b, h) (((b) * 2 + (h)) * HTB)
#define PG8_SB(b, h) ((4 + (b) * 2 + (h)) * HTB)
#define PG8_STAGE(bufoff, gbase, voff) do { _Pragma("unroll") for (int _i = 0; _i < 2; ++_i) \
        __builtin_amdgcn_global_load_lds((const unsigned*)((const char*)(gbase) + (voff)[_i]), (PG8_LAS unsigned*)(lds + (bufoff) + ldsw + _i * 8192), 16, 0, 0); } while (0)
#define PG8_LDA(dst, b, h) do { _Pragma("unroll") for (int m = 0; m < 4; ++m) _Pragma("unroll") for (int k = 0; k < 2; ++k) dst[m][k] = *(const PG8_LAS bf16x8*)(lds + PG8_SA(b, h) + aoff + m * 2048 + k * 1024); } while (0)
#define PG8_LDB(dst, b, h) do { _Pragma("unroll") for (int n = 0; n < 2; ++n) _Pragma("unroll") for (int k = 0; k < 2; ++k) dst[n][k] = *(const PG8_LAS bf16x8*)(lds + PG8_SB(b, h) + boff + n * 2048 + k * 1024); } while (0)
#define PG8_MMA(ai, bj, At, Bt) do { __builtin_amdgcn_s_setprio(1); _Pragma("unroll") for (int m = 0; m < 4; ++m) _Pragma("unroll") for (int n = 0; n < 2; ++n) _Pragma("unroll") for (int k = 0; k < 2; ++k) \
        acc[ai][bj][m][n] = __builtin_amdgcn_mfma_f32_16x16x32_bf16(Bt[n][k], At[m][k], acc[ai][bj][m][n], 0, 0, 0); __builtin_amdgcn_s_setprio(0); } while (0)
#define PG8_WAIT_V(n) asm volatile("s_waitcnt vmcnt(" #n ")" ::: "memory")
#define PG8_WAIT_L(n) asm volatile("s_waitcnt lgkmcnt(" #n ")" ::: "memory")
#define PG8_BAR __builtin_amdgcn_s_barrier()
#define PG8_SCHED __builtin_amdgcn_sched_barrier(0)
    Unit cur, nxt; int ui = 0;
    if (!S.next(0, cur)) return;
    f32x4 acc[2][2][4][2];
#pragma unroll
    for (int a = 0; a < 2; ++a)
#pragma unroll
        for (int b = 0; b < 2; ++b)
#pragma unroll
            for (int m = 0; m < 4; ++m)
#pragma unroll
                for (int n = 0; n < 2; ++n) acc[a][b][m][n] = (f32x4){0.f, 0.f, 0.f, 0.f};
    bf16x8 At[4][2], B0[2][2], B1[2][2];
    const char* cA = (const char*)g.A + (size_t)cur.pm * tstep; const char* cB = (const char*)g.Bt + (size_t)cur.pn * tstep;
    S.a_ready(cur);
    if constexpr (SP2) {
        PG8_STAGE(PG8_SB(0, 0), cB, voffB); PG8_STAGE(PG8_SB(0, 1), cB + hstep, voffB); PG8_STAGE(PG8_SA(0, 0), cA, voffA); PG8_STAGE(PG8_SA(0, 1), cA + hstep, voffA);
        if (wr == 1) PG8_BAR;
        PG8_WAIT_V(2); PG8_BAR;
        PG8_STAGE(PG8_SB(1, 0), cB + kstep, voffB); PG8_STAGE(PG8_SA(1, 0), cA + kstep, voffA); PG8_STAGE(PG8_SB(1, 1), cB + hstep + kstep, voffB);
        PG8_WAIT_V(6); PG8_BAR;
    } else {
        PG8_STAGE(PG8_SB(0, 0), cB, voffB); PG8_STAGE(PG8_SA(0, 0), cA, voffA); PG8_STAGE(PG8_SB(0, 1), cB + hstep, voffB); PG8_STAGE(PG8_SA(0, 1), cA + hstep, voffA);
        if (wr == 1) PG8_BAR;
        PG8_WAIT_V(4); PG8_BAR;
        PG8_STAGE(PG8_SB(1, 0), cB + kstep, voffB); PG8_STAGE(PG8_SA(1, 0), cA + kstep, voffA); PG8_STAGE(PG8_SB(1, 1), cB + hstep + kstep, voffB);
        PG8_WAIT_V(6); PG8_BAR;
    }
    for (;;) {
        const bool has_next = S.next(ui + 1, nxt);
        const char* nA = has_next ? (const char*)g.A + (size_t)nxt.pm * tstep : cA; const char* nB = has_next ? (const char*)g.Bt + (size_t)nxt.pn * tstep : cB;
        for (int t = 0; t < nt; t += 2) {
            const bool last = (t == nt - 2);
            const char* a1 = cA + (size_t)(t + 1) * kstep;
            const char* a2 = last ? nA : cA + (size_t)(t + 2) * kstep; const char* b2 = last ? nB : cB + (size_t)(t + 2) * kstep;
            const char* a3 = a2 + kstep; const char* b3 = b2 + kstep;
            if (last && has_next) S.a_ready(nxt);
            if constexpr (SP2) {
            PG8_LDB(B0, 0, 0); PG8_LDB(B1, 0, 1); PG8_SCHED; PG8_LDA(At, 0, 0); PG8_STAGE(PG8_SA(1, 1), a1 + hstep, voffA);
            PG8_WAIT_V(8); PG8_WAIT_L(0); PG8_BAR; PG8_MMA(0, 0, At, B0); PG8_MMA(0, 1, At, B1); PG8_BAR; PG8_SCHED;
            PG8_LDA(At, 0, 1); PG8_STAGE(PG8_SB(0, 0), b2, voffB); PG8_STAGE(PG8_SB(0, 1), b2 + hstep, voffB); PG8_STAGE(PG8_SA(0, 0), a2, voffA);
            PG8_WAIT_V(8); PG8_WAIT_L(0); PG8_BAR; PG8_MMA(1, 0, At, B0); PG8_MMA(1, 1, At, B1); PG8_BAR; PG8_SCHED;
            PG8_LDB(B0, 1, 0); PG8_LDB(B1, 1, 1); PG8_SCHED; PG8_LDA(At, 1, 0); PG8_STAGE(PG8_SA(0, 1), a2 + hstep, voffA);
            PG8_WAIT_V(8); PG8_WAIT_L(0); PG8_BAR; PG8_MMA(0, 0, At, B0); PG8_MMA(0, 1, At, B1); PG8_BAR; PG8_SCHED;
            PG8_LDA(At, 1, 1); PG8_STAGE(PG8_SB(1, 0), b3, voffB); PG8_STAGE(PG8_SB(1, 1), b3 + hstep, voffB); PG8_STAGE(PG8_SA(1, 0), a3, voffA);
            PG8_WAIT_V(8); PG8_WAIT_L(0); PG8_BAR; PG8_MMA(1, 0, At, B0); PG8_MMA(1, 1, At, B1); PG8_BAR; PG8_SCHED;
            } else {
            PG8_LDB(B0, 0, 0); PG8_SCHED; PG8_LDA(At, 0, 0); PG8_STAGE(PG8_SA(1, 1), a1 + hstep, voffA);
            PG8_WAIT_L(8); PG8_BAR; PG8_WAIT_L(0); PG8_MMA(0, 0, At, B0); PG8_BAR; PG8_SCHED;
            PG8_LDB(B1, 0, 1); PG8_STAGE(PG8_SB(0, 0), b2, voffB);
            PG8_BAR; PG8_WAIT_L(0); PG8_MMA(0, 1, At, B1); PG8_BAR;
            PG8_LDA(At, 0, 1); PG8_STAGE(PG8_SA(0, 0), a2, voffA);
            PG8_BAR; PG8_WAIT_L(0); PG8_MMA(1, 0, At, B0); PG8_BAR; PG8_SCHED;
            PG8_STAGE(PG8_SB(0, 1), b2 + hstep, voffB);
            PG8_WAIT_V(6); PG8_BAR; PG8_MMA(1, 1, At, B1); PG8_BAR;
            PG8_LDB(B0, 1, 0); PG8_SCHED; PG8_LDA(At, 1, 0); PG8_STAGE(PG8_SA(0, 1), a2 + hstep, voffA);
            PG8_WAIT_L(8); PG8_BAR; PG8_WAIT_L(0); PG8_MMA(0, 0, At, B0); PG8_BAR; PG8_SCHED;
            PG8_LDB(B1, 1, 1); PG8_STAGE(PG8_SB(1, 0), b3, voffB);
            PG8_BAR; PG8_WAIT_L(0); PG8_MMA(0, 1, At, B1); PG8_BAR;
            PG8_LDA(At, 1, 1); PG8_STAGE(PG8_SA(1, 0), a3, voffA);
            PG8_BAR; PG8_WAIT_L(0); PG8_MMA(1, 0, At, B0); PG8_BAR; PG8_SCHED;
            PG8_STAGE(PG8_SB(1, 1), b3 + hstep, voffB);
            PG8_WAIT_V(6); PG8_BAR; PG8_MMA(1, 1, At, B1); PG8_BAR;
            }
        }
        if constexpr (ALIGN_EPI) { if (wr == 0) PG8_BAR; }
        if constexpr (!Epi::AFTER_DRAIN) { E(acc, cur, wr, wc, fr, fq); S.done(cur); }
        if (!has_next) break;
#pragma unroll
        for (int a = 0; a < 2; ++a)
#pragma unroll
            for (int b = 0; b < 2; ++b)
#pragma unroll
                for (int m = 0; m < 4; ++m)
#pragma unroll
                    for (int n = 0; n < 2; ++n) acc[a][b][m][n] = (f32x4){0.f, 0.f, 0.f, 0.f};
        cur = nxt; cA = nA; cB = nB; ++ui;
        if constexpr (ALIGN_EPI) { if (wr == 1) PG8_BAR; }
    }
    PG8_WAIT_V(0);
    if constexpr (!ALIGN_EPI) { if (wr == 0) PG8_BAR; }
    PG8_BAR;
    if constexpr (Epi::AFTER_DRAIN) { E.fused(acc, cur, wr, wc, fr, fq, lds, wid, lane); S.done(cur); }
#undef PG8_SA
#undef PG8_SB
#undef PG8_STAGE
#undef PG8_LDA
#undef PG8_LDB
#undef PG8_MMA
#undef PG8_WAIT_V
#undef PG8_WAIT_L
#undef PG8_BAR
#undef PG8_SCHED
}
}
using namespace pg8;
#define LAS __attribute__((address_space(3)))
#define GAS __attribute__((address_space(1)))
template <class T> __device__ __forceinline__ T* as_global(T* p) { return (T*)(GAS T*)p; }
typedef short s16x4 __attribute__((ext_vector_type(4)));
typedef float f32x16 __attribute__((ext_vector_type(16)));

constexpr int BATCH = 8, SEQ = 2048, DM = 1024, MROWS = BATCH * SEQ, DEPTH = 2, NCH = 32;
constexpr int DFF = 2816, NIN = 9232, NIN_PAD = 9472, MEMROWS = BATCH * 256;
constexpr float EPS = 1e-6f, LOG2E = 1.4426950408889634f;
constexpr float QB_SCALE = 0.125f * LOG2E, QM_SCALE = 0.0625f * LOG2E;
constexpr size_t MiB = 1u << 20, SLOTB = 32 * MiB, SLOTE = (size_t)MROWS * DM;
constexpr size_t WS_SSQ = 1 * MiB, WS_AB = 2 * MiB, WS_HALO = 3 * MiB, WS_E = 8 * MiB, WS_MSSQ = 8 * MiB + 65536;
constexpr size_t WS_MEMB = 12 * MiB, WS_MEMKV = 16 * MiB, WS_W = 24 * MiB, WS_XB = 76 * MiB, WS_BIG = 108 * MiB, WS_END = 284 * MiB;
constexpr size_t WO_IN = 0, WO_A = WO_IN + (size_t)NIN_PAD * 1024, WO_B = WO_A + 1048576, WO_O = WO_B + 1048576, WO_MQ = WO_O + 1048576,
                 WO_MKV = WO_MQ + 1048576, WO_MO = WO_MKV + 2097152, WO_GU = WO_MO + 1048576, WO_DN = WO_GU + (size_t)2 * DFF * 1024, WO_END = WO_DN + (size_t)DFF * 1024;
static_assert(WS_W + WO_END * 2 <= WS_XB, "weights fit");
constexpr int LDS_BYTES = 147456;

__device__ __forceinline__ float bf2f(unsigned short b) { return __uint_as_float((unsigned)b << 16); }
__device__ __forceinline__ float bflo(unsigned w) { return __uint_as_float(w << 16); }
__device__ __forceinline__ float bfhi(unsigned w) { return __uint_as_float(w & 0xffff0000u); }
__device__ __forceinline__ float sigmoidf_(float x) { return __builtin_amdgcn_rcpf(1.f + __expf(-x)); }
__device__ __forceinline__ float siluf_(float x) { return x * __builtin_amdgcn_rcpf(1.f + __expf(-x)); }
__device__ __forceinline__ float row_rstd(const float* ssq, int row) {
    const f32x4* p = (const f32x4*)(ssq + (size_t)row * 16); const f32x4 a = p[0], b = p[1], c = p[2], d = p[3];
    const float s = ((a.x + a.y) + (a.z + a.w)) + ((b.x + b.y) + (b.z + b.w)) + ((c.x + c.y) + (c.z + c.w)) + ((d.x + d.y) + (d.z + d.w));
    return rsqrtf(s * (1.f / 1024.f) + EPS);
}
__device__ __forceinline__ float wave_sum(float v) {
#pragma unroll
    for (int o = 1; o < 64; o <<= 1) v += __shfl_xor(v, o);
    return v;
}

struct EpiIn {
    static constexpr bool PERM = true, AFTER_DRAIN = false;
    bf16_t* slot0; int act_slot, ab_tile; float* ab; bf16_t* halo; const float* ssq; int slot2;
    __device__ __forceinline__ void operator()(const f32x4 (&acc)[2][2][4][2], const Unit& u, int wr, int wc, int fr, int fq) const {
        float rs[2][4];
#pragma unroll
        for (int ai = 0; ai < 2; ++ai)
#pragma unroll
            for (int m = 0; m < 4; ++m) rs[ai][m] = row_rstd(ssq, u.pm * BM + ai * HALF + wr * 64 + m * 16 + fr);
        if (u.pn == ab_tile) {
            if (wc == 0 && fq < 2) {
#pragma unroll
                for (int ai = 0; ai < 2; ++ai)
#pragma unroll
                    for (int m = 0; m < 4; ++m) { const int row = u.pm * BM + ai * HALF + wr * 64 + m * 16 + fr;
#pragma unroll
                        for (int n = 0; n < 2; ++n) *(f32x4*)(ab + (size_t)row * 16 + 8 * fq + 4 * n) = acc[ai][0][m][n] * rs[ai][m]; }
            }
            return;
        }
        const int slot = u.pn >> 2; bf16_t* base = slot0 + (size_t)(slot == 2 ? slot2 : slot) * SLOTE; const bool act = (slot == act_slot);
        const int col0 = (u.pn & 3) * BM + wc * 32 + 8 * fq;
#pragma unroll
        for (int ai = 0; ai < 2; ++ai)
#pragma unroll
            for (int m = 0; m < 4; ++m) { const int row = u.pm * BM + ai * HALF + wr * 64 + m * 16 + fr; bf16_t* rowp = base + (size_t)row * DM + col0;
#pragma unroll
                for (int bj = 0; bj < 2; ++bj) { f32x4 v0 = acc[ai][bj][m][0] * rs[ai][m], v1 = acc[ai][bj][m][1] * rs[ai][m];
                    if (act) { v0 = (f32x4){siluf_(v0[0]), siluf_(v0[1]), siluf_(v0[2]), siluf_(v0[3])}; v1 = (f32x4){siluf_(v1[0]), siluf_(v1[1]), siluf_(v1[2]), siluf_(v1[3])}; }
                    u32x4 w; w.x = pk2(v0[0], v0[1]); w.y = pk2(v0[2], v0[3]); w.z = pk2(v1[0], v1[1]); w.w = pk2(v1[2], v1[3]);
                    *(u32x4*)(rowp + bj * HALF) = w;
                    if (halo && slot < 3 && m == 3 && fr >= 13) { const int hrow = (row >> 6) * 3 + (fr - 13); *(u32x4*)(halo + (size_t)hrow * 3072 + slot * 1024 + col0 + bj * HALF) = w; }
                } }
    }
};
struct EpiB {
    static constexpr bool PERM = true, AFTER_DRAIN = false;
    bf16_t* O; int ldc; const float* ssq; const bf16_t* g1; const bf16_t* t; int mode;
    __device__ __forceinline__ void operator()(const f32x4 (&acc)[2][2][4][2], const Unit& u, int wr, int wc, int fr, int fq) const {
        const int col0 = u.pn * BM + wc * 32 + 8 * fq;
#pragma unroll
        for (int ai = 0; ai < 2; ++ai)
#pragma unroll
            for (int m = 0; m < 4; ++m) { const int row = u.pm * BM + ai * HALF + wr * 64 + m * 16 + fr; const size_t off = (size_t)row * ldc + col0;
                float rs = 1.f; if (mode < 2) rs = row_rstd(ssq, row);
#pragma unroll
                for (int bj = 0; bj < 2; ++bj) { f32x4 v0 = acc[ai][bj][m][0] * rs, v1 = acc[ai][bj][m][1] * rs;
                    if (mode == 1) { v0 = (f32x4){sigmoidf_(v0[0]), sigmoidf_(v0[1]), sigmoidf_(v0[2]), sigmoidf_(v0[3])}; v1 = (f32x4){sigmoidf_(v1[0]), sigmoidf_(v1[1]), sigmoidf_(v1[2]), sigmoidf_(v1[3])}; }
                    if (mode >= 2) { const u32x4 g = *(const u32x4*)(g1 + off + bj * HALF);
                        v0 = v0 * (f32x4){bflo(g.x), bfhi(g.x), bflo(g.y), bfhi(g.y)}; v1 = v1 * (f32x4){bflo(g.z), bfhi(g.z), bflo(g.w), bfhi(g.w)};
                        if (mode == 3) { const u32x4 tt = *(const u32x4*)(t + off + bj * HALF);
                            v0 = v0 + (f32x4){bflo(tt.x), bfhi(tt.x), bflo(tt.y), bfhi(tt.y)}; v1 = v1 + (f32x4){bflo(tt.z), bfhi(tt.z), bflo(tt.w), bfhi(tt.w)}; } }
                    u32x4 w; w.x = pk2(v0[0], v0[1]); w.y = pk2(v0[2], v0[3]); w.z = pk2(v1[0], v1[1]); w.w = pk2(v1[2], v1[3]);
                    *(u32x4*)(O + off + bj * HALF) = w; } }
    }
};
struct EpiFfn {
    static constexpr bool PERM = true, AFTER_DRAIN = false;
    bf16_t* O; const float* ssq;
    __device__ __forceinline__ void operator()(const f32x4 (&acc)[2][2][4][2], const Unit& u, int wr, int wc, int fr, int fq) const {
        const int col0 = u.pn * HALF + wc * 32 + 8 * fq;
#pragma unroll
        for (int ai = 0; ai < 2; ++ai)
#pragma unroll
            for (int m = 0; m < 4; ++m) { const int row = u.pm * BM + ai * HALF + wr * 64 + m * 16 + fr; const float rs = row_rstd(ssq, row);
                const f32x4 g0 = acc[ai][0][m][0] * rs, g1 = acc[ai][0][m][1] * rs, u0 = acc[ai][1][m][0] * rs, u1 = acc[ai][1][m][1] * rs;
                u32x4 w; w.x = pk2(siluf_(g0[0]) * u0[0], siluf_(g0[1]) * u0[1]); w.y = pk2(siluf_(g0[2]) * u0[2], siluf_(g0[3]) * u0[3]);
                w.z = pk2(siluf_(g1[0]) * u1[0], siluf_(g1[1]) * u1[1]); w.w = pk2(siluf_(g1[2]) * u1[2], siluf_(g1[3]) * u1[3]);
                *(u32x4*)(O + (size_t)row * DFF + col0) = w; }
    }
};
struct EpiRes {
    static constexpr bool PERM = false, AFTER_DRAIN = false;
    const float* base; float* out; bf16_t* xb; float* ssq;
    __device__ __forceinline__ void operator()(const f32x4 (&acc)[2][2][4][2], const Unit& u, int wr, int wc, int fr, int fq) const {
        const int col0 = u.pn * BM + wc * 32 + 4 * fq;
#pragma unroll
        for (int ai = 0; ai < 2; ++ai)
#pragma unroll
            for (int m = 0; m < 4; ++m) { const int row = u.pm * BM + ai * HALF + wr * 64 + m * 16 + fr; const size_t off = (size_t)row * DM + col0; float s = 0.f;
#pragma unroll
                for (int bj = 0; bj < 2; ++bj)
#pragma unroll
                    for (int n = 0; n < 2; ++n) { const size_t o2 = off + bj * HALF + n * 16; const f32x4 v = *(const f32x4*)(base + o2) + acc[ai][bj][m][n];
                        *(f32x4*)(out + o2) = v; if (xb) { u32x2 w; w.x = pk2(v[0], v[1]); w.y = pk2(v[2], v[3]); *(u32x2*)(xb + o2) = w; }
                        s += (v[0] * v[0] + v[1] * v[1]) + (v[2] * v[2] + v[3] * v[3]); }
                s += __shfl_xor(s, 16); s += __shfl_xor(s, 32);
                if (fq == 0) ssq[(size_t)row * 16 + u.pn * 4 + wc] = s; }
    }
};
__device__ __forceinline__ int map_row(int mode, int n) {
    if (mode == 1) return n >= 4112 ? n + 240 : n;
    if (mode == 2) { const int m = n < DFF ? n : n - DFF; return (m >> 7) * 256 + (n < DFF ? 0 : 128) + (m & 127); }
    return n;
}
__device__ __forceinline__ void tr_item(const float* W, int K, int N, bf16_t* WT, int mode, const float* g, LAS float* scr, int item, int lane) {
    const int nblk = (N + 63) / 64, kb = item / nblk, nb = item % nblk, k0 = 64 * kb, n0 = 64 * nb;
    const int nl = n0 + 4 * (lane & 15), kr = lane >> 4;
    f32x4 v[16];
#pragma unroll
    for (int i = 0; i < 16; ++i) { const int kk = 4 * i + kr; v[i] = (nl < N) ? *(const f32x4*)(W + (size_t)(k0 + kk) * N + nl) : (f32x4){0.f, 0.f, 0.f, 0.f}; }
#pragma unroll
    for (int i = 0; i < 16; ++i) { const int kk = 4 * i + kr; f32x4 x = v[i]; if (g) x = x * g[k0 + kk]; *(LAS f32x4*)(scr + kk * 68 + 4 * (lane & 15)) = x; }
    asm volatile("s_waitcnt lgkmcnt(0)" ::: "memory");
    const int c = lane & 7;
#pragma unroll
    for (int j = 0; j < 8; ++j) { const int nn = (lane >> 3) + 8 * j, n = n0 + nn;
        if (n < N) { float sc = 1.f; if (mode == 1 && n >= 4112 && n < 5136) sc = QB_SCALE; if (mode == 3) sc = QM_SCALE;
            const LAS float* s = scr + (8 * c) * 68 + nn;
            u32x4 o; o.x = pk2(s[0 * 68] * sc, s[1 * 68] * sc); o.y = pk2(s[2 * 68] * sc, s[3 * 68] * sc); o.z = pk2(s[4 * 68] * sc, s[5 * 68] * sc); o.w = pk2(s[6 * 68] * sc, s[7 * 68] * sc);
            *(u32x4*)(WT + (size_t)map_row(mode, n) * K + k0 + 8 * c) = o; } }
    asm volatile("s_waitcnt lgkmcnt(0)" ::: "memory");
}
struct Inputs { const float* p[21]; };
__device__ __forceinline__ void convert_phase(LAS unsigned char* lds, const Inputs& in, bf16_t* Wt, int l, int gw, int NGW, int wid, int lane) {
    LAS float* scr = (LAS float*)(lds + wid * 18432);
    constexpr int I_IN = 16 * 145, I_SQ = 16 * 16, I_MKV = 16 * 32, I_GU = 16 * 88, I_DN = 44 * 16;
    constexpr int NITEMS = I_IN + 5 * I_SQ + I_MKV + I_GU + I_DN;
    for (int it = gw; it < NITEMS; it += NGW) {
        int r = it;
        if (r < I_IN) { tr_item(as_global(in.p[3]) + (size_t)l * 1024 * NIN, 1024, NIN, Wt + WO_IN, 1, as_global(in.p[2]) + l * 1024, scr, r, lane); continue; } r -= I_IN;
        if (r < I_SQ) { tr_item(as_global(in.p[8]) + (size_t)l * 1048576, 1024, 1024, Wt + WO_A, 0, nullptr, scr, r, lane); continue; } r -= I_SQ;
        if (r < I_SQ) { tr_item(as_global(in.p[9]) + (size_t)l * 1048576, 1024, 1024, Wt + WO_B, 0, nullptr, scr, r, lane); continue; } r -= I_SQ;
        if (r < I_SQ) { tr_item(as_global(in.p[11]) + (size_t)l * 1048576, 1024, 1024, Wt + WO_O, 0, nullptr, scr, r, lane); continue; } r -= I_SQ;
        if (r < I_SQ) { tr_item(as_global(in.p[14]) + (size_t)l * 1048576, 1024, 1024, Wt + WO_MQ, 3, as_global(in.p[12]) + l * 1024, scr, r, lane); continue; } r -= I_SQ;
        if (r < I_SQ) { tr_item(as_global(in.p[16]) + (size_t)l * 1048576, 1024, 1024, Wt + WO_MO, 0, nullptr, scr, r, lane); continue; } r -= I_SQ;
        if (r < I_MKV) { tr_item(as_global(in.p[15]) + (size_t)l * 2097152, 1024, 2048, Wt + WO_MKV, 0, as_global(in.p[13]) + l * 1024, scr, r, lane); continue; } r -= I_MKV;
        if (r < I_GU) { tr_item(as_global(in.p[18]) + (size_t)l * 1024 * 2 * DFF, 1024, 2 * DFF, Wt + WO_GU, 2, as_global(in.p[17]) + l * 1024, scr, r, lane); continue; } r -= I_GU;
        tr_item(as_global(in.p[19]) + (size_t)l * DFF * 1024, DFF, 1024, Wt + WO_DN, 0, nullptr, scr, r, lane);
    }
    for (int i = gw * 64 + lane; i < 240 * 128; i += NGW * 64) *(u32x4*)(Wt + WO_IN + (size_t)4112 * 1024 + (size_t)i * 8) = (u32x4){0u, 0u, 0u, 0u};
}
__device__ __forceinline__ void rows_to_bf16(const float* x, bf16_t* xb, float* ssq, int nrows, int gw, int NGW, int lane) {
    for (int m = gw; m < nrows; m += NGW) {
        const f32x4* xr = (const f32x4*)(x + (size_t)m * DM) + lane; f32x4 v[4]; float s = 0.f;
#pragma unroll
        for (int j = 0; j < 4; ++j) { v[j] = xr[64 * j]; s += (v[j].x * v[j].x + v[j].y * v[j].y) + (v[j].z * v[j].z + v[j].w * v[j].w); }
        s = wave_sum(s);
        u32x2* o8 = (u32x2*)(xb + (size_t)m * DM) + lane;
#pragma unroll
        for (int j = 0; j < 4; ++j) { u32x2 w; w.x = pk2(v[j].x, v[j].y); w.y = pk2(v[j].z, v[j].w); o8[64 * j] = w; }
        if (lane < 16) ssq[(size_t)m * 16 + lane] = (lane == 0) ? s : 0.f;
    }
}
__device__ __forceinline__ void final_norm(float* out, const float* ssq, const float* g, int gw, int NGW, int lane) {
    for (int m = gw; m < MROWS; m += NGW) {
        const float rs = row_rstd(ssq, m); f32x4* xr = (f32x4*)(out + (size_t)m * DM) + lane; const f32x4* gr = (const f32x4*)g + lane;
#pragma unroll
        for (int j = 0; j < 4; ++j) xr[64 * j] = xr[64 * j] * rs * gr[64 * j];
    }
}
__device__ __forceinline__ void oa_norm(const bf16_t* o, bf16_t* za, const float* hn, int gw, int NGW, int lane) {
    for (int m = gw; m < MROWS; m += NGW) {
        const size_t off = (size_t)m * DM + lane * 16; const u32x4 a0 = *(const u32x4*)(o + off), a1 = *(const u32x4*)(o + off + 8); const u32x4 z0 = *(const u32x4*)(za + off), z1 = *(const u32x4*)(za + off + 8);
        float v[16] = {bflo(a0.x), bfhi(a0.x), bflo(a0.y), bfhi(a0.y), bflo(a0.z), bfhi(a0.z), bflo(a0.w), bfhi(a0.w), bflo(a1.x), bfhi(a1.x), bflo(a1.y), bfhi(a1.y), bflo(a1.z), bfhi(a1.z), bflo(a1.w), bfhi(a1.w)};
        float z[16] = {bflo(z0.x), bfhi(z0.x), bflo(z0.y), bfhi(z0.y), bflo(z0.z), bfhi(z0.z), bflo(z0.w), bfhi(z0.w), bflo(z1.x), bfhi(z1.x), bflo(z1.y), bfhi(z1.y), bflo(z1.z), bfhi(z1.z), bflo(z1.w), bfhi(z1.w)};
        float s = 0.f;
#pragma unroll
        for (int j = 0; j < 16; ++j) s += v[j] * v[j];
        s += __shfl_xor(s, 1); s += __shfl_xor(s, 2); s += __shfl_xor(s, 4);
        const float rs = rsqrtf(s * (1.f / 128.f) + EPS); const float* h = hn + (lane & 7) * 16;
#pragma unroll
        for (int j = 0; j < 16; ++j) v[j] = v[j] * rs * h[j] * z[j];
        u32x4 w0, w1; w0.x = pk2(v[0], v[1]); w0.y = pk2(v[2], v[3]); w0.z = pk2(v[4], v[5]); w0.w = pk2(v[6], v[7]); w1.x = pk2(v[8], v[9]); w1.y = pk2(v[10], v[11]); w1.z = pk2(v[12], v[13]); w1.w = pk2(v[14], v[15]);
        *(u32x4*)(za + off) = w0; *(u32x4*)(za + off + 8) = w1;
    }
}

#define MFMA16(a, b, c) __builtin_amdgcn_mfma_f32_16x16x32_bf16((a), (b), (c), 0, 0, 0)
#define MFMA32(a, b, c) __builtin_amdgcn_mfma_f32_32x32x16_bf16((a), (b), (c), 0, 0, 0)
constexpr int RP = 272, LP = 68;
constexpr int PR_QS = 0, PR_KS = 17408, PR_RHS = 34816, PR_LM = 104448, PR_G = 121856, PR_B = 122112, PR_CW = 122368, PR_DP = 128512;
#define LBAR() asm volatile("s_waitcnt lgkmcnt(0)\n\ts_barrier" ::: "memory")
__device__ __forceinline__ void prep_phase(LAS unsigned char* lds, bf16_t* R0, const float* ab, const bf16_t* halo, const float* convw, const float* a_log, const float* dt_bias,
                                           bf16_t* KT, bf16_t* PT, float* Eg, bf16_t* Oq, bf16_t* Ow, bf16_t* Ou, int tid, int wid, int lane) {
    LAS unsigned char* qs = lds + PR_QS; LAS unsigned char* ks = lds + PR_KS; LAS float* rhs = (LAS float*)(lds + PR_RHS); LAS float* Lm = (LAS float*)(lds + PR_LM);
    LAS float* Gs = (LAS float*)(lds + PR_G); LAS float* Bs = (LAS float*)(lds + PR_B); LAS float* cw = (LAS float*)(lds + PR_CW);
    int cw_head = -1;
    float pa, pb; { const int u0 = (int)blockIdx.x < BATCH * NCH * 8 ? (int)blockIdx.x : 0; pa = ab[(size_t)((u0 >> 3) * 64 + lane) * 16 + (u0 & 7)]; pb = ab[(size_t)((u0 >> 3) * 64 + lane) * 16 + 8 + (u0 & 7)]; }
#pragma unroll 1
    for (int unit = blockIdx.x; unit < BATCH * NCH * 8; unit += gridDim.x) {
        const int h = unit & 7, row0 = (unit >> 3) * 64, nchunk = (unit >> 3) & 31;
        const bool restaged = (h != cw_head);
        if (h != cw_head) {
            for (int i = tid; i < 4 * 3 * 128; i += 512) { const int tap = i / 384, rem = i % 384; cw[i] = convw[(size_t)tap * 3072 + (rem >> 7) * 1024 + h * 128 + (rem & 127)]; }
            cw_head = h;
        }
        {
            const float a = pa, bt = pb;
            { const int un = unit + (int)gridDim.x < BATCH * NCH * 8 ? unit + (int)gridDim.x : unit; pa = ab[(size_t)((un >> 3) * 64 + lane) * 16 + (un & 7)]; pb = ab[(size_t)((un >> 3) * 64 + lane) * 16 + 8 + (un & 7)]; }
            const float x = a + dt_bias[h]; const float sp = x > 20.f ? x : __logf(1.f + __expf(x)); float g = -__expf(a_log[h]) * sp;
#pragma unroll
            for (int o = 1; o < 64; o <<= 1) { const float y = __shfl_up(g, o); if (lane >= o) g += y; }
            Gs[lane] = g; Bs[lane] = 1.f / (1.f + __expf(-bt)); if (wid == 0 && lane == 63) Eg[unit] = __expf(g);
        }
        if (restaged) LBAR(); else asm volatile("s_waitcnt lgkmcnt(0)" ::: "memory");
        {
            const int t = tid >> 3, c0 = (tid & 7) * 16; const float beta = Bs[t], eg = __expf(Gs[t]);
#pragma unroll
            for (int mat = 0; mat < 3; ++mat) {
                const bf16_t* src = R0 + (size_t)mat * SLOTE; float acc[16];
#pragma unroll
                for (int j = 0; j < 16; ++j) acc[j] = 0.f;
#pragma unroll
                for (int i = 0; i < 4; ++i) { const int tt = t - 3 + i; u32x4 x0 = {0u, 0u, 0u, 0u}, x1 = {0u, 0u, 0u, 0u};
                    if (tt >= 0) { const bf16_t* p = src + (size_t)(row0 + tt) * DM + h * 128 + c0; x0 = *(const u32x4*)p; x1 = *(const u32x4*)(p + 8); }
                    else if (nchunk > 0) { const bf16_t* p = halo + (size_t)(((row0 >> 6) - 1) * 3 + (3 + tt)) * 3072 + mat * 1024 + h * 128 + c0; x0 = *(const u32x4*)p; x1 = *(const u32x4*)(p + 8); }
                    const LAS f32x4* wp = (const LAS f32x4*)(cw + i * 384 + mat * 128 + c0); const f32x4 w0 = wp[0], w1 = wp[1], w2 = wp[2], w3 = wp[3];
                    acc[0] += w0.x * bflo(x0.x); acc[1] += w0.y * bfhi(x0.x); acc[2] += w0.z * bflo(x0.y); acc[3] += w0.w * bfhi(x0.y);
                    acc[4] += w1.x * bflo(x0.z); acc[5] += w1.y * bfhi(x0.z); acc[6] += w1.z * bflo(x0.w); acc[7] += w1.w * bfhi(x0.w);
                    acc[8] += w2.x * bflo(x1.x); acc[9] += w2.y * bfhi(x1.x); acc[10] += w2.z * bflo(x1.y); acc[11] += w2.w * bfhi(x1.y);
                    acc[12] += w3.x * bflo(x1.z); acc[13] += w3.y * bfhi(x1.z); acc[14] += w3.z * bflo(x1.w); acc[15] += w3.w * bfhi(x1.w); }
                float ss = 0.f;
#pragma unroll
                for (int j = 0; j < 16; ++j) { acc[j] = siluf_(acc[j]); ss += acc[j] * acc[j]; }
                if (mat < 2) {
                    ss += __shfl_xor(ss, 1); ss += __shfl_xor(ss, 2); ss += __shfl_xor(ss, 4);
                    const float rn = rsqrtf(ss + EPS) * (mat == 0 ? 0.08838834764831845f : 1.f);
#pragma unroll
                    for (int j = 0; j < 16; ++j) acc[j] *= rn;
                    u32x4 w0, w1; w0.x = pk2(acc[0], acc[1]); w0.y = pk2(acc[2], acc[3]); w0.z = pk2(acc[4], acc[5]); w0.w = pk2(acc[6], acc[7]);
                    w1.x = pk2(acc[8], acc[9]); w1.y = pk2(acc[10], acc[11]); w1.z = pk2(acc[12], acc[13]); w1.w = pk2(acc[14], acc[15]);
                    LAS unsigned char* d = (mat == 0 ? qs : ks) + t * 272 + c0 * 2; *(LAS u32x4*)d = w0; *(LAS u32x4*)(d + 16) = w1;
                }
                if (mat >= 1) { const float sc = (mat == 1) ? beta * eg : beta; LAS float* d = rhs + t * RP + (mat == 1 ? 128 : 0) + c0;
#pragma unroll
                    for (int j4 = 0; j4 < 4; ++j4) *(LAS f32x4*)(d + 4 * j4) = (f32x4){acc[4 * j4] * sc, acc[4 * j4 + 1] * sc, acc[4 * j4 + 2] * sc, acc[4 * j4 + 3] * sc}; }
            }
        }
        LBAR();
        {
            const int mtx = wid >> 2, ti = wid & 3, r = lane & 15, quad = lane >> 4; const LAS unsigned char* Ab = mtx ? qs : ks;
#pragma unroll
            for (int tj = 0; tj < 4; ++tj) { f32x4 c = {0.f, 0.f, 0.f, 0.f};
#pragma unroll
                for (int s = 0; s < 4; ++s) { const bf16x8 a = *(const LAS bf16x8*)(Ab + (16 * ti + r) * 272 + (32 * s + quad * 8) * 2); const bf16x8 b = *(const LAS bf16x8*)(ks + (16 * tj + r) * 272 + (32 * s + quad * 8) * 2); c = MFMA16(a, b, c); }
#pragma unroll
                for (int jj = 0; jj < 4; ++jj) { const int t = 16 * ti + quad * 4 + jj, col = 16 * tj + r; const float dec = (col <= t) ? __expf(Gs[t] - Gs[col]) : 0.f;
                    if (mtx == 0) Lm[t * LP + col] = (col < t) ? -(Bs[t] * c[jj] * dec) : 0.f;
                    else PT[(size_t)unit * 4096 + t * 64 + col] = (bf16_t)(pk2(c[jj] * dec, 0.f) & 0xffffu); }
            }
            if (mtx == 0 && lane < 16) {
                float d[16]; const LAS float* Lb = Lm + (16 * ti) * LP + 16 * ti; LAS float* DP = (LAS float*)(lds + PR_DP) + ti * 256 + (lane & 3) * 64 + (lane >> 2) * 16;
                f32x4 rc[4], rn[4];
#pragma unroll
                for (int q = 0; q < 4; ++q) { rc[q] = *(const LAS f32x4*)(Lb + 1 * LP + 4 * q); rn[q] = rc[q]; }
                d[0] = (lane == 0) ? 1.f : 0.f; DP[0] = d[0];
#pragma unroll
                for (int rr = 1; rr < 16; ++rr) {
                    if (rr < 15) {
#pragma unroll
                        for (int q = 0; q < 4; ++q) if (4 * q < rr + 1) rn[q] = *(const LAS f32x4*)(Lb + (rr + 1) * LP + 4 * q); }
                    float a0 = (rr == lane) ? 1.f : 0.f, a1 = 0.f;
#pragma unroll
                    for (int k = 0; k < rr; ++k) { if (k & 1) a1 += rc[k >> 2][k & 3] * d[k]; else a0 += rc[k >> 2][k & 3] * d[k]; }
                    d[rr] = a0 + a1; DP[rr] = d[rr];
#pragma unroll
                    for (int q = 0; q < 4; ++q) rc[q] = rn[q];
                }
            }
        }
        LBAR();
        {
            const int r = lane & 15, quad = lane >> 4; const LAS float* DPb = (const LAS float*)(lds + PR_DP);
#pragma unroll 1
            for (int I = 0; I < 4; ++I) {
                f32x4 C0, C1; LAS float* x0 = rhs + (16 * I + 4 * quad) * RP + wid * 32 + r; LAS float* x1 = x0 + 16;
#pragma unroll
                for (int jj = 0; jj < 4; ++jj) { C0[jj] = x0[jj * RP]; C1[jj] = x1[jj * RP]; }
#pragma unroll 2
                for (int j0 = 0; j0 < 16 * I; j0 += 4) { const float a = Lm[(16 * I + r) * LP + j0 + quad]; const LAS float* bp = rhs + (j0 + quad) * RP + wid * 32 + r;
                    C0 = __builtin_amdgcn_mfma_f32_16x16x4f32(a, bp[0], C0, 0, 0, 0); C1 = __builtin_amdgcn_mfma_f32_16x16x4f32(a, bp[16], C1, 0, 0, 0); }
                f32x4 X0 = {0.f, 0.f, 0.f, 0.f}, X1 = {0.f, 0.f, 0.f, 0.f};
#pragma unroll
                for (int sx = 0; sx < 4; ++sx) { const float a = DPb[I * 256 + sx * 64 + quad * 16 + r];
                    X0 = __builtin_amdgcn_mfma_f32_16x16x4f32(a, C0[sx], X0, 0, 0, 0); X1 = __builtin_amdgcn_mfma_f32_16x16x4f32(a, C1[sx], X1, 0, 0, 0); }
#pragma unroll
                for (int jj = 0; jj < 4; ++jj) { x0[jj * RP] = X0[jj]; x1[jj * RP] = X1[jj]; }
            }
        }
        {
#pragma unroll
            for (int k = 0; k < 2; ++k) { const int p = tid + 512 * k, t = p >> 4, c8 = (p & 15) * 8; const u32x4 v = *(const LAS u32x4*)(qs + t * 272 + c8 * 2); const float eg = __expf(Gs[t]);
                u32x4 w; w.x = pk2(bflo(v.x) * eg, bfhi(v.x) * eg); w.y = pk2(bflo(v.y) * eg, bfhi(v.y) * eg); w.z = pk2(bflo(v.z) * eg, bfhi(v.z) * eg); w.w = pk2(bflo(v.w) * eg, bfhi(v.w) * eg);
                *(u32x4*)(Oq + (size_t)(row0 + t) * DM + h * 128 + c8) = w; }
            const int dk = tid & 127, qtr = tid >> 7; const float g63 = Gs[63];
#pragma unroll
            for (int tg = 0; tg < 2; ++tg) { float v[8];
#pragma unroll
                for (int i = 0; i < 8; ++i) { const int t = 16 * qtr + 8 * tg + i; v[i] = bf2f(*(const LAS unsigned short*)(ks + t * 272 + dk * 2)) * __expf(g63 - Gs[t]); }
                u32x4 w; w.x = pk2(v[0], v[1]); w.y = pk2(v[2], v[3]); w.z = pk2(v[4], v[5]); w.w = pk2(v[6], v[7]);
                *(u32x4*)(KT + (size_t)unit * 8192 + dk * 64 + 16 * qtr + 8 * tg) = w; }
        }
        LBAR();
#pragma unroll
        for (int k = 0; k < 4; ++k) { const int p = tid + 512 * k, t = p >> 5, c8 = (p & 31) * 8; const f32x4 v0 = *(const LAS f32x4*)(rhs + t * RP + c8), v1 = *(const LAS f32x4*)(rhs + t * RP + c8 + 4);
            const float sg = (c8 < 128) ? 1.f : -1.f; u32x4 w; w.x = pk2(v0.x * sg, v0.y * sg); w.y = pk2(v0.z * sg, v0.w * sg); w.z = pk2(v1.x * sg, v1.y * sg); w.w = pk2(v1.z * sg, v1.w * sg);
            bf16_t* dst = (c8 < 128) ? (Ou + (size_t)(row0 + t) * DM + h * 128 + c8) : (Ow + (size_t)(row0 + t) * DM + h * 128 + (c8 - 128));
            *(u32x4*)dst = w; }
        LBAR();
    }
}
constexpr int SC_W = 0, SC_Q = 17408, SC_P = 34816, SC_K = 44032, SC_U = 62464, SC_BUF = 66560;
__device__ __forceinline__ bf16x8 afrag(const LAS unsigned char* p) { const u32x2 lo = *(const LAS u32x2*)p; const u32x2 hi = *(const LAS u32x2*)(p + 32); const u32x4 v = {lo.x, lo.y, hi.x, hi.y}; return __builtin_bit_cast(bf16x8, v); }
__device__ __forceinline__ bf16x8 packB(const f32x4 a, const f32x4 b) { const u32x4 v = {pk2(a.x, a.y), pk2(a.z, a.w), pk2(b.x, b.y), pk2(b.z, b.w)}; return __builtin_bit_cast(bf16x8, v); }
__device__ __forceinline__ void scan_phase(LAS unsigned char* lds, bf16_t* R0, const bf16_t* KT, const bf16_t* PT, const float* Eg, bf16_t* Odst, int tid, int wid, int lane) {
    const int r = lane & 15, quad = lane >> 4;
    const int vcu = (gridDim.x % 8 == 0) ? (int)((blockIdx.x & 7) * (gridDim.x >> 3) + (blockIdx.x >> 3)) : (int)blockIdx.x;
    for (int task = vcu; task < 256; task += gridDim.x) {
        const int bh = task >> 2, dvq = task & 3, b = bh >> 3, h = bh & 7, dv16 = dvq * 32 + (wid & 1) * 16;
        const bf16_t* Wsrc = R0 + SLOTE; const bf16_t* Qsrc = R0; const bf16_t* Usrc = R0 + 2 * SLOTE;
        if (wid < 2) {
            f32x4 S[8];
#pragma unroll
            for (int d = 0; d < 8; ++d) S[d] = (f32x4){0.f, 0.f, 0.f, 0.f};
            float en = Eg[(size_t)((b * NCH + 0) * 8 + h)];
            __syncthreads();
#pragma unroll 1
            for (int n = 0; n < NCH; ++n) {
                f32x4 U[4], O[4]; const float ec = en; int rq = quad * 4 * DM + h * 128 + dv16 + r; asm volatile("" : "+v"(rq));
                const LAS unsigned char* B_ = lds + (n & 1) * SC_BUF; const int row0 = (b * NCH + n) * 64;
#pragma unroll
                for (int m = 0; m < 4; ++m) { const LAS unsigned short* up = (const LAS unsigned short*)(B_ + SC_U + (16 * m + quad * 4) * 64 + ((wid & 1) * 16 + r) * 2);
                    U[m] = (f32x4){bf2f(up[0]), bf2f(up[32]), bf2f(up[64]), bf2f(up[96])}; }
                if (n + 1 < NCH) en = Eg[(size_t)((b * NCH + n + 1) * 8 + h)];
                bf16x8 Sb[4];
#pragma unroll
                for (int s = 0; s < 4; ++s) Sb[s] = packB(S[2 * s], S[2 * s + 1]);
#pragma unroll
                for (int m = 0; m < 4; ++m) O[m] = (f32x4){0.f, 0.f, 0.f, 0.f};
#define SBAR_ __builtin_amdgcn_sched_barrier(0)
#define LM(m, fw, fq) do { _Pragma("unroll") for (int s = 0; s < 4; ++s) { fw[s] = afrag(B_ + SC_W + (16 * (m) + r) * 272 + (32 * s + quad * 4) * 2); fq[s] = afrag(B_ + SC_Q + (16 * (m) + r) * 272 + (32 * s + quad * 4) * 2); } } while (0)
#define MM(m, fw, fq) do { _Pragma("unroll") for (int s = 0; s < 4; ++s) { U[m] = MFMA16(fw[s], Sb[s], U[m]); O[m] = MFMA16(fq[s], Sb[s], O[m]); } } while (0)
                bf16x8 fwa[4], fqa[4], fwb[4], fqb[4], fp[8], fk[8];
                LM(0, fwa, fqa);
                LM(1, fwb, fqb); SBAR_; MM(0, fwa, fqa); SBAR_;
                LM(2, fwa, fqa); SBAR_; MM(1, fwb, fqb); SBAR_;
                LM(3, fwb, fqb); SBAR_; MM(2, fwa, fqa); SBAR_;
#pragma unroll
                for (int m = 0; m < 4; ++m)
#pragma unroll
                    for (int s = 0; s < 2; ++s) fp[m * 2 + s] = afrag(B_ + SC_P + (16 * m + r) * 144 + (32 * s + quad * 4) * 2);
                SBAR_; MM(3, fwb, fqb); SBAR_;
                bf16x8 Ub[2]; Ub[0] = packB(U[0], U[1]); Ub[1] = packB(U[2], U[3]);
#pragma unroll
                for (int d = 0; d < 4; ++d)
#pragma unroll
                    for (int s = 0; s < 2; ++s) fk[d * 2 + s] = afrag(B_ + SC_K + (16 * d + r) * 144 + (32 * s + quad * 4) * 2);
                SBAR_;
#pragma unroll
                for (int m = 0; m < 4; ++m)
#pragma unroll
                    for (int s = 0; s < 2; ++s) O[m] = MFMA16(fp[m * 2 + s], Ub[s], O[m]);
                SBAR_;
#pragma unroll
                for (int d = 0; d < 4; ++d)
#pragma unroll
                    for (int s = 0; s < 2; ++s) fp[d * 2 + s] = afrag(B_ + SC_K + (16 * (d + 4) + r) * 144 + (32 * s + quad * 4) * 2);
                SBAR_;
#pragma unroll
                for (int d = 0; d < 4; ++d) { S[d] = S[d] * ec;
#pragma unroll
                    for (int s = 0; s < 2; ++s) S[d] = MFMA16(fk[d * 2 + s], Ub[s], S[d]); }
                SBAR_;
#pragma unroll
                for (int d = 0; d < 4; ++d) { S[d + 4] = S[d + 4] * ec;
#pragma unroll
                    for (int s = 0; s < 2; ++s) S[d + 4] = MFMA16(fp[d * 2 + s], Ub[s], S[d + 4]); }
#undef LM
#undef MM
#undef SBAR_
#pragma unroll
                for (int m = 0; m < 4; ++m)
#pragma unroll
                    for (int jj = 0; jj < 4; ++jj) Odst[(size_t)(row0 + 16 * m + jj) * DM + rq] = (bf16_t)(pk2(O[m][jj], 0.f) & 0xffffu);
                __syncthreads();
            }
        } else {
            const int lt = tid - 128;
            u32x4 pfa[10], pfb[10];
#define SC_LOAD(n, pf) do { const int row0_ = (b * NCH + (n)) * 64; const size_t unit_ = (size_t)((b * NCH + (n)) * 8 + h); \
                int lt_ = lt; asm volatile("" : "+v"(lt_)); _Pragma("unroll") for (int k = 0; k < 10; ++k) { const int p = lt_ + 384 * k; const bf16_t* src; \
                    if (p < 2048) { const int q = p & 1023; src = (p < 1024 ? Wsrc : Qsrc) + (size_t)(row0_ + (q >> 4)) * DM + h * 128 + (q & 15) * 8; } \
                    else if (p < 2560) src = PT + unit_ * 4096 + (size_t)(p - 2048) * 8; \
                    else if (p < 3584) src = KT + unit_ * 8192 + (size_t)(p - 2560) * 8; \
                    else { const int q = p - 3584; src = Usrc + (size_t)(row0_ + (q >> 2)) * DM + h * 128 + dvq * 32 + (q & 3) * 8; } \
                    pf[k] = *(const u32x4*)src; } } while (0)
#define SC_STORE(buf, pf) do { LAS unsigned char* B_ = lds + (buf) * SC_BUF; \
                int lt_ = lt; asm volatile("" : "+v"(lt_)); _Pragma("unroll") for (int k = 0; k < 10; ++k) { const int p = lt_ + 384 * k; int off; \
                    if (p < 2048) { const int q = p & 1023; off = (p < 1024 ? SC_W : SC_Q) + (q >> 4) * 272 + (q & 15) * 16; } \
                    else if (p < 2560) { const int q = p - 2048; off = SC_P + (q >> 3) * 144 + (q & 7) * 16; } \
                    else if (p < 3584) { const int q = p - 2560; off = SC_K + (q >> 3) * 144 + (q & 7) * 16; } \
                    else { const int q = p - 3584; off = SC_U + (q >> 2) * 64 + (q & 3) * 16; } \
                    *(LAS u32x4*)(B_ + off) = pf[k]; } } while (0)
            SC_LOAD(0, pfa); SC_STORE(0, pfa); SC_LOAD(1, pfb);
            __syncthreads();
#pragma unroll 1
            for (int n = 0; n < NCH; n += 2) {
                if (n + 2 < NCH) SC_LOAD(n + 2, pfa);
                SC_STORE(1, pfb);
                __syncthreads();
                if (n + 3 < NCH) SC_LOAD(n + 3, pfb);
                if (n + 2 < NCH) SC_STORE(0, pfa);
                __syncthreads();
            }
#undef SC_LOAD
#undef SC_STORE
        }
    }
}

__device__ __forceinline__ int crow(int reg, int h) { return (reg & 3) + 8 * (reg >> 2) + 4 * h; }
__device__ __forceinline__ bf16x8 pack8(const f32x16& p, int s) { const u32x4 v = {pk2(p[8 * s], p[8 * s + 1]), pk2(p[8 * s + 2], p[8 * s + 3]), pk2(p[8 * s + 4], p[8 * s + 5]), pk2(p[8 * s + 6], p[8 * s + 7])}; return __builtin_bit_cast(bf16x8, v); }
__device__ __forceinline__ bf16x8 vfrag(const LAS unsigned char* p) { const u32x2 lo = *(const LAS u32x2*)p; const u32x2 hi = *(const LAS u32x2*)(p + 16); const u32x4 v = {lo.x, lo.y, hi.x, hi.y}; return __builtin_bit_cast(bf16x8, v); }
constexpr int BA_K = 0, BA_V = 18432, BA_T = 36864;
__device__ __forceinline__ void band_phase(LAS unsigned char* lds, const bf16_t* Qb, const bf16_t* Kb, const bf16_t* Vb, bf16_t* Ob, const float* rel_bias, int tid, int wid, int lane) {
    const int r = lane & 31, h5 = lane >> 5; LAS float* btab = (LAS float*)(lds + BA_T);
    const int vcu = (gridDim.x % 8 == 0) ? (int)((blockIdx.x & 7) * (gridDim.x >> 3) + (blockIdx.x >> 3)) : (int)blockIdx.x;
    for (int uu = vcu * 4; uu < 1024; uu += gridDim.x * 4)
    for (int ui = 0; ui < 4; ++ui) {
        const int bhh = uu >> 3, b = bhh >> 4, h = bhh & 15, odd = (uu >> 2) & 1; const int qblk = odd ? ((ui == 0) ? 1 : (ui == 1) ? 2 : (ui == 2) ? 5 : 6) : ((ui == 0) ? 0 : (ui == 1) ? 3 : (ui == 2) ? 4 : 7);
        const int rowb = b * SEQ, c_first = (4 * qblk - 8) > 0 ? (4 * qblk - 8) : 0, ntile = 4 * qblk + 4 - c_first;
        const int nq = 4 * qblk + (wid >> 1), qi = 32 * (wid & 1) + r; const int q0 = rowb + 256 * qblk + 32 * wid;
        if (tid < 384) { int rel = 319 - tid; rel = rel < -63 ? -63 : (rel > 256 ? 256 : rel); btab[tid] = rel_bias[h * 320 + rel + 63] * LOG2E; }
        bf16x8 qf[4];
#pragma unroll
        for (int d0 = 0; d0 < 4; ++d0) qf[d0] = *(const bf16x8*)(Qb + (size_t)(q0 + r) * DM + h * 64 + 16 * d0 + 8 * h5);
        u32x4 kreg, vreg; const int skey = tid >> 3, sc8 = tid & 7;
#define BA_LOAD(c) do { const size_t o_ = (size_t)(rowb + 64 * (c) + skey) * DM + h * 64 + sc8 * 8; kreg = *(const u32x4*)(Kb + o_); vreg = *(const u32x4*)(Vb + o_); } while (0)
#define BA_STORE(buf) do { *(LAS u32x4*)(lds + BA_K + (buf) * 9216 + skey * 144 + sc8 * 16) = kreg; LAS unsigned char* v_ = lds + BA_V + (buf) * 9216 + (sc8 * 8) * 136 + skey * 2; \
            *(LAS unsigned short*)(v_) = (unsigned short)kregv(vreg.x, 0); *(LAS unsigned short*)(v_ + 136) = (unsigned short)kregv(vreg.x, 1); *(LAS unsigned short*)(v_ + 272) = (unsigned short)kregv(vreg.y, 0); *(LAS unsigned short*)(v_ + 408) = (unsigned short)kregv(vreg.y, 1); \
            *(LAS unsigned short*)(v_ + 544) = (unsigned short)kregv(vreg.z, 0); *(LAS unsigned short*)(v_ + 680) = (unsigned short)kregv(vreg.z, 1); *(LAS unsigned short*)(v_ + 816) = (unsigned short)kregv(vreg.w, 0); *(LAS unsigned short*)(v_ + 952) = (unsigned short)kregv(vreg.w, 1); } while (0)
#define kregv(w, hi) ((hi) ? ((w) >> 16) : ((w) & 0xffffu))
        BA_LOAD(c_first); BA_STORE(0);
        float m_run = -1e30f, l_run = 0.f; f32x16 O[2];
#pragma unroll
        for (int i = 0; i < 16; ++i) { O[0][i] = 0.f; O[1][i] = 0.f; }
        __syncthreads();
        for (int ti = 0; ti < ntile; ++ti) {
            const int c = c_first + ti;
            if (ti + 1 < ntile) BA_LOAD(c + 1);
            if (c >= nq - 8 && c <= nq) {
                const LAS unsigned char* Kt = lds + BA_K + (ti & 1) * 9216; const LAS unsigned char* Vt = lds + BA_V + (ti & 1) * 9216;
                f32x16 P0, P1;
#pragma unroll
                for (int i = 0; i < 16; ++i) { P0[i] = 0.f; P1[i] = 0.f; }
#pragma unroll
                for (int d0 = 0; d0 < 4; ++d0) { const bf16x8 a0 = *(const LAS bf16x8*)(Kt + r * 144 + (16 * d0 + 8 * h5) * 2); const bf16x8 a1 = *(const LAS bf16x8*)(Kt + (32 + r) * 144 + (16 * d0 + 8 * h5) * 2);
                    P0 = MFMA32(a0, qf[d0], P0); P1 = MFMA32(a1, qf[d0], P1); }
                const int dch = nq - c;
                if (dch >= 5) { const float bc = btab[0];
#pragma unroll
                    for (int i = 0; i < 16; ++i) { P0[i] += bc; P1[i] += bc; } }
                else {
                    const LAS float* bp = btab + (319 - dch * 64 - qi + 4 * h5);
#pragma unroll
                    for (int i = 0; i < 16; ++i) { P0[i] += bp[(i & 3) + 8 * (i >> 2)]; P1[i] += bp[(i & 3) + 8 * (i >> 2) + 32]; } }
                float mx = P0[0];
#pragma unroll
                for (int i = 0; i < 16; ++i) { mx = fmaxf(mx, P0[i]); mx = fmaxf(mx, P1[i]); }
                mx = fmaxf(mx, __shfl_xor(mx, 32));
                const float m_new = fmaxf(m_run, mx), alpha = __builtin_amdgcn_exp2f(m_run - m_new); m_run = m_new;
                float ls = 0.f;
#pragma unroll
                for (int i = 0; i < 16; ++i) { P0[i] = __builtin_amdgcn_exp2f(P0[i] - m_new); P1[i] = __builtin_amdgcn_exp2f(P1[i] - m_new); ls += P0[i] + P1[i]; }
                l_run = l_run * alpha + ls;
#pragma unroll
                for (int i = 0; i < 16; ++i) { O[0][i] *= alpha; O[1][i] *= alpha; }
#pragma unroll
                for (int p = 0; p < 2; ++p)
#pragma unroll
                    for (int s = 0; s < 2; ++s) { const bf16x8 pb = pack8(p ? P1 : P0, s);
#pragma unroll
                        for (int dt = 0; dt < 2; ++dt) O[dt] = MFMA32(vfrag(Vt + (32 * dt + r) * 136 + (32 * p + 16 * s + 4 * h5) * 2), pb, O[dt]); }
            }
            if (ti + 1 < ntile) BA_STORE((ti + 1) & 1);
            __syncthreads();
        }
        l_run += __shfl_xor(l_run, 32); const float inv = 1.f / l_run;
#pragma unroll
        for (int dt = 0; dt < 2; ++dt)
#pragma unroll
            for (int g = 0; g < 4; ++g) { u32x2 w; w.x = pk2(O[dt][4 * g] * inv, O[dt][4 * g + 1] * inv); w.y = pk2(O[dt][4 * g + 2] * inv, O[dt][4 * g + 3] * inv);
                *(u32x2*)(Ob + (size_t)(q0 + r) * DM + h * 64 + 32 * dt + 8 * g + 4 * h5) = w; }
#undef BA_LOAD
#undef BA_STORE
#undef kregv
    }
}

__device__ __forceinline__ void xattn_phase(LAS unsigned char* lds, const bf16_t* Qm, const bf16_t* KV, bf16_t* Om, int tid, int wid, int lane) {
    const int r = lane & 31, h5 = lane >> 5;
    const int vcu = (gridDim.x % 8 == 0) ? (int)((blockIdx.x & 7) * (gridDim.x >> 3) + (blockIdx.x >> 3)) : (int)blockIdx.x;
#define SBAR_ __builtin_amdgcn_sched_barrier(0)
    for (int unit = vcu; unit < 256; unit += gridDim.x) {
        const int b = unit >> 5, mh = (unit >> 3) & 3, qblk = unit & 7; const int q0 = b * SEQ + qblk * 256 + 32 * wid;
        const bf16_t* Kg = KV + (size_t)(b * 256) * 2048 + mh * 256; const bf16_t* Vg = Kg + 1024;
#pragma unroll 1
        for (int kb = 0; kb < 16; kb += 8) { u32x4 kst[8];
#pragma unroll
          for (int k = 0; k < 8; ++k) { const int p = tid + 512 * (kb + k), key = p >> 5, c = p & 31; kst[k] = *(const u32x4*)(Kg + (size_t)key * 2048 + c * 8); }
#pragma unroll
          for (int k = 0; k < 8; ++k) { const int p = tid + 512 * (kb + k), key = p >> 5, c = p & 31; *(LAS u32x4*)(lds + key * 528 + c * 16) = kst[k]; } }
        const bf16_t* qp = Qm + (size_t)(q0 + r) * DM + mh * 256 + 8 * h5;
        bf16x8 qa = *(const bf16x8*)(qp), qb = *(const bf16x8*)(qp + 16);
        __syncthreads();
        f32x16 Sx[8];
#pragma unroll
        for (int kt = 0; kt < 8; ++kt)
#pragma unroll
            for (int i = 0; i < 16; ++i) Sx[kt][i] = 0.f;
#define LK(d0, hf, kf) do { _Pragma("unroll") for (int kt = 0; kt < 4; ++kt) kf[kt] = *(const LAS bf16x8*)(lds + (32 * ((hf) * 4 + kt) + r) * 528 + (16 * (d0) + 8 * h5) * 2); } while (0)
#define MK(kf, hf, q) do { _Pragma("unroll") for (int kt = 0; kt < 4; ++kt) Sx[(hf) * 4 + kt] = MFMA32(kf[kt], q, Sx[(hf) * 4 + kt]); } while (0)
        bf16x8 kfa[4], kfb[4];
        LK(0, 0, kfa);
#pragma unroll 1
        for (int d0 = 0; d0 < 16; d0 += 2) {
            LK(d0, 1, kfb); SBAR_; MK(kfa, 0, qa); SBAR_;
            LK(d0 + 1, 0, kfa); SBAR_; MK(kfb, 1, qa); SBAR_;
            if (d0 + 2 < 16) qa = *(const bf16x8*)(qp + 16 * (d0 + 2));
            LK(d0 + 1, 1, kfb); SBAR_; MK(kfa, 0, qb); SBAR_;
            if (d0 + 2 < 16) LK(d0 + 2, 0, kfa);
            SBAR_; MK(kfb, 1, qb); SBAR_;
            if (d0 + 3 < 16) qb = *(const bf16x8*)(qp + 16 * (d0 + 3));
        }
#undef LK
#undef MK
        float mx = Sx[0][0];
#pragma unroll
        for (int kt = 0; kt < 8; ++kt)
#pragma unroll
            for (int i = 0; i < 16; ++i) mx = fmaxf(mx, Sx[kt][i]);
        mx = fmaxf(mx, __shfl_xor(mx, 32));
        float ls = 0.f;
#pragma unroll
        for (int kt = 0; kt < 8; ++kt)
#pragma unroll
            for (int i = 0; i < 16; ++i) { Sx[kt][i] = __builtin_amdgcn_exp2f(Sx[kt][i] - mx); ls += Sx[kt][i]; }
        ls += __shfl_xor(ls, 32); const float inv = 1.f / ls;
        bf16x8 Pb[16];
#pragma unroll
        for (int kt = 0; kt < 8; ++kt) { Pb[2 * kt] = pack8(Sx[kt], 0); Pb[2 * kt + 1] = pack8(Sx[kt], 1); }
        __syncthreads();
        {
            const int kh = wid & 1, cg4 = wid >> 1, k0 = 128 * kh + 2 * lane;
#pragma unroll 1
            for (int ib = 0; ib < 8; ib += 4) { u32x4 vsa[4], vsb[4];
#pragma unroll
              for (int i = 0; i < 4; ++i) { const int c = cg4 + 4 * (ib + i); vsa[i] = *(const u32x4*)(Vg + (size_t)k0 * 2048 + c * 8); vsb[i] = *(const u32x4*)(Vg + (size_t)(k0 + 1) * 2048 + c * 8); }
#pragma unroll
              for (int i = 0; i < 4; ++i) { const int c = cg4 + 4 * (ib + i); const u32x4 va = vsa[i], vb = vsb[i];
                LAS unsigned char* d = lds + (c * 8) * 536 + k0 * 2;
                *(LAS unsigned*)(d) = (va.x & 0xffffu) | (vb.x << 16); *(LAS unsigned*)(d + 536) = (va.x >> 16) | (vb.x & 0xffff0000u);
                *(LAS unsigned*)(d + 1072) = (va.y & 0xffffu) | (vb.y << 16); *(LAS unsigned*)(d + 1608) = (va.y >> 16) | (vb.y & 0xffff0000u);
                *(LAS unsigned*)(d + 2144) = (va.z & 0xffffu) | (vb.z << 16); *(LAS unsigned*)(d + 2680) = (va.z >> 16) | (vb.z & 0xffff0000u);
                *(LAS unsigned*)(d + 3216) = (va.w & 0xffffu) | (vb.w << 16); *(LAS unsigned*)(d + 3752) = (va.w >> 16) | (vb.w & 0xffff0000u); } }
        }
        __syncthreads();
#define LV(dt, k8, vf) do { _Pragma("unroll") for (int ks = 0; ks < 8; ++ks) vf[ks] = vfrag(lds + (32 * (dt) + r) * 536 + (16 * ((k8) * 8 + ks) + 4 * h5) * 2); } while (0)
        bf16x8 vfa[8], vfb[8];
        LV(0, 0, vfa);
#pragma unroll 1
        for (int dt = 0; dt < 8; ++dt) {
            f32x16 Oa;
#pragma unroll
            for (int i = 0; i < 16; ++i) Oa[i] = 0.f;
            LV(dt, 1, vfb); SBAR_;
#pragma unroll
            for (int ks = 0; ks < 8; ++ks) Oa = MFMA32(vfa[ks], Pb[ks], Oa);
            SBAR_;
            if (dt + 1 < 8) LV(dt + 1, 0, vfa);
            SBAR_;
#pragma unroll
            for (int ks = 0; ks < 8; ++ks) Oa = MFMA32(vfb[ks], Pb[8 + ks], Oa);
            SBAR_;
#pragma unroll
            for (int g = 0; g < 4; ++g) { u32x2 w; w.x = pk2(Oa[4 * g] * inv, Oa[4 * g + 1] * inv); w.y = pk2(Oa[4 * g + 2] * inv, Oa[4 * g + 3] * inv);
                *(u32x2*)(Om + (size_t)(q0 + r) * DM + mh * 256 + 32 * dt + 8 * g + 4 * h5) = w; }
        }
#undef LV
        __syncthreads();
    }
#undef SBAR_
}
#define XB_TMO      128
#define XB_XCNT(j)  (256  + 64 * (j))
#define XB_XSUB(j)  (1280 + 64 * (j))
#define XB_XGEN(j)  (2304 + 64 * (j))
#define XB_TOP      3328
#define XB_TOPGEN   3392
#define XCD_BAR_WORDS 3456
#define XB_SPIN_CAP (1u << 18)

__device__ __forceinline__ unsigned xb_ld(unsigned* p)              { return __hip_atomic_load(p, __ATOMIC_RELAXED, __HIP_MEMORY_SCOPE_AGENT); }
__device__ __forceinline__ unsigned xb_add(unsigned* p, unsigned v) { return __hip_atomic_fetch_add(p, v, __ATOMIC_RELAXED, __HIP_MEMORY_SCOPE_AGENT); }
__device__ __forceinline__ unsigned xb_xcc_id() { return (unsigned)__builtin_amdgcn_s_getreg((3 << 11) | 20) & 0xFu; }
#define XB_SPIN(cond, bar) do { unsigned _sp = 0; while (cond) { __builtin_amdgcn_s_sleep(1); \
    if ((++_sp & 255u) == 0u) { if (xb_ld(&(bar)[XB_TMO])) break; if (_sp > XB_SPIN_CAP) { atomicAdd(&(bar)[XB_TMO], 1u); break; } } } } while (0)

struct XcdBarrier {
    unsigned* bar; unsigned x;
    volatile LAS unsigned* st;
};

__device__ __forceinline__ XcdBarrier xcd_barrier_post(unsigned* bar, volatile LAS unsigned* st) {
    XcdBarrier b; b.bar = bar; b.x = xb_xcc_id(); b.st = st;
    if (threadIdx.x == 0) (void)xb_add(&bar[XB_XCNT(b.x)], 1u);
    return b;
}
__device__ __forceinline__ void xcd_barrier_complete(unsigned* bar, unsigned x, unsigned& nloc, unsigned& nx) {
    const unsigned G = gridDim.x * gridDim.y * gridDim.z;
    unsigned sum, cnt, mine, sp = 0u;
    for (;;) {
        sum = 0u; cnt = 0u; mine = 0u;
#pragma unroll
        for (unsigned j = 0; j < 16; ++j) { const unsigned c = xb_ld(&bar[XB_XCNT(j)]); sum += c; cnt += (c > 0u) ? 1u : 0u; mine = (j == x) ? c : mine; }
        if (sum == G) break;
        __builtin_amdgcn_s_sleep(1);
        if ((++sp & 255u) == 0u) { if (xb_ld(&bar[XB_TMO])) break; if (sp > XB_SPIN_CAP) { atomicAdd(&bar[XB_TMO], 1u); break; } }
    }
    nloc = mine > 0u ? mine : 1u; nx = cnt > 0u ? cnt : 1u;
}

__device__ __forceinline__ void xcd_barrier(const XcdBarrier& b) {
    asm volatile("s_waitcnt vmcnt(0)" ::: "memory");
    __syncthreads();
    if (threadIdx.x == 0) {
        unsigned* bar = b.bar;
        __builtin_amdgcn_s_waitcnt(0);
        unsigned nloc = b.st[0], nx = b.st[1];
        if (nloc == 0u) { xcd_barrier_complete(bar, b.x, nloc, nx); b.st[0] = nloc; b.st[1] = nx; }
        const unsigned old = xb_add(&bar[XB_XSUB(b.x)], 1u);
        const unsigned gen = old / nloc;
        if (old + 1u == (gen + 1u) * nloc) {
            __builtin_amdgcn_fence(__ATOMIC_RELEASE, "agent");
            asm volatile("s_waitcnt vmcnt(0)" ::: "memory");
            const unsigned og = xb_add(&bar[XB_TOP], 1u);
            const unsigned tg = og / nx;
            if (og + 1u == (tg + 1u) * nx) xb_add(&bar[XB_TOPGEN], 1u);
            else XB_SPIN(xb_ld(&bar[XB_TOPGEN]) == tg, bar);
            __builtin_amdgcn_fence(__ATOMIC_ACQUIRE, "agent");
            xb_add(&bar[XB_XGEN(b.x)], 1u);
            asm volatile("s_waitcnt vmcnt(0)" ::: "memory");
        } else {
            XB_SPIN(xb_ld(&bar[XB_XGEN(b.x)]) == gen, bar);
            __builtin_amdgcn_fence(__ATOMIC_ACQUIRE, "agent");
            asm volatile("s_waitcnt vmcnt(0)" ::: "memory");
        }
    }
    __syncthreads();
}
#ifndef PROBE_DUP_MASK
#define PROBE_DUP_MASK 0
#endif
#ifndef PROBE_EXTRA_SYNC
#define PROBE_EXTRA_SYNC 0
#endif
struct Args { Inputs in; float* out; unsigned char* ws; };
enum { PH_IN_A = 0, PH_MEMKV, PH_PREP, PH_SCAN, PH_IN_B, PH_BAND, PH_GA, PH_T, PH_GB, PH_Y, PH_WO, PH_QM, PH_XATTN, PH_WMO, PH_FFN, PH_DOWN, PH_CONV, PH_COUNT };
__global__ void __launch_bounds__(512, 2) fwd_megakernel(Args args) {
    extern __shared__ __attribute__((aligned(16))) unsigned char lds_raw[];
    cg::grid_group grid = cg::this_grid();
    LAS unsigned char* lds = (LAS unsigned char*)lds_raw;
    const int tid = threadIdx.x, lane = tid & 63, wid = __builtin_amdgcn_readfirstlane(tid >> 6);
    const int G = gridDim.x, gw = blockIdx.x * 8 + wid, NGW = G * 8;
    unsigned char* ws = as_global(args.ws); const Inputs& in = args.in;
    float* ssq = (float*)(ws + WS_SSQ); float* ab = (float*)(ws + WS_AB); bf16_t* halo = (bf16_t*)(ws + WS_HALO); float* Eg = (float*)(ws + WS_E); float* mssq = (float*)(ws + WS_MSSQ);
    bf16_t* memb = (bf16_t*)(ws + WS_MEMB); bf16_t* memkv = (bf16_t*)(ws + WS_MEMKV); bf16_t* Wt = (bf16_t*)(ws + WS_W); bf16_t* xb = (bf16_t*)(ws + WS_XB);
    bf16_t* R0 = (bf16_t*)(ws + WS_BIG); bf16_t* R1 = R0 + SLOTE; bf16_t* R2 = R0 + 2 * SLOTE; bf16_t* R3 = R0 + 3 * SLOTE; bf16_t* R4 = R0 + 4 * SLOTE; bf16_t* R5 = R0 + 5 * SLOTE;
    float* out = as_global(args.out);
    volatile LAS unsigned* bst = (volatile LAS unsigned*)(lds + LDS_BYTES - 64);
    if (threadIdx.x < 16) bst[threadIdx.x] = 0u;
    __syncthreads();
    XcdBarrier xbar = xcd_barrier_post((unsigned*)ws, bst);

    convert_phase(lds, in, Wt, 0, gw, NGW, wid, lane);
    rows_to_bf16(as_global(in.p[0]), xb, ssq, MROWS, gw, NGW, lane);
    rows_to_bf16(as_global(in.p[1]), memb, mssq, MEMROWS, gw, NGW, lane);
    grid.sync();

    for (int l = 0; l < DEPTH; ++l) {
        int rep_ = 0;
        for (int ph = 0; ph < PH_COUNT; ++ph) {
            if (ph == PH_CONV && l == DEPTH - 1) continue;
            const bool dupl = ((PROBE_DUP_MASK >> ph) & 1) && !((ph == PH_PREP || ph == PH_SCAN || ph == PH_BAND) && l != 0);
            unsigned char* ws = as_global(args.ws);
            float* ssq = (float*)(ws + WS_SSQ); float* ab = (float*)(ws + WS_AB); bf16_t* halo = (bf16_t*)(ws + WS_HALO); float* Eg = (float*)(ws + WS_E); float* mssq = (float*)(ws + WS_MSSQ);
            bf16_t* memb = (bf16_t*)(ws + WS_MEMB); bf16_t* memkv = (bf16_t*)(ws + WS_MEMKV); bf16_t* Wt = (bf16_t*)(ws + WS_W); bf16_t* xb = (bf16_t*)(ws + WS_XB);
            bf16_t* R0 = (bf16_t*)(ws + WS_BIG); bf16_t* R1 = R0 + SLOTE; bf16_t* R2 = R0 + 2 * SLOTE; bf16_t* R3 = R0 + 3 * SLOTE; bf16_t* R4 = R0 + 4 * SLOTE; bf16_t* R5 = R0 + 5 * SLOTE;
            int tid = threadIdx.x; asm volatile("" : "+v"(tid)); const int lane = tid & 63, wid = __builtin_amdgcn_readfirstlane(tid >> 6), gw = blockIdx.x * 8 + wid;
            int kind = -1;
            Gemm g{nullptr, nullptr, MROWS, 1024, 1024}; int cshift = 0;
            EpiIn ei{R0, -1, -1, ab, nullptr, ssq, 2}; EpiB eb{nullptr, DM, ssq, nullptr, nullptr, 0}; EpiRes er{out, out, xb, ssq};
            bool sync_after = true;
            switch (ph) {
                case PH_IN_A: kind = 0; g.A = xb; g.Bt = Wt + WO_IN; g.N = 4352; ei.act_slot = 3; ei.ab_tile = 16; ei.halo = halo; sync_after = false; break;
                case PH_MEMKV: kind = 1; g.A = memb; g.Bt = Wt + WO_MKV; g.M = MEMROWS; g.N = 2048; eb.O = memkv; eb.ldc = 2048; eb.ssq = mssq; eb.mode = 0; cshift = 192; break;
                case PH_IN_B: kind = 0; g.A = xb; g.Bt = Wt + WO_IN + (size_t)4352 * 1024; g.N = 3072; ei.slot2 = 4; break;
                case PH_GA: kind = 1; g.A = xb; g.Bt = Wt + WO_IN + (size_t)7424 * 1024; eb.O = R1; eb.mode = 1; sync_after = false; break;
                case PH_T: kind = 1; g.A = R3; g.Bt = Wt + WO_A; eb.O = R2; eb.g1 = R1; eb.mode = 2; sync_after = false; break;
                case PH_GB: kind = 1; g.A = xb; g.Bt = Wt + WO_IN + (size_t)8448 * 1024; eb.O = R1; eb.mode = 1; sync_after = false; break;
                case PH_Y: kind = 1; g.A = R0; g.Bt = Wt + WO_B; eb.O = R4; eb.g1 = R1; eb.t = R2; eb.mode = 3; break;
                case PH_WO: kind = 3; g.A = R4; g.Bt = Wt + WO_O; er.base = (l == 0) ? as_global(in.p[0]) : out; break;
                case PH_QM: kind = 1; g.A = xb; g.Bt = Wt + WO_MQ; eb.O = R0; eb.mode = 0; break;
                case PH_WMO: kind = 3; g.A = R1; g.Bt = Wt + WO_MO; break;
                case PH_FFN: kind = 2; g.A = xb; g.Bt = Wt + WO_GU; g.N = 2 * DFF; break;
                case PH_DOWN: kind = 3; g.A = R0; g.Bt = Wt + WO_DN; g.K = DFF; if (l == DEPTH - 1) er.xb = nullptr; break;
                default: break;
            }
            if (kind >= 0) {
#ifndef SKIP_GEMM
                StaticOrder S; S.init(g.M, g.N, G, (int)((blockIdx.x + cshift) % G));
#ifndef SKIP_G0
                if (kind == 0) gemm_phase<EpiIn, StaticOrder, true, true>(lds, g, S, ei);
#endif
#ifndef SKIP_G1
                if (kind == 1) gemm_phase<EpiB, StaticOrder, true, true>(lds, g, S, eb);
#endif
#ifndef SKIP_G2
                if (kind == 2) { EpiFfn ef{R0, ssq}; gemm_phase<EpiFfn, StaticOrder, true, true>(lds, g, S, ef); }
#endif
#ifndef SKIP_G3
                if (kind == 3) gemm_phase<EpiRes, StaticOrder, true, true>(lds, g, S, er);
#endif
#endif
            } else if (ph == PH_PREP) {
#ifndef SKIP_PREP
                prep_phase(lds, R0, ab, halo, as_global(in.p[4]) + (size_t)l * 4 * 3072, as_global(in.p[5]) + l * 8, as_global(in.p[6]) + l * 8, R4, R5, Eg, (rep_ == 0 && dupl) ? (bf16_t*)out : R0, (rep_ == 0 && dupl) ? (bf16_t*)out + SLOTE : R1, (rep_ == 0 && dupl) ? (bf16_t*)out : R2, tid, wid, lane);
#endif
            } else if (ph == PH_SCAN) {
#ifndef SKIP_SCAN
                scan_phase(lds, R0, R4, R5, Eg, (rep_ == 0 && dupl) ? (bf16_t*)out : R2, tid, wid, lane);
#endif
            } else if (ph == PH_BAND) {
                if (!(rep_ == 1)) oa_norm(R2, R3, as_global(in.p[7]) + l * 128, gw, NGW, lane);
#ifndef SKIP_BAND
                band_phase(lds, R0, R1, R4, (rep_ == 0 && dupl) ? (bf16_t*)out : R0, as_global(in.p[10]), tid, wid, lane);
#endif
            } else if (ph == PH_XATTN) {
#ifndef SKIP_XATTN
                xattn_phase(lds, R0, memkv, R1, tid, wid, lane);
#endif
            } else if (ph == PH_CONV) {
                convert_phase(lds, in, Wt, l + 1, gw, NGW, wid, lane);
            }
            if (dupl && rep_ == 0) { rep_ = 1; --ph; continue; }
            rep_ = 0;
            if (sync_after) { xcd_barrier(xbar); for (int e_ = 0; e_ < PROBE_EXTRA_SYNC; ++e_) xcd_barrier(xbar); }
        }
    }
    final_norm(out, ssq, as_global(in.p[20]), gw, NGW, lane);
}

extern "C" void kernel_launch(void* const* d_in, const int* in_sizes, int n_in, void* d_out, int out_size, void* d_ws, size_t ws_size, hipStream_t stream) {
    static int grid = 0;
    if (grid == 0) {
        if (n_in != 21 || out_size != MROWS * DM || ws_size < WS_END) { fprintf(stderr, "kernel_launch: unexpected shapes (n_in %d out %d ws %zu)\n", n_in, out_size, ws_size); grid = -1; return; }
        int dev = 0, cus = 0, per_cu = 0;
        hipGetDevice(&dev); hipDeviceGetAttribute(&cus, hipDeviceAttributeMultiprocessorCount, dev);
        if (hipFuncSetAttribute((const void*)fwd_megakernel, hipFuncAttributeMaxDynamicSharedMemorySize, LDS_BYTES) != hipSuccess) { fprintf(stderr, "kernel_launch: hipFuncSetAttribute failed\n"); grid = -1; return; }
        if (hipOccupancyMaxActiveBlocksPerMultiprocessor(&per_cu, (const void*)fwd_megakernel, 512, LDS_BYTES) != hipSuccess || per_cu < 1) { fprintf(stderr, "kernel_launch: occupancy query says %d\n", per_cu); per_cu = 1; }
        (void)hipGetLastError();
        grid = cus * 1;
        if (grid > 256) grid = 256;
    }
    if (grid < 0) return;
    if (hipMemsetAsync(d_ws, 0, 16384, stream) != hipSuccess) { fprintf(stderr, "kernel_launch: memset failed\n"); return; }
    Args a{};
    for (int i = 0; i < 21; ++i) a.in.p[i] = (const float*)d_in[i];
    a.out = (float*)d_out; a.ws = (unsigned char*)d_ws;
    void* kargs[] = {&a};
    hipError_t e = hipLaunchCooperativeKernel((const void*)fwd_megakernel, dim3(grid), dim3(512), kargs, LDS_BYTES, stream);
    if (e != hipSuccess) fprintf(stderr, "cooperative launch failed: %s (grid %d)\n", hipGetErrorString(e), grid);
}
```

```cpp
#include <hip/hip_runtime.h>
#include <hip/hip_cooperative_groups.h>
#include <cstdio>
#include <cstdint>
namespace cg = cooperative_groups;
namespace pg8 {
#define PG8_LAS __attribute__((address_space(3)))
typedef unsigned short bf16_t;
typedef short bf16x8 __attribute__((ext_vector_type(8)));
typedef float f32x4 __attribute__((ext_vector_type(4)));
typedef unsigned u32x4 __attribute__((ext_vector_type(4)));
constexpr int BM = 256, BK = 64, HALF = 128, HTB = HALF * BK * 2  , STAGE_BYTES = 8 * HTB, NXCD = 8, WGM = 8;

__host__ __device__ __forceinline__ int lds_byte(int r, int c) { const int st = (r >> 4) * 2 + (c >> 5), rr = r & 15, cc = c & 31, ob = rr * 64 + cc * 2; return st * 1024 + (ob ^ (((ob >> 9) & 1) << 5)); }
__host__ __device__ __forceinline__ void stage_rc(int b, int& R, int& C) { const int st = b / 1024, sb = b % 1024, swz = sb ^ (((sb >> 9) & 1) << 5); R = (st >> 1) * 16 + swz / 64; C = (st & 1) * 32 + (swz % 64) / 2; }
__host__ __device__ __forceinline__ int perm32(int rho) { const int n = rho >> 4, i = rho & 15; return 8 * (i >> 2) + 4 * n + (i & 3); }

struct Unit { int pm, pn; };
struct Gemm { const bf16_t* A; const bf16_t* Bt; int M, N, K; };

struct StaticOrder {
    int nM, nN, nwg, G, c;
    __host__ __device__ void init(int M, int N, int G_, int c_) { nM = M / BM; nN = N / BM; nwg = nM * nN; G = G_; c = c_; }
    __host__ __device__ bool next(int i, Unit& u) const {
        const long L = (long)i * G + c; if (L >= nwg) return false;
        int wgid = (int)L; { const int q = nwg / NXCD, r = nwg % NXCD, xcd = wgid % NXCD, off = wgid / NXCD; wgid = (xcd < r ? xcd * (q + 1) : r * (q + 1) + (xcd - r) * q) + off; }
        const int nig = WGM * nN, gid = wgid / nig, fm = gid * WGM, gsz = (nM - fm) < WGM ? (nM - fm) : WGM;
        u.pm = fm + ((wgid % nig) % gsz); u.pn = (wgid % nig) / gsz; return true;
    }
    __device__ __forceinline__ void a_ready(const Unit&) const {}
    __device__ __forceinline__ void done(const Unit&) const {}
};

typedef float f32x2 __attribute__((ext_vector_type(2)));
typedef __bf16 bf16x2_t __attribute__((ext_vector_type(2)));
typedef unsigned u32x2 __attribute__((ext_vector_type(2)));
__device__ __forceinline__ unsigned pk2(float lo, float hi) { f32x2 v = {lo, hi}; bf16x2_t b = __builtin_convertvector(v, bf16x2_t); return __builtin_bit_cast(unsigned, b); }
template <class Epi, class Sched, bool ALIGN_EPI = false, bool SP2 = false>
__device__ __forceinline__ void gemm_phase(PG8_LAS unsigned char* lds, const Gemm g, const Sched& S, const Epi& E) {
    int tid_ = threadIdx.x; asm volatile("" : "+v"(tid_));
    const int tid = tid_, wid = __builtin_amdgcn_readfirstlane(tid >> 6), lane = tid & 63, wr = wid >> 2, wc = wid & 3, fr = lane & 15, fq = lane >> 4;
    const int K = g.K, nt = K / BK;
    unsigned voffA[2], voffB[2];
#pragma unroll
    for (int i = 0; i < 2; ++i) { int R, C; stage_rc(tid * 16 + i * 8192, R, C); const int Rb = Epi::PERM ? ((R & ~31) + perm32(R & 31)) : R;
        voffA[i] = (unsigned)(R * K + C) * 2u; voffB[i] = (unsigned)(Rb * K + C) * 2u; }
    const size_t kstep = (size_t)(BK * 2);
    const size_t hstep = (size_t)HALF * K * 2;
    const size_t tstep = 2 * hstep;
    const unsigned ldsw = (unsigned)wid * 1024u;
    const int aoff = lds_byte(wr * 64 + fr, fq * 8), boff = lds_byte(wc * 32 + fr, fq * 8);
#define PG8_SA(b, h) (((b) * 2 + (h)) * HTB)
#define PG8_SB(b, h) ((4 + (b) * 2 + (h)) * HTB)
#define PG8_STAGE(bufoff, gbase, voff) do { _Pragma("unroll") for (int _i = 0; _i < 2; ++_i) \
        __builtin_amdgcn_global_load_lds((const unsigned*)((const char*)(gbase) + (voff)[_i]), (PG8_LAS unsigned*)(lds + (bufoff) + ldsw + _i * 8192), 16, 0, 0); } while (0)
#define PG8_LDA(dst, b, h) do { _Pragma("unroll") for (int m = 0; m < 4; ++m) _Pragma("unroll") for (int k = 0; k < 2; ++k) dst[m][k] = *(const PG8_LAS bf16x8*)(lds + PG8_SA(b, h) + aoff + m * 2048 + k * 1024); } while (0)
#define PG8_LDB(dst, b, h) do { _Pragma("unroll") for (int n = 0; n < 2; ++n) _Pragma("unroll") for (int k = 0; k < 2; ++k) dst[n][k] = *(const PG8_LAS bf16x8*)(lds + PG8_SB(b, h) + boff + n * 2048 + k * 1024); } while (0)
#define PG8_MMA(ai, bj, At, Bt) do { __builtin_amdgcn_s_setprio(1); _Pragma("unroll") for (int m = 0; m < 4; ++m) _Pragma("unroll") for (int n = 0; n < 2; ++n) _Pragma("unroll") for (int k = 0; k < 2; ++k) \
        acc[ai][bj][m][n] = __builtin_amdgcn_mfma_f32_16x16x32_bf16(Bt[n][k], At[m][k], acc[ai][bj][m][n], 0, 0, 0); __builtin_amdgcn_s_setprio(0); } while (0)
#define PG8_WAIT_V(n) asm volatile("s_waitcnt vmcnt(" #n ")" ::: "memory")
#define PG8_WAIT_L(n) asm volatile("s_waitcnt lgkmcnt(" #n ")" ::: "memory")
#define PG8_BAR __builtin_amdgcn_s_barrier()
#define PG8_SCHED __builtin_amdgcn_sched_barrier(0)
    Unit cur, nxt; int ui = 0;
    if (!S.next(0, cur)) return;
    f32x4 acc[2][2][4][2];
#pragma unroll
    for (int a = 0; a < 2; ++a)
#pragma unroll
        for (int b = 0; b < 2; ++b)
#pragma unroll
            for (int m = 0; m < 4; ++m)
#pragma unroll
                for (int n = 0; n < 2; ++n) acc[a][b][m][n] = (f32x4){0.f, 0.f, 0.f, 0.f};
    bf16x8 At[4][2], B0[2][2], B1[2][2];
    const char* cA = (const char*)g.A + (size_t)cur.pm * tstep; const char* cB = (const char*)g.Bt + (size_t)cur.pn * tstep;
    S.a_ready(cur);
    if constexpr (SP2) {
        PG8_STAGE(PG8_SB(0, 0), cB, voffB); PG8_STAGE(PG8_SB(0, 1), cB + hstep, voffB); PG8_STAGE(PG8_SA(0, 0), cA, voffA); PG8_STAGE(PG8_SA(0, 1), cA + hstep, voffA);
        if (wr == 1) PG8_BAR;
        PG8_WAIT_V(2); PG8_BAR;
        PG8_STAGE(PG8_SB(1, 0), cB + kstep, voffB); PG8_STAGE(PG8_SA(1, 0), cA + kstep, voffA); PG8_STAGE(PG8_SB(1, 1), cB + hstep + kstep, voffB);
        PG8_WAIT_V(6); PG8_BAR;
    } else {
        PG8_STAGE(PG8_SB(0, 0), cB, voffB); PG8_STAGE(PG8_SA(0, 0), cA, voffA); PG8_STAGE(PG8_SB(0, 1), cB + hstep, voffB); PG8_STAGE(PG8_SA(0, 1), cA + hstep, voffA);
        if (wr == 1) PG8_BAR;
        PG8_WAIT_V(4); PG8_BAR;
        PG8_STAGE(PG8_SB(1, 0), cB + kstep, voffB); PG8_STAGE(PG8_SA(1, 0), cA + kstep, voffA); PG8_STAGE(PG8_SB(1, 1), cB + hstep + kstep, voffB);
        PG8_WAIT_V(6); PG8_BAR;
    }
    for (;;) {
        const bool has_next = S.next(ui + 1, nxt);
        const char* nA = has_next ? (const char*)g.A + (size_t)nxt.pm * tstep : cA; const char* nB = has_next ? (const char*)g.Bt + (size_t)nxt.pn * tstep : cB;
        for (int t = 0; t < nt; t += 2) {
            const bool last = (t == nt - 2);
            const char* a1 = cA + (size_t)(t + 1) * kstep;
            const char* a2 = last ? nA : cA + (size_t)(t + 2) * kstep; const char* b2 = last ? nB : cB + (size_t)(t + 2) * kstep;
            const char* a3 = a2 + kstep; const char* b3 = b2 + kstep;
            if (last && has_next) S.a_ready(nxt);
            if constexpr (SP2) {
            PG8_LDB(B0, 0, 0); PG8_LDB(B1, 0, 1); PG8_SCHED; PG8_LDA(At, 0, 0); PG8_STAGE(PG8_SA(1, 1), a1 + hstep, voffA);
            PG8_WAIT_V(8); PG8_WAIT_L(0); PG8_BAR; PG8_MMA(0, 0, At, B0); PG8_MMA(0, 1, At, B1); PG8_BAR; PG8_SCHED;
            PG8_LDA(At, 0, 1); PG8_STAGE(PG8_SB(0, 0), b2, voffB); PG8_STAGE(PG8_SB(0, 1), b2 + hstep, voffB); PG8_STAGE(PG8_SA(0, 0), a2, voffA);
            PG8_WAIT_V(8); PG8_WAIT_L(0); PG8_BAR; PG8_MMA(1, 0, At, B0); PG8_MMA(1, 1, At, B1); PG8_BAR; PG8_SCHED;
            PG8_LDB(B0, 1, 0); PG8_LDB(B1, 1, 1); PG8_SCHED; PG8_LDA(At, 1, 0); PG8_STAGE(PG8_SA(0, 1), a2 + hstep, voffA);
            PG8_WAIT_V(8); PG8_WAIT_L(0); PG8_BAR; PG8_MMA(0, 0, At, B0); PG8_MMA(0, 1, At, B1); PG8_BAR; PG8_SCHED;
            PG8_LDA(At, 1, 1); PG8_STAGE(PG8_SB(1, 0), b3, voffB); PG8_STAGE(PG8_SB(1, 1), b3 + hstep, voffB); PG8_STAGE(PG8_SA(1, 0), a3, voffA);
            PG8_WAIT_V(8); PG8_WAIT_L(0); PG8_BAR; PG8_MMA(1, 0, At, B0); PG8_MMA(1, 1, At, B1); PG8_BAR; PG8_SCHED;
            } else {
            PG8_LDB(B0, 0, 0); PG8_SCHED; PG8_LDA(At, 0, 0); PG8_STAGE(PG8_SA(1, 1), a1 + hstep, voffA);
            PG8_WAIT_L(8); PG8_BAR; PG8_WAIT_L(0); PG8_MMA(0, 0, At, B0); PG8_BAR; PG8_SCHED;
            PG8_LDB(B1, 0, 1); PG8_STAGE(PG8_SB(0, 0), b2, voffB);
            PG8_BAR; PG8_WAIT_L(0); PG8_MMA(0, 1, At, B1); PG8_BAR;
            PG8_LDA(At, 0, 1); PG8_STAGE(PG8_SA(0, 0), a2, voffA);
            PG8_BAR; PG8_WAIT_L(0); PG8_MMA(1, 0, At, B0); PG8_BAR; PG8_SCHED;
            PG8_STAGE(PG8_SB(0, 1), b2 + hstep, voffB);
            PG8_WAIT_V(6); PG8_BAR; PG8_MMA(1, 1, At, B1); PG8_BAR;
            PG8_LDB(B0, 1, 0); PG8_SCHED; PG8_LDA(At, 1, 0); PG8_STAGE(PG8_SA(0, 1), a2 + hstep, voffA);
            PG8_WAIT_L(8); PG8_BAR; PG8_WAIT_L(0); PG8_MMA(0, 0, At, B0); PG8_BAR; PG8_SCHED;
            PG8_LDB(B1, 1, 1); PG8_STAGE(PG8_SB(1, 0), b3, voffB);
            PG8_BAR; PG8_WAIT_L(0); PG8_MMA(0, 1, At, B1); PG8_BAR;
            PG8_LDA(At, 1, 1); PG8_STAGE(PG8_SA(1, 0), a3, voffA);
            PG8_BAR; PG8_WAIT_L(0); PG8_MMA(1, 0, At, B0); PG8_BAR; PG8_SCHED;
            PG8_STAGE(PG8_SB(1, 1), b3 + hstep, voffB);
            PG8_WAIT_V(6); PG8_BAR; PG8_MMA(1, 1, At, B1); PG8_BAR;
            }
        }
        if constexpr (ALIGN_EPI) { if (wr == 0) PG8_BAR; }
        if constexpr (!Epi::AFTER_DRAIN) { E(acc, cur, wr, wc, fr, fq); S.done(cur); }
        if (!has_next) break;
#pragma unroll
        for (int a = 0; a < 2; ++a)
#pragma unroll
            for (int b = 0; b < 2; ++b)
#pragma unroll
                for (int m = 0; m < 4; ++m)
#pragma unroll
                    for (int n = 0; n < 2; ++n) acc[a][b][m][n] = (f32x4){0.f, 0.f, 0.f, 0.f};
        cur = nxt; cA = nA; cB = nB; ++ui;
        if constexpr (ALIGN_EPI) { if (wr == 1) PG8_BAR; }
    }
    PG8_WAIT_V(0);
    if constexpr (!ALIGN_EPI) { if (wr == 0) PG8_BAR; }
    PG8_BAR;
    if constexpr (Epi::AFTER_DRAIN) { E.fused(acc, cur, wr, wc, fr, fq, lds, wid, lane); S.done(cur); }
#undef PG8_SA
#undef PG8_SB
#undef PG8_STAGE
#undef PG8_LDA
#undef PG8_LDB
#undef PG8_MMA
#undef PG8_WAIT_V
#undef PG8_WAIT_L
#undef PG8_BAR
#undef PG8_SCHED
}
}
using namespace pg8;
#define LAS __attribute__((address_space(3)))
#define GAS __attribute__((address_space(1)))
template <class T> __device__ __forceinline__ T* as_global(T* p) { return (T*)(GAS T*)p; }
typedef short s16x4 __attribute__((ext_vector_type(4)));
typedef float f32x16 __attribute__((ext_vector_type(16)));

constexpr int BATCH = 8, SEQ = 2048, DM = 1024, MROWS = BATCH * SEQ, DEPTH = 2, NCH = 32;
constexpr int DFF = 2816, NIN = 9232, NIN_PAD = 9472, MEMROWS = BATCH * 256;
constexpr float EPS = 1e-6f, LOG2E = 1.4426950408889634f;
constexpr float QB_SCALE = 0.125f * LOG2E, QM_SCALE = 0.0625f * LOG2E;
constexpr size_t MiB = 1u << 20, SLOTB = 32 * MiB, SLOTE = (size_t)MROWS * DM;
constexpr size_t WS_SSQ = 1 * MiB, WS_AB = 2 * MiB, WS_HALO = 3 * MiB, WS_E = 8 * MiB, WS_MSSQ = 8 * MiB + 65536;
constexpr size_t WS_MEMB = 12 * MiB, WS_MEMKV = 16 * MiB, WS_W = 24 * MiB, WS_XB = 76 * MiB, WS_BIG = 108 * MiB, WS_END = 284 * MiB;
constexpr size_t WO_IN = 0, WO_A = WO_IN + (size_t)NIN_PAD * 1024, WO_B = WO_A + 1048576, WO_O = WO_B + 1048576, WO_MQ = WO_O + 1048576,
                 WO_MKV = WO_MQ + 1048576, WO_MO = WO_MKV + 2097152, WO_GU = WO_MO + 1048576, WO_DN = WO_GU + (size_t)2 * DFF * 1024, WO_END = WO_DN + (size_t)DFF * 1024;
static_assert(WS_W + WO_END * 2 <= WS_XB, "weights fit");
constexpr int LDS_BYTES = 147456;

__device__ __forceinline__ float bf2f(unsigned short b) { return __uint_as_float((unsigned)b << 16); }
__device__ __forceinline__ float bflo(unsigned w) { return __uint_as_float(w << 16); }
__device__ __forceinline__ float bfhi(unsigned w) { return __uint_as_float(w & 0xffff0000u); }
__device__ __forceinline__ float sigmoidf_(float x) { return __builtin_amdgcn_rcpf(1.f + __expf(-x)); }
__device__ __forceinline__ float siluf_(float x) { return x * __builtin_amdgcn_rcpf(1.f + __expf(-x)); }
__device__ __forceinline__ float row_rstd(const float* ssq, int row) {
    const f32x4* p = (const f32x4*)(ssq + (size_t)row * 16); const f32x4 a = p[0], b = p[1], c = p[2], d = p[3];
    const float s = ((a.x + a.y) + (a.z + a.w)) + ((b.x + b.y) + (b.z + b.w)) + ((c.x + c.y) + (c.z + c.w)) + ((d.x + d.y) + (d.z + d.w));
    return rsqrtf(s * (1.f / 1024.f) + EPS);
}
__device__ __forceinline__ float wave_sum(float v) {
#pragma unroll
    for (int o = 1; o < 64; o <<= 1) v += __shfl_xor(v, o);
    return v;
}

struct EpiIn {
    static constexpr bool PERM = true, AFTER_DRAIN = false;
    bf16_t* slot0; int act_slot, ab_tile; float* ab; bf16_t* halo; const float* ssq; int slot2;
    __device__ __forceinline__ void operator()(const f32x4 (&acc)[2][2][4][2], const Unit& u, int wr, int wc, int fr, int fq) const {
        float rs[2][4];
#pragma unroll
        for (int ai = 0; ai < 2; ++ai)
#pragma unroll
            for (int m = 0; m < 4; ++m) rs[ai][m] = row_rstd(ssq, u.pm * BM + ai * HALF + wr * 64 + m * 16 + fr);
        if (u.pn == ab_tile) {
            if (wc == 0 && fq < 2) {
#pragma unroll
                for (int ai = 0; ai < 2; ++ai)
#pragma unroll
                    for (int m = 0; m < 4; ++m) { const int row = u.pm * BM + ai * HALF + wr * 64 + m * 16 + fr;
#pragma unroll
                        for (int n = 0; n < 2; ++n) *(f32x4*)(ab + (size_t)row * 16 + 8 * fq + 4 * n) = acc[ai][0][m][n] * rs[ai][m]; }
            }
            return;
        }
        const int slot = u.pn >> 2; bf16_t* base = slot0 + (size_t)(slot == 2 ? slot2 : slot) * SLOTE; const bool act = (slot == act_slot);
        const int col0 = (u.pn & 3) * BM + wc * 32 + 8 * fq;
#pragma unroll
        for (int ai = 0; ai < 2; ++ai)
#pragma unroll
            for (int m = 0; m < 4; ++m) { const int row = u.pm * BM + ai * HALF + wr * 64 + m * 16 + fr; bf16_t* rowp = base + (size_t)row * DM + col0;
#pragma unroll
                for (int bj = 0; bj < 2; ++bj) { f32x4 v0 = acc[ai][bj][m][0] * rs[ai][m], v1 = acc[ai][bj][m][1] * rs[ai][m];
                    if (act) { v0 = (f32x4){siluf_(v0[0]), siluf_(v0[1]), siluf_(v0[2]), siluf_(v0[3])}; v1 = (f32x4){siluf_(v1[0]), siluf_(v1[1]), siluf_(v1[2]), siluf_(v1[3])}; }
                    u32x4 w; w.x = pk2(v0[0], v0[1]); w.y = pk2(v0[2], v0[3]); w.z = pk2(v1[0], v1[1]); w.w = pk2(v1[2], v1[3]);
                    *(u32x4*)(rowp + bj * HALF) = w;
                    if (halo && slot < 3 && m == 3 && fr >= 13) { const int hrow = (row >> 6) * 3 + (fr - 13); *(u32x4*)(halo + (size_t)hrow * 3072 + slot * 1024 + col0 + bj * HALF) = w; }
                } }
    }
};
struct EpiB {
    static constexpr bool PERM = true, AFTER_DRAIN = false;
    bf16_t* O; int ldc; const float* ssq; const bf16_t* g1; const bf16_t* t; int mode;
    __device__ __forceinline__ void operator()(const f32x4 (&acc)[2][2][4][2], const Unit& u, int wr, int wc, int fr, int fq) const {
        const int col0 = u.pn * BM + wc * 32 + 8 * fq;
#pragma unroll
        for (int ai = 0; ai < 2; ++ai)
#pragma unroll
            for (int m = 0; m < 4; ++m) { const int row = u.pm * BM + ai * HALF + wr * 64 + m * 16 + fr; const size_t off = (size_t)row * ldc + col0;
                float rs = 1.f; if (mode < 2) rs = row_rstd(ssq, row);
#pragma unroll
                for (int bj = 0; bj < 2; ++bj) { f32x4 v0 = acc[ai][bj][m][0] * rs, v1 = acc[ai][bj][m][1] * rs;
                    if (mode == 1) { v0 = (f32x4){sigmoidf_(v0[0]), sigmoidf_(v0[1]), sigmoidf_(v0[2]), sigmoidf_(v0[3])}; v1 = (f32x4){sigmoidf_(v1[0]), sigmoidf_(v1[1]), sigmoidf_(v1[2]), sigmoidf_(v1[3])}; }
                    if (mode >= 2) { const u32x4 g = *(const u32x4*)(g1 + off + bj * HALF);
                        v0 = v0 * (f32x4){bflo(g.x), bfhi(g.x), bflo(g.y), bfhi(g.y)}; v1 = v1 * (f32x4){bflo(g.z), bfhi(g.z), bflo(g.w), bfhi(g.w)};
                        if (mode == 3) { const u32x4 tt = *(const u32x4*)(t + off + bj * HALF);
                            v0 = v0 + (f32x4){bflo(tt.x), bfhi(tt.x), bflo(tt.y), bfhi(tt.y)}; v1 = v1 + (f32x4){bflo(tt.z), bfhi(tt.z), bflo(tt.w), bfhi(tt.w)}; } }
                    u32x4 w; w.x = pk2(v0[0], v0[1]); w.y = pk2(v0[2], v0[3]); w.z = pk2(v1[0], v1[1]); w.w = pk2(v1[2], v1[3]);
                    *(u32x4*)(O + off + bj * HALF) = w; } }
    }
};
struct EpiFfn {
    static constexpr bool PERM = true, AFTER_DRAIN = false;
    bf16_t* O; const float* ssq;
    __device__ __forceinline__ void operator()(const f32x4 (&acc)[2][2][4][2], const Unit& u, int wr, int wc, int fr, int fq) const {
        const int col0 = u.pn * HALF + wc * 32 + 8 * fq;
#pragma unroll
        for (int ai = 0; ai < 2; ++ai)
#pragma unroll
            for (int m = 0; m < 4; ++m) { const int row = u.pm * BM + ai * HALF + wr * 64 + m * 16 + fr; const float rs = row_rstd(ssq, row);
                const f32x4 g0 = acc[ai][0][m][0] * rs, g1 = acc[ai][0][m][1] * rs, u0 = acc[ai][1][m][0] * rs, u1 = acc[ai][1][m][1] * rs;
                u32x4 w; w.x = pk2(siluf_(g0[0]) * u0[0], siluf_(g0[1]) * u0[1]); w.y = pk2(siluf_(g0[2]) * u0[2], siluf_(g0[3]) * u0[3]);
                w.z = pk2(siluf_(g1[0]) * u1[0], siluf_(g1[1]) * u1[1]); w.w = pk2(siluf_(g1[2]) * u1[2], siluf_(g1[3]) * u1[3]);
                *(u32x4*)(O + (size_t)row * DFF + col0) = w; }
    }
};
struct EpiRes {
    static constexpr bool PERM = false, AFTER_DRAIN = false;
    const float* base; float* out; bf16_t* xb; float* ssq;
    __device__ __forceinline__ void operator()(const f32x4 (&acc)[2][2][4][2], const Unit& u, int wr, int wc, int fr, int fq) const {
        const int col0 = u.pn * BM + wc * 32 + 4 * fq;
#pragma unroll
        for (int ai = 0; ai < 2; ++ai)
#pragma unroll
            for (int m = 0; m < 4; ++m) { const int row = u.pm * BM + ai * HALF + wr * 64 + m * 16 + fr; const size_t off = (size_t)row * DM + col0; float s = 0.f;
#pragma unroll
                for (int bj = 0; bj < 2; ++bj)
#pragma unroll
                    for (int n = 0; n < 2; ++n) { const size_t o2 = off + bj * HALF + n * 16; const f32x4 v = *(const f32x4*)(base + o2) + acc[ai][bj][m][n];
                        *(f32x4*)(out + o2) = v; if (xb) { u32x2 w; w.x = pk2(v[0], v[1]); w.y = pk2(v[2], v[3]); *(u32x2*)(xb + o2) = w; }
                        s += (v[0] * v[0] + v[1] * v[1]) + (v[2] * v[2] + v[3] * v[3]); }
                s += __shfl_xor(s, 16); s += __shfl_xor(s, 32);
                if (fq == 0) ssq[(size_t)row * 16 + u.pn * 4 + wc] = s; }
    }
};
__device__ __forceinline__ int map_row(int mode, int n) {
    if (mode == 1) return n >= 4112 ? n + 240 : n;
    if (mode == 2) { const int m = n < DFF ? n : n - DFF; return (m >> 7) * 256 + (n < DFF ? 0 : 128) + (m & 127); }
    return n;
}
__device__ __forceinline__ void tr_item(const float* W, int K, int N, bf16_t* WT, int mode, const float* g, LAS float* scr, int item, int lane) {
    const int nblk = (N + 63) / 64, kb = item / nblk, nb = item % nblk, k0 = 64 * kb, n0 = 64 * nb;
    const int nl = n0 + 4 * (lane & 15), kr = lane >> 4;
    f32x4 v[16];
#pragma unroll
    for (int i = 0; i < 16; ++i) { const int kk = 4 * i + kr; v[i] = (nl < N) ? *(const f32x4*)(W + (size_t)(k0 + kk) * N + nl) : (f32x4){0.f, 0.f, 0.f, 0.f}; }
#pragma unroll
    for (int i = 0; i < 16; ++i) { const int kk = 4 * i + kr; f32x4 x = v[i]; if (g) x = x * g[k0 + kk]; *(LAS f32x4*)(scr + kk * 68 + 4 * (lane & 15)) = x; }
    asm volatile("s_waitcnt lgkmcnt(0)" ::: "memory");
    const int c = lane & 7;
#pragma unroll
    for (int j = 0; j < 8; ++j) { const int nn = (lane >> 3) + 8 * j, n = n0 + nn;
        if (n < N) { float sc = 1.f; if (mode == 1 && n >= 4112 && n < 5136) sc = QB_SCALE; if (mode == 3) sc = QM_SCALE;
            const LAS float* s = scr + (8 * c) * 68 + nn;
            u32x4 o; o.x = pk2(s[0 * 68] * sc, s[1 * 68] * sc); o.y = pk2(s[2 * 68] * sc, s[3 * 68] * sc); o.z = pk2(s[4 * 68] * sc, s[5 * 68] * sc); o.w = pk2(s[6 * 68] * sc, s[7 * 68] * sc);
            *(u32x4*)(WT + (size_t)map_row(mode, n) * K + k0 + 8 * c) = o; } }
    asm volatile("s_waitcnt lgkmcnt(0)" ::: "memory");
}
struct Inputs { const float* p[21]; };
__device__ __forceinline__ void convert_phase(LAS unsigned char* lds, const Inputs& in, bf16_t* Wt, int l, int gw, int NGW, int wid, int lane) {
    LAS float* scr = (LAS float*)(lds + wid * 18432);
    constexpr int I_IN = 16 * 145, I_SQ = 16 * 16, I_MKV = 16 * 32, I_GU = 16 * 88, I_DN = 44 * 16;
    constexpr int NITEMS = I_IN + 5 * I_SQ + I_MKV + I_GU + I_DN;
    for (int it = gw; it < NITEMS; it += NGW) {
        int r = it;
        if (r < I_IN) { tr_item(as_global(in.p[3]) + (size_t)l * 1024 * NIN, 1024, NIN, Wt + WO_IN, 1, as_global(in.p[2]) + l * 1024, scr, r, lane); continue; } r -= I_IN;
        if (r < I_SQ) { tr_item(as_global(in.p[8]) + (size_t)l * 1048576, 1024, 1024, Wt + WO_A, 0, nullptr, scr, r, lane); continue; } r -= I_SQ;
        if (r < I_SQ) { tr_item(as_global(in.p[9]) + (size_t)l * 1048576, 1024, 1024, Wt + WO_B, 0, nullptr, scr, r, lane); continue; } r -= I_SQ;
        if (r < I_SQ) { tr_item(as_global(in.p[11]) + (size_t)l * 1048576, 1024, 1024, Wt + WO_O, 0, nullptr, scr, r, lane); continue; } r -= I_SQ;
        if (r < I_SQ) { tr_item(as_global(in.p[14]) + (size_t)l * 1048576, 1024, 1024, Wt + WO_MQ, 3, as_global(in.p[12]) + l * 1024, scr, r, lane); continue; } r -= I_SQ;
        if (r < I_SQ) { tr_item(as_global(in.p[16]) + (size_t)l * 1048576, 1024, 1024, Wt + WO_MO, 0, nullptr, scr, r, lane); continue; } r -= I_SQ;
        if (r < I_MKV) { tr_item(as_global(in.p[15]) + (size_t)l * 2097152, 1024, 2048, Wt + WO_MKV, 0, as_global(in.p[13]) + l * 1024, scr, r, lane); continue; } r -= I_MKV;
        if (r < I_GU) { tr_item(as_global(in.p[18]) + (size_t)l * 1024 * 2 * DFF, 1024, 2 * DFF, Wt + WO_GU, 2, as_global(in.p[17]) + l * 1024, scr, r, lane); continue; } r -= I_GU;
        tr_item(as_global(in.p[19]) + (size_t)l * DFF * 1024, DFF, 1024, Wt + WO_DN, 0, nullptr, scr, r, lane);
    }
    for (int i = gw * 64 + lane; i < 240 * 128; i += NGW * 64) *(u32x4*)(Wt + WO_IN + (size_t)4112 * 1024 + (size_t)i * 8) = (u32x4){0u, 0u, 0u, 0u};
}
__device__ __forceinline__ void rows_to_bf16(const float* x, bf16_t* xb, float* ssq, int nrows, int gw, int NGW, int lane) {
    for (int m = gw; m < nrows; m += NGW) {
        const f32x4* xr = (const f32x4*)(x + (size_t)m * DM) + lane; f32x4 v[4]; float s = 0.f;
#pragma unroll
        for (int j = 0; j < 4; ++j) { v[j] = xr[64 * j]; s += (v[j].x * v[j].x + v[j].y * v[j].y) + (v[j].z * v[j].z + v[j].w * v[j].w); }
        s = wave_sum(s);
        u32x2* o8 = (u32x2*)(xb + (size_t)m * DM) + lane;
#pragma unroll
        for (int j = 0; j < 4; ++j) { u32x2 w; w.x = pk2(v[j].x, v[j].y); w.y = pk2(v[j].z, v[j].w); o8[64 * j] = w; }
        if (lane < 16) ssq[(size_t)m * 16 + lane] = (lane == 0) ? s : 0.f;
    }
}
__device__ __forceinline__ void final_norm(float* out, const float* ssq, const float* g, int gw, int NGW, int lane) {
    for (int m = gw; m < MROWS; m += NGW) {
        const float rs = row_rstd(ssq, m); f32x4* xr = (f32x4*)(out + (size_t)m * DM) + lane; const f32x4* gr = (const f32x4*)g + lane;
#pragma unroll
        for (int j = 0; j < 4; ++j) xr[64 * j] = xr[64 * j] * rs * gr[64 * j];
    }
}
__device__ __forceinline__ void oa_norm(const bf16_t* o, bf16_t* za, const float* hn, int gw, int NGW, int lane) {
    for (int m = gw; m < MROWS; m += NGW) {
        const size_t off = (size_t)m * DM + lane * 16; const u32x4 a0 = *(const u32x4*)(o + off), a1 = *(const u32x4*)(o + off + 8); const u32x4 z0 = *(const u32x4*)(za + off), z1 = *(const u32x4*)(za + off + 8);
        float v[16] = {bflo(a0.x), bfhi(a0.x), bflo(a0.y), bfhi(a0.y), bflo(a0.z), bfhi(a0.z), bflo(a0.w), bfhi(a0.w), bflo(a1.x), bfhi(a1.x), bflo(a1.y), bfhi(a1.y), bflo(a1.z), bfhi(a1.z), bflo(a1.w), bfhi(a1.w)};
        float z[16] = {bflo(z0.x), bfhi(z0.x), bflo(z0.y), bfhi(z0.y), bflo(z0.z), bfhi(z0.z), bflo(z0.w), bfhi(z0.w), bflo(z1.x), bfhi(z1.x), bflo(z1.y), bfhi(z1.y), bflo(z1.z), bfhi(z1.z), bflo(z1.w), bfhi(z1.w)};
        float s = 0.f;
#pragma unroll
        for (int j = 0; j < 16; ++j) s += v[j] * v[j];
        s += __shfl_xor(s, 1); s += __shfl_xor(s, 2); s += __shfl_xor(s, 4);
        const float rs = rsqrtf(s * (1.f / 128.f) + EPS); const float* h = hn + (lane & 7) * 16;
#pragma unroll
        for (int j = 0; j < 16; ++j) v[j] = v[j] * rs * h[j] * z[j];
        u32x4 w0, w1; w0.x = pk2(v[0], v[1]); w0.y = pk2(v[2], v[3]); w0.z = pk2(v[4], v[5]); w0.w = pk2(v[6], v[7]); w1.x = pk2(v[8], v[9]); w1.y = pk2(v[10], v[11]); w1.z = pk2(v[12], v[13]); w1.w = pk2(v[14], v[15]);
        *(u32x4*)(za + off) = w0; *(u32x4*)(za + off + 8) = w1;
    }
}

#define MFMA16(a, b, c) __builtin_amdgcn_mfma_f32_16x16x32_bf16((a), (b), (c), 0, 0, 0)
#define MFMA32(a, b, c) __builtin_amdgcn_mfma_f32_32x32x16_bf16((a), (b), (c), 0, 0, 0)
constexpr int RP = 272, LP = 68;
constexpr int PR_QS = 0, PR_KS = 17408, PR_RHS = 34816, PR_LM = 104448, PR_G = 121856, PR_B = 122112, PR_CW = 122368, PR_DP = 128512;
#define LBAR() asm volatile("s_waitcnt lgkmcnt(0)\n\ts_barrier" ::: "memory")
__device__ __forceinline__ void prep_phase(LAS unsigned char* lds, bf16_t* R0, const float* ab, const bf16_t* halo, const float* convw, const float* a_log, const float* dt_bias,
                                           bf16_t* KT, bf16_t* PT, float* Eg, bf16_t* Oq, bf16_t* Ow, bf16_t* Ou, int tid, int wid, int lane) {
    LAS unsigned char* qs = lds + PR_QS; LAS unsigned char* ks = lds + PR_KS; LAS float* rhs = (LAS float*)(lds + PR_RHS); LAS float* Lm = (LAS float*)(lds + PR_LM);
    LAS float* Gs = (LAS float*)(lds + PR_G); LAS float* Bs = (LAS float*)(lds + PR_B); LAS float* cw = (LAS float*)(lds + PR_CW);
    int cw_head = -1;
    float pa, pb; { const int u0 = (int)blockIdx.x < BATCH * NCH * 8 ? (int)blockIdx.x : 0; pa = ab[(size_t)((u0 >> 3) * 64 + lane) * 16 + (u0 & 7)]; pb = ab[(size_t)((u0 >> 3) * 64 + lane) * 16 + 8 + (u0 & 7)]; }
#pragma unroll 1
    for (int unit = blockIdx.x; unit < BATCH * NCH * 8; unit += gridDim.x) {
        const int h = unit & 7, row0 = (unit >> 3) * 64, nchunk = (unit >> 3) & 31;
        const bool restaged = (h != cw_head);
        if (h != cw_head) {
            for (int i = tid; i < 4 * 3 * 128; i += 512) { const int tap = i / 384, rem = i % 384; cw[i] = convw[(size_t)tap * 3072 + (rem >> 7) * 1024 + h * 128 + (rem & 127)]; }
            cw_head = h;
        }
        {
            const float a = pa, bt = pb;
            { const int un = unit + (int)gridDim.x < BATCH * NCH * 8 ? unit + (int)gridDim.x : unit; pa = ab[(size_t)((un >> 3) * 64 + lane) * 16 + (un & 7)]; pb = ab[(size_t)((un >> 3) * 64 + lane) * 16 + 8 + (un & 7)]; }
            const float x = a + dt_bias[h]; const float sp = x > 20.f ? x : __logf(1.f + __expf(x)); float g = -__expf(a_log[h]) * sp;
#pragma unroll
            for (int o = 1; o < 64; o <<= 1) { const float y = __shfl_up(g, o); if (lane >= o) g += y; }
            Gs[lane] = g; Bs[lane] = 1.f / (1.f + __expf(-bt)); if (wid == 0 && lane == 63) Eg[unit] = __expf(g);
        }
        if (restaged) LBAR(); else asm volatile("s_waitcnt lgkmcnt(0)" ::: "memory");
        {
            const int t = tid >> 3, c0 = (tid & 7) * 16; const float beta = Bs[t], eg = __expf(Gs[t]);
#pragma unroll
            for (int mat = 0; mat < 3; ++mat) {
                const bf16_t* src = R0 + (size_t)mat * SLOTE; float acc[16];
#pragma unroll
                for (int j = 0; j < 16; ++j) acc[j] = 0.f;
#pragma unroll
                for (int i = 0; i < 4; ++i) { const int tt = t - 3 + i; u32x4 x0 = {0u, 0u, 0u, 0u}, x1 = {0u, 0u, 0u, 0u};
                    if (tt >= 0) { const bf16_t* p = src + (size_t)(row0 + tt) * DM + h * 128 + c0; x0 = *(const u32x4*)p; x1 = *(const u32x4*)(p + 8); }
                    else if (nchunk > 0) { const bf16_t* p = halo + (size_t)(((row0 >> 6) - 1) * 3 + (3 + tt)) * 3072 + mat * 1024 + h * 128 + c0; x0 = *(const u32x4*)p; x1 = *(const u32x4*)(p + 8); }
                    const LAS f32x4* wp = (const LAS f32x4*)(cw + i * 384 + mat * 128 + c0); const f32x4 w0 = wp[0], w1 = wp[1], w2 = wp[2], w3 = wp[3];
                    acc[0] += w0.x * bflo(x0.x); acc[1] += w0.y * bfhi(x0.x); acc[2] += w0.z * bflo(x0.y); acc[3] += w0.w * bfhi(x0.y);
                    acc[4] += w1.x * bflo(x0.z); acc[5] += w1.y * bfhi(x0.z); acc[6] += w1.z * bflo(x0.w); acc[7] += w1.w * bfhi(x0.w);
                    acc[8] += w2.x * bflo(x1.x); acc[9] += w2.y * bfhi(x1.x); acc[10] += w2.z * bflo(x1.y); acc[11] += w2.w * bfhi(x1.y);
                    acc[12] += w3.x * bflo(x1.z); acc[13] += w3.y * bfhi(x1.z); acc[14] += w3.z * bflo(x1.w); acc[15] += w3.w * bfhi(x1.w); }
                float ss = 0.f;
#pragma unroll
                for (int j = 0; j < 16; ++j) { acc[j] = siluf_(acc[j]); ss += acc[j] * acc[j]; }
                if (mat < 2) {
                    ss += __shfl_xor(ss, 1); ss += __shfl_xor(ss, 2); ss += __shfl_xor(ss, 4);
                    const float rn = rsqrtf(ss + EPS) * (mat == 0 ? 0.08838834764831845f : 1.f);
#pragma unroll
                    for (int j = 0; j < 16; ++j) acc[j] *= rn;
                    u32x4 w0, w1; w0.x = pk2(acc[0], acc[1]); w0.y = pk2(acc[2], acc[3]); w0.z = pk2(acc[4], acc[5]); w0.w = pk2(acc[6], acc[7]);
                    w1.x = pk2(acc[8], acc[9]); w1.y = pk2(acc[10], acc[11]); w1.z = pk2(acc[12], acc[13]); w1.w = pk2(acc[14], acc[15]);
                    LAS unsigned char* d = (mat == 0 ? qs : ks) + t * 272 + c0 * 2; *(LAS u32x4*)d = w0; *(LAS u32x4*)(d + 16) = w1;
                }
                if (mat >= 1) { const float sc = (mat == 1) ? beta * eg : beta; LAS float* d = rhs + t * RP + (mat == 1 ? 128 : 0) + c0;
#pragma unroll
                    for (int j4 = 0; j4 < 4; ++j4) *(LAS f32x4*)(d + 4 * j4) = (f32x4){acc[4 * j4] * sc, acc[4 * j4 + 1] * sc, acc[4 * j4 + 2] * sc, acc[4 * j4 + 3] * sc}; }
            }
        }
        LBAR();
        {
            const int mtx = wid >> 2, ti = wid & 3, r = lane & 15, quad = lane >> 4; const LAS unsigned char* Ab = mtx ? qs : ks;
#pragma unroll
            for (int tj = 0; tj < 4; ++tj) { f32x4 c = {0.f, 0.f, 0.f, 0.f};
#pragma unroll
                for (int s = 0; s < 4; ++s) { const bf16x8 a = *(const LAS bf16x8*)(Ab + (16 * ti + r) * 272 + (32 * s + quad * 8) * 2); const bf16x8 b = *(const LAS bf16x8*)(ks + (16 * tj + r) * 272 + (32 * s + quad * 8) * 2); c = MFMA16(a, b, c); }
#pragma unroll
                for (int jj = 0; jj < 4; ++jj) { const int t = 16 * ti + quad * 4 + jj, col = 16 * tj + r; const float dec = (col <= t) ? __expf(Gs[t] - Gs[col]) : 0.f;
                    if (mtx == 0) Lm[t * LP + col] = (col < t) ? -(Bs[t] * c[jj] * dec) : 0.f;
                    else PT[(size_t)unit * 4096 + t * 64 + col] = (bf16_t)(pk2(c[jj] * dec, 0.f) & 0xffffu); }
            }
            if (mtx == 0 && lane < 16) {
                float d[16]; const LAS float* Lb = Lm + (16 * ti) * LP + 16 * ti; LAS float* DP = (LAS float*)(lds + PR_DP) + ti * 256 + (lane & 3) * 64 + (lane >> 2) * 16;
                f32x4 rc[4], rn[4];
#pragma unroll
                for (int q = 0; q < 4; ++q) { rc[q] = *(const LAS f32x4*)(Lb + 1 * LP + 4 * q); rn[q] = rc[q]; }
                d[0] = (lane == 0) ? 1.f : 0.f; DP[0] = d[0];
#pragma unroll
                for (int rr = 1; rr < 16; ++rr) {
                    if (rr < 15) {
#pragma unroll
                        for (int q = 0; q < 4; ++q) if (4 * q < rr + 1) rn[q] = *(const LAS f32x4*)(Lb + (rr + 1) * LP + 4 * q); }
                    float a0 = (rr == lane) ? 1.f : 0.f, a1 = 0.f;
#pragma unroll
                    for (int k = 0; k < rr; ++k) { if (k & 1) a1 += rc[k >> 2][k & 3] * d[k]; else a0 += rc[k >> 2][k & 3] * d[k]; }
                    d[rr] = a0 + a1; DP[rr] = d[rr];
#pragma unroll
                    for (int q = 0; q < 4; ++q) rc[q] = rn[q];
                }
            }
        }
        LBAR();
        {
            const int r = lane & 15, quad = lane >> 4; const LAS float* DPb = (const LAS float*)(lds + PR_DP);
#pragma unroll 1
            for (int I = 0; I < 4; ++I) {
                f32x4 C0, C1; LAS float* x0 = rhs + (16 * I + 4 * quad) * RP + wid * 32 + r; LAS float* x1 = x0 + 16;
#pragma unroll
                for (int jj = 0; jj < 4; ++jj) { C0[jj] = x0[jj * RP]; C1[jj] = x1[jj * RP]; }
#pragma unroll 2
                for (int j0 = 0; j0 < 16 * I; j0 += 4) { const float a = Lm[(16 * I + r) * LP + j0 + quad]; const LAS float* bp = rhs + (j0 + quad) * RP + wid * 32 + r;
                    C0 = __builtin_amdgcn_mfma_f32_16x16x4f32(a, bp[0], C0, 0, 0, 0); C1 = __builtin_amdgcn_mfma_f32_16x16x4f32(a, bp[16], C1, 0, 0, 0); }
                f32x4 X0 = {0.f, 0.f, 0.f, 0.f}, X1 = {0.f, 0.f, 0.f, 0.f};
#pragma unroll
                for (int sx = 0; sx < 4; ++sx) { const float a = DPb[I * 256 + sx * 64 + quad * 16 + r];
                    X0 = __builtin_amdgcn_mfma_f32_16x16x4f32(a, C0[sx], X0, 0, 0, 0); X1 = __builtin_amdgcn_mfma_f32_16x16x4f32(a, C1[sx], X1, 0, 0, 0); }
#pragma unroll
                for (int jj = 0; jj < 4; ++jj) { x0[jj * RP] = X0[jj]; x1[jj * RP] = X1[jj]; }
            }
        }
        {
#pragma unroll
            for (int k = 0; k < 2; ++k) { const int p = tid + 512 * k, t = p >> 4, c8 = (p & 15) * 8; const u32x4 v = *(const LAS u32x4*)(qs + t * 272 + c8 * 2); const float eg = __expf(Gs[t]);
                u32x4 w; w.x = pk2(bflo(v.x) * eg, bfhi(v.x) * eg); w.y = pk2(bflo(v.y) * eg, bfhi(v.y) * eg); w.z = pk2(bflo(v.z) * eg, bfhi(v.z) * eg); w.w = pk2(bflo(v.w) * eg, bfhi(v.w) * eg);
                *(u32x4*)(Oq + (size_t)(row0 + t) * DM + h * 128 + c8) = w; }
            const int dk = tid & 127, qtr = tid >> 7; const float g63 = Gs[63];
#pragma unroll
            for (int tg = 0; tg < 2; ++tg) { float v[8];
#pragma unroll
                for (int i = 0; i < 8; ++i) { const int t = 16 * qtr + 8 * tg + i; v[i] = bf2f(*(const LAS unsigned short*)(ks + t * 272 + dk * 2)) * __expf(g63 - Gs[t]); }
                u32x4 w; w.x = pk2(v[0], v[1]); w.y = pk2(v[2], v[3]); w.z = pk2(v[4], v[5]); w.w = pk2(v[6], v[7]);
                *(u32x4*)(KT + (size_t)unit * 8192 + dk * 64 + 16 * qtr + 8 * tg) = w; }
        }
        LBAR();
#pragma unroll
        for (int k = 0; k < 4; ++k) { const int p = tid + 512 * k, t = p >> 5, c8 = (p & 31) * 8; const f32x4 v0 = *(const LAS f32x4*)(rhs + t * RP + c8), v1 = *(const LAS f32x4*)(rhs + t * RP + c8 + 4);
            const float sg = (c8 < 128) ? 1.f : -1.f; u32x4 w; w.x = pk2(v0.x * sg, v0.y * sg); w.y = pk2(v0.z * sg, v0.w * sg); w.z = pk2(v1.x * sg, v1.y * sg); w.w = pk2(v1.z * sg, v1.w * sg);
            bf16_t* dst = (c8 < 128) ? (Ou + (size_t)(row0 + t) * DM + h * 128 + c8) : (Ow + (size_t)(row0 + t) * DM + h * 128 + (c8 - 128));
            *(u32x4*)dst = w; }
        LBAR();
    }
}
constexpr int SC_W = 0, SC_Q = 17408, SC_P = 34816, SC_K = 44032, SC_U = 62464, SC_BUF = 66560;
__device__ __forceinline__ bf16x8 afrag(const LAS unsigned char* p) { const u32x2 lo = *(const LAS u32x2*)p; const u32x2 hi = *(const LAS u32x2*)(p + 32); const u32x4 v = {lo.x, lo.y, hi.x, hi.y}; return __builtin_bit_cast(bf16x8, v); }
__device__ __forceinline__ bf16x8 packB(const f32x4 a, const f32x4 b) { const u32x4 v = {pk2(a.x, a.y), pk2(a.z, a.w), pk2(b.x, b.y), pk2(b.z, b.w)}; return __builtin_bit_cast(bf16x8, v); }
__device__ __forceinline__ void scan_phase(LAS unsigned char* lds, bf16_t* R0, const bf16_t* KT, const bf16_t* PT, const float* Eg, bf16_t* Odst, int tid, int wid, int lane) {
    const int r = lane & 15, quad = lane >> 4;
    const int vcu = (gridDim.x % 8 == 0) ? (int)((blockIdx.x & 7) * (gridDim.x >> 3) + (blockIdx.x >> 3)) : (int)blockIdx.x;
    for (int task = vcu; task < 256; task += gridDim.x) {
        const int bh = task >> 2, dvq = task & 3, b = bh >> 3, h = bh & 7, dv16 = dvq * 32 + (wid & 1) * 16;
        const bf16_t* Wsrc = R0 + SLOTE; const bf16_t* Qsrc = R0; const bf16_t* Usrc = R0 + 2 * SLOTE;
        if (wid < 2) {
            f32x4 S[8];
#pragma unroll
            for (int d = 0; d < 8; ++d) S[d] = (f32x4){0.f, 0.f, 0.f, 0.f};
            float en = Eg[(size_t)((b * NCH + 0) * 8 + h)];
            __syncthreads();
#pragma unroll 1
            for (int n = 0; n < NCH; ++n) {
                f32x4 U[4], O[4]; const float ec = en; int rq = quad * 4 * DM + h * 128 + dv16 + r; asm volatile("" : "+v"(rq));
                const LAS unsigned char* B_ = lds + (n & 1) * SC_BUF; const int row0 = (b * NCH + n) * 64;
#pragma unroll
                for (int m = 0; m < 4; ++m) { const LAS unsigned short* up = (const LAS unsigned short*)(B_ + SC_U + (16 * m + quad * 4) * 64 + ((wid & 1) * 16 + r) * 2);
                    U[m] = (f32x4){bf2f(up[0]), bf2f(up[32]), bf2f(up[64]), bf2f(up[96])}; }
                if (n + 1 < NCH) en = Eg[(size_t)((b * NCH + n + 1) * 8 + h)];
                bf16x8 Sb[4];
#pragma unroll
                for (int s = 0; s < 4; ++s) Sb[s] = packB(S[2 * s], S[2 * s + 1]);
#pragma unroll
                for (int m = 0; m < 4; ++m) O[m] = (f32x4){0.f, 0.f, 0.f, 0.f};
#define SBAR_ __builtin_amdgcn_sched_barrier(0)
#define LM(m, fw, fq) do { _Pragma("unroll") for (int s = 0; s < 4; ++s) { fw[s] = afrag(B_ + SC_W + (16 * (m) + r) * 272 + (32 * s + quad * 4) * 2); fq[s] = afrag(B_ + SC_Q + (16 * (m) + r) * 272 + (32 * s + quad * 4) * 2); } } while (0)
#define MM(m, fw, fq) do { _Pragma("unroll") for (int s = 0; s < 4; ++s) { U[m] = MFMA16(fw[s], Sb[s], U[m]); O[m] = MFMA16(fq[s], Sb[s], O[m]); } } while (0)
                bf16x8 fwa[4], fqa[4], fwb[4], fqb[4], fp[8], fk[8];
                LM(0, fwa, fqa);
                LM(1, fwb, fqb); SBAR_; MM(0, fwa, fqa); SBAR_;
                LM(2, fwa, fqa); SBAR_; MM(1, fwb, fqb); SBAR_;
                LM(3, fwb, fqb); SBAR_; MM(2, fwa, fqa); SBAR_;
#pragma unroll
                for (int m = 0; m < 4; ++m)
#pragma unroll
                    for (int s = 0; s < 2; ++s) fp[m * 2 + s] = afrag(B_ + SC_P + (16 * m + r) * 144 + (32 * s + quad * 4) * 2);
                SBAR_; MM(3, fwb, fqb); SBAR_;
                bf16x8 Ub[2]; Ub[0] = packB(U[0], U[1]); Ub[1] = packB(U[2], U[3]);
#pragma unroll
                for (int d = 0; d < 4; ++d)
#pragma unroll
                    for (int s = 0; s < 2; ++s) fk[d * 2 + s] = afrag(B_ + SC_K + (16 * d + r) * 144 + (32 * s + quad * 4) * 2);
                SBAR_;
#pragma unroll
                for (int m = 0; m < 4; ++m)
#pragma unroll
                    for (int s = 0; s < 2; ++s) O[m] = MFMA16(fp[m * 2 + s], Ub[s], O[m]);
                SBAR_;
#pragma unroll
                for (int d = 0; d < 4; ++d)
#pragma unroll
                    for (int s = 0; s < 2; ++s) fp[d * 2 + s] = afrag(B_ + SC_K + (16 * (d + 4) + r) * 144 + (32 * s + quad * 4) * 2);
                SBAR_;
#pragma unroll
                for (int d = 0; d < 4; ++d) { S[d] = S[d] * ec;
#pragma unroll
                    for (int s = 0; s < 2; ++s) S[d] = MFMA16(fk[d * 2 + s], Ub[s], S[d]); }
                SBAR_;
#pragma unroll
                for (int d = 0; d < 4; ++d) { S[d + 4] = S[d + 4] * ec;
#pragma unroll
                    for (int s = 0; s < 2; ++s) S[d + 4] = MFMA16(fp[d * 2 + s], Ub[s], S[d + 4]); }
#undef LM
#undef MM
#undef SBAR_
#pragma unroll
                for (int m = 0; m < 4; ++m)
#pragma unroll
                    for (int jj = 0; jj < 4; ++jj) Odst[(size_t)(row0 + 16 * m + jj) * DM + rq] = (bf16_t)(pk2(O[m][jj], 0.f) & 0xffffu);
                __syncthreads();
            }
        } else {
            const int lt = tid - 128;
            u32x4 pfa[10], pfb[10];
#define SC_LOAD(n, pf) do { const int row0_ = (b * NCH + (n)) * 64; const size_t unit_ = (size_t)((b * NCH + (n)) * 8 + h); \
                int lt_ = lt; asm volatile("" : "+v"(lt_)); _Pragma("unroll") for (int k = 0; k < 10; ++k) { const int p = lt_ + 384 * k; const bf16_t* src; \
                    if (p < 2048) { const int q = p & 1023; src = (p < 1024 ? Wsrc : Qsrc) + (size_t)(row0_ + (q >> 4)) * DM + h * 128 + (q & 15) * 8; } \
                    else if (p < 2560) src = PT + unit_ * 4096 + (size_t)(p - 2048) * 8; \
                    else if (p < 3584) src = KT + unit_ * 8192 + (size_t)(p - 2560) * 8; \
                    else { const int q = p - 3584; src = Usrc + (size_t)(row0_ + (q >> 2)) * DM + h * 128 + dvq * 32 + (q & 3) * 8; } \
                    pf[k] = *(const u32x4*)src; } } while (0)
#define SC_STORE(buf, pf) do { LAS unsigned char* B_ = lds + (buf) * SC_BUF; \
                int lt_ = lt; asm volatile("" : "+v"(lt_)); _Pragma("unroll") for (int k = 0; k < 10; ++k) { const int p = lt_ + 384 * k; int off; \
                    if (p < 2048) { const int q = p & 1023; off = (p < 1024 ? SC_W : SC_Q) + (q >> 4) * 272 + (q & 15) * 16; } \
                    else if (p < 2560) { const int q = p - 2048; off = SC_P + (q >> 3) * 144 + (q & 7) * 16; } \
                    else if (p < 3584) { const int q = p - 2560; off = SC_K + (q >> 3) * 144 + (q & 7) * 16; } \
                    else { const int q = p - 3584; off = SC_U + (q >> 2) * 64 + (q & 3) * 16; } \
                    *(LAS u32x4*)(B_ + off) = pf[k]; } } while (0)
            SC_LOAD(0, pfa); SC_STORE(0, pfa); SC_LOAD(1, pfb);
            __syncthreads();
#pragma unroll 1
            for (int n = 0; n < NCH; n += 2) {
                if (n + 2 < NCH) SC_LOAD(n + 2, pfa);
                SC_STORE(1, pfb);
                __syncthreads();
                if (n + 3 < NCH) SC_LOAD(n + 3, pfb);
                if (n + 2 < NCH) SC_STORE(0, pfa);
                __syncthreads();
            }
#undef SC_LOAD
#undef SC_STORE
        }
    }
}

__device__ __forceinline__ int crow(int reg, int h) { return (reg & 3) + 8 * (reg >> 2) + 4 * h; }
__device__ __forceinline__ bf16x8 pack8(const f32x16& p, int s) { const u32x4 v = {pk2(p[8 * s], p[8 * s + 1]), pk2(p[8 * s + 2], p[8 * s + 3]), pk2(p[8 * s + 4], p[8 * s + 5]), pk2(p[8 * s + 6], p[8 * s + 7])}; return __builtin_bit_cast(bf16x8, v); }
__device__ __forceinline__ bf16x8 vfrag(const LAS unsigned char* p) { const u32x2 lo = *(const LAS u32x2*)p; const u32x2 hi = *(const LAS u32x2*)(p + 16); const u32x4 v = {lo.x, lo.y, hi.x, hi.y}; return __builtin_bit_cast(bf16x8, v); }
constexpr int BA_K = 0, BA_V = 18432, BA_T = 36864;
__device__ __forceinline__ void band_phase(LAS unsigned char* lds, const bf16_t* Qb, const bf16_t* Kb, const bf16_t* Vb, bf16_t* Ob, const float* rel_bias, int tid, int wid, int lane) {
    const int r = lane & 31, h5 = lane >> 5; LAS float* btab = (LAS float*)(lds + BA_T);
    const int vcu = (gridDim.x % 8 == 0) ? (int)((blockIdx.x & 7) * (gridDim.x >> 3) + (blockIdx.x >> 3)) : (int)blockIdx.x;
    for (int uu = vcu * 4; uu < 1024; uu += gridDim.x * 4)
    for (int ui = 0; ui < 4; ++ui) {
        const int bhh = uu >> 3, b = bhh >> 4, h = bhh & 15, odd = (uu >> 2) & 1; const int qblk = odd ? ((ui == 0) ? 1 : (ui == 1) ? 2 : (ui == 2) ? 5 : 6) : ((ui == 0) ? 0 : (ui == 1) ? 3 : (ui == 2) ? 4 : 7);
        const int rowb = b * SEQ, c_first = (4 * qblk - 8) > 0 ? (4 * qblk - 8) : 0, ntile = 4 * qblk + 4 - c_first;
        const int nq = 4 * qblk + (wid >> 1), qi = 32 * (wid & 1) + r; const int q0 = rowb + 256 * qblk + 32 * wid;
        if (tid < 384) { int rel = 319 - tid; rel = rel < -63 ? -63 : (rel > 256 ? 256 : rel); btab[tid] = rel_bias[h * 320 + rel + 63] * LOG2E; }
        bf16x8 qf[4];
#pragma unroll
        for (int d0 = 0; d0 < 4; ++d0) qf[d0] = *(const bf16x8*)(Qb + (size_t)(q0 + r) * DM + h * 64 + 16 * d0 + 8 * h5);
        u32x4 kreg, vreg; const int skey = tid >> 3, sc8 = tid & 7;
#define BA_LOAD(c) do { const size_t o_ = (size_t)(rowb + 64 * (c) + skey) * DM + h * 64 + sc8 * 8; kreg = *(const u32x4*)(Kb + o_); vreg = *(const u32x4*)(Vb + o_); } while (0)
#define BA_STORE(buf) do { *(LAS u32x4*)(lds + BA_K + (buf) * 9216 + skey * 144 + sc8 * 16) = kreg; LAS unsigned char* v_ = lds + BA_V + (buf) * 9216 + (sc8 * 8) * 136 + skey * 2; \
            *(LAS unsigned short*)(v_) = (unsigned short)kregv(vreg.x, 0); *(LAS unsigned short*)(v_ + 136) = (unsigned short)kregv(vreg.x, 1); *(LAS unsigned short*)(v_ + 272) = (unsigned short)kregv(vreg.y, 0); *(LAS unsigned short*)(v_ + 408) = (unsigned short)kregv(vreg.y, 1); \
            *(LAS unsigned short*)(v_ + 544) = (unsigned short)kregv(vreg.z, 0); *(LAS unsigned short*)(v_ + 680) = (unsigned short)kregv(vreg.z, 1); *(LAS unsigned short*)(v_ + 816) = (unsigned short)kregv(vreg.w, 0); *(LAS unsigned short*)(v_ + 952) = (unsigned short)kregv(vreg.w, 1); } while (0)
#define kregv(w, hi) ((hi) ? ((w) >> 16) : ((w) & 0xffffu))
        BA_LOAD(c_first); BA_STORE(0);
        float m_run = -1e30f, l_run = 0.f; f32x16 O[2];
#pragma unroll
        for (int i = 0; i < 16; ++i) { O[0][i] = 0.f; O[1][i] = 0.f; }
        __syncthreads();
        for (int ti = 0; ti < ntile; ++ti) {
            const int c = c_first + ti;
            if (ti + 1 < ntile) BA_LOAD(c + 1);
            if (c >= nq - 8 && c <= nq) {
                const LAS unsigned char* Kt = lds + BA_K + (ti & 1) * 9216; const LAS unsigned char* Vt = lds + BA_V + (ti & 1) * 9216;
                f32x16 P0, P1;
#pragma unroll
                for (int i = 0; i < 16; ++i) { P0[i] = 0.f; P1[i] = 0.f; }
#pragma unroll
                for (int d0 = 0; d0 < 4; ++d0) { const bf16x8 a0 = *(const LAS bf16x8*)(Kt + r * 144 + (16 * d0 + 8 * h5) * 2); const bf16x8 a1 = *(const LAS bf16x8*)(Kt + (32 + r) * 144 + (16 * d0 + 8 * h5) * 2);
                    P0 = MFMA32(a0, qf[d0], P0); P1 = MFMA32(a1, qf[d0], P1); }
                const int dch = nq - c;
                if (dch >= 5) { const float bc = btab[0];
#pragma unroll
                    for (int i = 0; i < 16; ++i) { P0[i] += bc; P1[i] += bc; } }
                else {
                    const LAS float* bp = btab + (319 - dch * 64 - qi + 4 * h5);
#pragma unroll
                    for (int i = 0; i < 16; ++i) { P0[i] += bp[(i & 3) + 8 * (i >> 2)]; P1[i] += bp[(i & 3) + 8 * (i >> 2) + 32]; } }
                float mx = P0[0];
#pragma unroll
                for (int i = 0; i < 16; ++i) { mx = fmaxf(mx, P0[i]); mx = fmaxf(mx, P1[i]); }
                mx = fmaxf(mx, __shfl_xor(mx, 32));
                const float m_new = fmaxf(m_run, mx), alpha = __builtin_amdgcn_exp2f(m_run - m_new); m_run = m_new;
                float ls = 0.f;
#pragma unroll
                for (int i = 0; i < 16; ++i) { P0[i] = __builtin_amdgcn_exp2f(P0[i] - m_new); P1[i] = __builtin_amdgcn_exp2f(P1[i] - m_new); ls += P0[i] + P1[i]; }
                l_run = l_run * alpha + ls;
#pragma unroll
                for (int i = 0; i < 16; ++i) { O[0][i] *= alpha; O[1][i] *= alpha; }
#pragma unroll
                for (int p = 0; p < 2; ++p)
#pragma unroll
                    for (int s = 0; s < 2; ++s) { const bf16x8 pb = pack8(p ? P1 : P0, s);
#pragma unroll
                        for (int dt = 0; dt < 2; ++dt) O[dt] = MFMA32(vfrag(Vt + (32 * dt + r) * 136 + (32 * p + 16 * s + 4 * h5) * 2), pb, O[dt]); }
            }
            if (ti + 1 < ntile) BA_STORE((ti + 1) & 1);
            __syncthreads();
        }
        l_run += __shfl_xor(l_run, 32); const float inv = 1.f / l_run;
#pragma unroll
        for (int dt = 0; dt < 2; ++dt)
#pragma unroll
            for (int g = 0; g < 4; ++g) { u32x2 w; w.x = pk2(O[dt][4 * g] * inv, O[dt][4 * g + 1] * inv); w.y = pk2(O[dt][4 * g + 2] * inv, O[dt][4 * g + 3] * inv);
                *(u32x2*)(Ob + (size_t)(q0 + r) * DM + h * 64 + 32 * dt + 8 * g + 4 * h5) = w; }
#undef BA_LOAD
#undef BA_STORE
#undef kregv
    }
}

__device__ __forceinline__ void xattn_phase(LAS unsigned char* lds, const bf16_t* Qm, const bf16_t* KV, bf16_t* Om, int tid, int wid, int lane) {
    const int r = lane & 31, h5 = lane >> 5;
    const int vcu = (gridDim.x % 8 == 0) ? (int)((blockIdx.x & 7) * (gridDim.x >> 3) + (blockIdx.x >> 3)) : (int)blockIdx.x;
#define SBAR_ __builtin_amdgcn_sched_barrier(0)
    for (int unit = vcu; unit < 256; unit += gridDim.x) {
        const int b = unit >> 5, mh = (unit >> 3) & 3, qblk = unit & 7; const int q0 = b * SEQ + qblk * 256 + 32 * wid;
        const bf16_t* Kg = KV + (size_t)(b * 256) * 2048 + mh * 256; const bf16_t* Vg = Kg + 1024;
#pragma unroll 1
        for (int kb = 0; kb < 16; kb += 8) { u32x4 kst[8];
#pragma unroll
          for (int k = 0; k < 8; ++k) { const int p = tid + 512 * (kb + k), key = p >> 5, c = p & 31; kst[k] = *(const u32x4*)(Kg + (size_t)key * 2048 + c * 8); }
#pragma unroll
          for (int k = 0; k < 8; ++k) { const int p = tid + 512 * (kb + k), key = p >> 5, c = p & 31; *(LAS u32x4*)(lds + key * 528 + c * 16) = kst[k]; } }
        const bf16_t* qp = Qm + (size_t)(q0 + r) * DM + mh * 256 + 8 * h5;
        bf16x8 qa = *(const bf16x8*)(qp), qb = *(const bf16x8*)(qp + 16);
        __syncthreads();
        f32x16 Sx[8];
#pragma unroll
        for (int kt = 0; kt < 8; ++kt)
#pragma unroll
            for (int i = 0; i < 16; ++i) Sx[kt][i] = 0.f;
#define LK(d0, hf, kf) do { _Pragma("unroll") for (int kt = 0; kt < 4; ++kt) kf[kt] = *(const LAS bf16x8*)(lds + (32 * ((hf) * 4 + kt) + r) * 528 + (16 * (d0) + 8 * h5) * 2); } while (0)
#define MK(kf, hf, q) do { _Pragma("unroll") for (int kt = 0; kt < 4; ++kt) Sx[(hf) * 4 + kt] = MFMA32(kf[kt], q, Sx[(hf) * 4 + kt]); } while (0)
        bf16x8 kfa[4], kfb[4];
        LK(0, 0, kfa);
#pragma unroll 1
        for (int d0 = 0; d0 < 16; d0 += 2) {
            LK(d0, 1, kfb); SBAR_; MK(kfa, 0, qa); SBAR_;
            LK(d0 + 1, 0, kfa); SBAR_; MK(kfb, 1, qa); SBAR_;
            if (d0 + 2 < 16) qa = *(const bf16x8*)(qp + 16 * (d0 + 2));
            LK(d0 + 1, 1, kfb); SBAR_; MK(kfa, 0, qb); SBAR_;
            if (d0 + 2 < 16) LK(d0 + 2, 0, kfa);
            SBAR_; MK(kfb, 1, qb); SBAR_;
            if (d0 + 3 < 16) qb = *(const bf16x8*)(qp + 16 * (d0 + 3));
        }
#undef LK
#undef MK
        float mx = Sx[0][0];
#pragma unroll
        for (int kt = 0; kt < 8; ++kt)
#pragma unroll
            for (int i = 0; i < 16; ++i) mx = fmaxf(mx, Sx[kt][i]);
        mx = fmaxf(mx, __shfl_xor(mx, 32));
        float ls = 0.f;
#pragma unroll
        for (int kt = 0; kt < 8; ++kt)
#pragma unroll
            for (int i = 0; i < 16; ++i) { Sx[kt][i] = __builtin_amdgcn_exp2f(Sx[kt][i] - mx); ls += Sx[kt][i]; }
        ls += __shfl_xor(ls, 32); const float inv = 1.f / ls;
        bf16x8 Pb[16];
#pragma unroll
        for (int kt = 0; kt < 8; ++kt) { Pb[2 * kt] = pack8(Sx[kt], 0); Pb[2 * kt + 1] = pack8(Sx[kt], 1); }
        __syncthreads();
        {
            const int kh = wid & 1, cg4 = wid >> 1, k0 = 128 * kh + 2 * lane;
#pragma unroll 1
            for (int ib = 0; ib < 8; ib += 4) { u32x4 vsa[4], vsb[4];
#pragma unroll
              for (int i = 0; i < 4; ++i) { const int c = cg4 + 4 * (ib + i); vsa[i] = *(const u32x4*)(Vg + (size_t)k0 * 2048 + c * 8); vsb[i] = *(const u32x4*)(Vg + (size_t)(k0 + 1) * 2048 + c * 8); }
#pragma unroll
              for (int i = 0; i < 4; ++i) { const int c = cg4 + 4 * (ib + i); const u32x4 va = vsa[i], vb = vsb[i];
                LAS unsigned char* d = lds + (c * 8) * 536 + k0 * 2;
                *(LAS unsigned*)(d) = (va.x & 0xffffu) | (vb.x << 16); *(LAS unsigned*)(d + 536) = (va.x >> 16) | (vb.x & 0xffff0000u);
                *(LAS unsigned*)(d + 1072) = (va.y & 0xffffu) | (vb.y << 16); *(LAS unsigned*)(d + 1608) = (va.y >> 16) | (vb.y & 0xffff0000u);
                *(LAS unsigned*)(d + 2144) = (va.z & 0xffffu) | (vb.z << 16); *(LAS unsigned*)(d + 2680) = (va.z >> 16) | (vb.z & 0xffff0000u);
                *(LAS unsigned*)(d + 3216) = (va.w & 0xffffu) | (vb.w << 16); *(LAS unsigned*)(d + 3752) = (va.w >> 16) | (vb.w & 0xffff0000u); } }
        }
        __syncthreads();
#define LV(dt, k8, vf) do { _Pragma("unroll") for (int ks = 0; ks < 8; ++ks) vf[ks] = vfrag(lds + (32 * (dt) + r) * 536 + (16 * ((k8) * 8 + ks) + 4 * h5) * 2); } while (0)
        bf16x8 vfa[8], vfb[8];
        LV(0, 0, vfa);
#pragma unroll 1
        for (int dt = 0; dt < 8; ++dt) {
            f32x16 Oa;
#pragma unroll
            for (int i = 0; i < 16; ++i) Oa[i] = 0.f;
            LV(dt, 1, vfb); SBAR_;
#pragma unroll
            for (int ks = 0; ks < 8; ++ks) Oa = MFMA32(vfa[ks], Pb[ks], Oa);
            SBAR_;
            if (dt + 1 < 8) LV(dt + 1, 0, vfa);
            SBAR_;
#pragma unroll
            for (int ks = 0; ks < 8; ++ks) Oa = MFMA32(vfb[ks], Pb[8 + ks], Oa);
            SBAR_;
#pragma unroll
            for (int g = 0; g < 4; ++g) { u32x2 w; w.x = pk2(Oa[4 * g] * inv, Oa[4 * g + 1] * inv); w.y = pk2(Oa[4 * g + 2] * inv, Oa[4 * g + 3] * inv);
                *(u32x2*)(Om + (size_t)(q0 + r) * DM + mh * 256 + 32 * dt + 8 * g + 4 * h5) = w; }
        }
#undef LV
        __syncthreads();
    }
#undef SBAR_
}
#define XB_TMO      128
#define XB_XCNT(j)  (256  + 64 * (j))
#define XB_XSUB(j)  (1280 + 64 * (j))
#define XB_XGEN(j)  (2304 + 64 * (j))
#define XB_TOP      3328
#define XB_TOPGEN   3392
#define XCD_BAR_WORDS 3456
#define XB_SPIN_CAP (1u << 18)

__device__ __forceinline__ unsigned xb_ld(unsigned* p)              { return __hip_atomic_load(p, __ATOMIC_RELAXED, __HIP_MEMORY_SCOPE_AGENT); }
__device__ __forceinline__ unsigned xb_add(unsigned* p, unsigned v) { return __hip_atomic_fetch_add(p, v, __ATOMIC_RELAXED, __HIP_MEMORY_SCOPE_AGENT); }
__device__ __forceinline__ unsigned xb_xcc_id() { return (unsigned)__builtin_amdgcn_s_getreg((3 << 11) | 20) & 0xFu; }
#define XB_SPIN(cond, bar) do { unsigned _sp = 0; while (cond) { __builtin_amdgcn_s_sleep(1); \
    if ((++_sp & 255u) == 0u) { if (xb_ld(&(bar)[XB_TMO])) break; if (_sp > XB_SPIN_CAP) { atomicAdd(&(bar)[XB_TMO], 1u); break; } } } } while (0)

struct XcdBarrier {
    unsigned* bar; unsigned x;
    volatile LAS unsigned* st;
};

__device__ __forceinline__ XcdBarrier xcd_barrier_post(unsigned* bar, volatile LAS unsigned* st) {
    XcdBarrier b; b.bar = bar; b.x = xb_xcc_id(); b.st = st;
    if (threadIdx.x == 0) (void)xb_add(&bar[XB_XCNT(b.x)], 1u);
    return b;
}
__device__ __forceinline__ void xcd_barrier_complete(unsigned* bar, unsigned x, unsigned& nloc, unsigned& nx) {
    const unsigned G = gridDim.x * gridDim.y * gridDim.z;
    unsigned sum, cnt, mine, sp = 0u;
    for (;;) {
        sum = 0u; cnt = 0u; mine = 0u;
#pragma unroll
        for (unsigned j = 0; j < 16; ++j) { const unsigned c = xb_ld(&bar[XB_XCNT(j)]); sum += c; cnt += (c > 0u) ? 1u : 0u; mine = (j == x) ? c : mine; }
        if (sum == G) break;
        __builtin_amdgcn_s_sleep(1);
        if ((++sp & 255u) == 0u) { if (xb_ld(&bar[XB_TMO])) break; if (sp > XB_SPIN_CAP) { atomicAdd(&bar[XB_TMO], 1u); break; } }
    }
    nloc = mine > 0u ? mine : 1u; nx = cnt > 0u ? cnt : 1u;
}

__device__ __forceinline__ void xcd_barrier(const XcdBarrier& b) {
    asm volatile("s_waitcnt vmcnt(0)" ::: "memory");
    __syncthreads();
    if (threadIdx.x == 0) {
        unsigned* bar = b.bar;
        __builtin_amdgcn_s_waitcnt(0);
        unsigned nloc = b.st[0], nx = b.st[1];
        if (nloc == 0u) { xcd_barrier_complete(bar, b.x, nloc, nx); b.st[0] = nloc; b.st[1] = nx; }
        const unsigned old = xb_add(&bar[XB_XSUB(b.x)], 1u);
        const unsigned gen = old / nloc;
        if (old + 1u == (gen + 1u) * nloc) {
            __builtin_amdgcn_fence(__ATOMIC_RELEASE, "agent");
            asm volatile("s_waitcnt vmcnt(0)" ::: "memory");
            const unsigned og = xb_add(&bar[XB_TOP], 1u);
            const unsigned tg = og / nx;
            if (og + 1u == (tg + 1u) * nx) xb_add(&bar[XB_TOPGEN], 1u);
            else XB_SPIN(xb_ld(&bar[XB_TOPGEN]) == tg, bar);
            __builtin_amdgcn_fence(__ATOMIC_ACQUIRE, "agent");
            xb_add(&bar[XB_XGEN(b.x)], 1u);
            asm volatile("s_waitcnt vmcnt(0)" ::: "memory");
        } else {
            XB_SPIN(xb_ld(&bar[XB_XGEN(b.x)]) == gen, bar);
            __builtin_amdgcn_fence(__ATOMIC_ACQUIRE, "agent");
            asm volatile("s_waitcnt vmcnt(0)" ::: "memory");
        }
    }
    __syncthreads();
}
#ifndef PROBE_DUP_MASK
#define PROBE_DUP_MASK 0
#endif
#ifndef PROBE_EXTRA_SYNC
#define PROBE_EXTRA_SYNC 0
#endif
struct Args { Inputs in; float* out; unsigned char* ws; };
enum { PH_IN_A = 0, PH_MEMKV, PH_PREP, PH_SCAN, PH_IN_B, PH_BAND, PH_GA, PH_T, PH_GB, PH_Y, PH_WO, PH_QM, PH_XATTN, PH_WMO, PH_FFN, PH_DOWN, PH_CONV, PH_COUNT };
__global__ void __launch_bounds__(512, 2) fwd_megakernel(Args args) {
    extern __shared__ __attribute__((aligned(16))) unsigned char lds_raw[];
    cg::grid_group grid = cg::this_grid();
    LAS unsigned char* lds = (LAS unsigned char*)lds_raw;
    const int tid = threadIdx.x, lane = tid & 63, wid = __builtin_amdgcn_readfirstlane(tid >> 6);
    const int G = gridDim.x, gw = blockIdx.x * 8 + wid, NGW = G * 8;
    unsigned char* ws = as_global(args.ws); const Inputs& in = args.in;
    float* ssq = (float*)(ws + WS_SSQ); float* ab = (float*)(ws + WS_AB); bf16_t* halo = (bf16_t*)(ws + WS_HALO); float* Eg = (float*)(ws + WS_E); float* mssq = (float*)(ws + WS_MSSQ);
    bf16_t* memb = (bf16_t*)(ws + WS_MEMB); bf16_t* memkv = (bf16_t*)(ws + WS_MEMKV); bf16_t* Wt = (bf16_t*)(ws + WS_W); bf16_t* xb = (bf16_t*)(ws + WS_XB);
    bf16_t* R0 = (bf16_t*)(ws + WS_BIG); bf16_t* R1 = R0 + SLOTE; bf16_t* R2 = R0 + 2 * SLOTE; bf16_t* R3 = R0 + 3 * SLOTE; bf16_t* R4 = R0 + 4 * SLOTE; bf16_t* R5 = R0 + 5 * SLOTE;
    float* out = as_global(args.out);
    volatile LAS unsigned* bst = (volatile LAS unsigned*)(lds + LDS_BYTES - 64);
    if (threadIdx.x < 16) bst[threadIdx.x] = 0u;
    __syncthreads();
    XcdBarrier xbar = xcd_barrier_post((unsigned*)ws, bst);

    if (args.out == nullptr) grid.sync();

    for (int l = 0; l < DEPTH; ++l) {
        int rep_ = 0;
        for (int ph = (l == 0) ? -1 : 0; ph < PH_COUNT; ++ph) {
            if (ph == PH_CONV && l == DEPTH - 1) continue;
            const bool dupl = (ph >= 0) && ((PROBE_DUP_MASK >> (ph & 31)) & 1) && !((ph == PH_PREP || ph == PH_SCAN || ph == PH_BAND) && l != 0);
            unsigned char* ws = as_global(args.ws);
            float* ssq = (float*)(ws + WS_SSQ); float* ab = (float*)(ws + WS_AB); bf16_t* halo = (bf16_t*)(ws + WS_HALO); float* Eg = (float*)(ws + WS_E); float* mssq = (float*)(ws + WS_MSSQ);
            bf16_t* memb = (bf16_t*)(ws + WS_MEMB); bf16_t* memkv = (bf16_t*)(ws + WS_MEMKV); bf16_t* Wt = (bf16_t*)(ws + WS_W); bf16_t* xb = (bf16_t*)(ws + WS_XB);
            bf16_t* R0 = (bf16_t*)(ws + WS_BIG); bf16_t* R1 = R0 + SLOTE; bf16_t* R2 = R0 + 2 * SLOTE; bf16_t* R3 = R0 + 3 * SLOTE; bf16_t* R4 = R0 + 4 * SLOTE; bf16_t* R5 = R0 + 5 * SLOTE;
            int tid = threadIdx.x; asm volatile("" : "+v"(tid)); const int lane = tid & 63, wid = __builtin_amdgcn_readfirstlane(tid >> 6), gw = blockIdx.x * 8 + wid;
            int kind = -1;
            Gemm g{nullptr, nullptr, MROWS, 1024, 1024}; int cshift = 0;
            EpiIn ei{R0, -1, -1, ab, nullptr, ssq, 2}; EpiB eb{nullptr, DM, ssq, nullptr, nullptr, 0}; EpiRes er{out, out, xb, ssq};
            bool sync_after = true;
            switch (ph) {
                case PH_IN_A: kind = 0; g.A = xb; g.Bt = Wt + WO_IN; g.N = 4352; ei.act_slot = 3; ei.ab_tile = 16; ei.halo = halo; sync_after = false; break;
                case PH_MEMKV: kind = 1; g.A = memb; g.Bt = Wt + WO_MKV; g.M = MEMROWS; g.N = 2048; eb.O = memkv; eb.ldc = 2048; eb.ssq = mssq; eb.mode = 0; cshift = 192; break;
                case PH_IN_B: kind = 0; g.A = xb; g.Bt = Wt + WO_IN + (size_t)4352 * 1024; g.N = 3072; ei.slot2 = 4; break;
                case PH_GA: kind = 1; g.A = xb; g.Bt = Wt + WO_IN + (size_t)7424 * 1024; eb.O = R1; eb.mode = 1; sync_after = false; break;
                case PH_T: kind = 1; g.A = R3; g.Bt = Wt + WO_A; eb.O = R2; eb.g1 = R1; eb.mode = 2; sync_after = false; break;
                case PH_GB: kind = 1; g.A = xb; g.Bt = Wt + WO_IN + (size_t)8448 * 1024; eb.O = R1; eb.mode = 1; sync_after = false; break;
                case PH_Y: kind = 1; g.A = R0; g.Bt = Wt + WO_B; eb.O = R4; eb.g1 = R1; eb.t = R2; eb.mode = 3; break;
                case PH_WO: kind = 3; g.A = R4; g.Bt = Wt + WO_O; er.base = (l == 0) ? as_global(in.p[0]) : out; break;
                case PH_QM: kind = 1; g.A = xb; g.Bt = Wt + WO_MQ; eb.O = R0; eb.mode = 0; break;
                case PH_WMO: kind = 3; g.A = R1; g.Bt = Wt + WO_MO; break;
                case PH_FFN: kind = 2; g.A = xb; g.Bt = Wt + WO_GU; g.N = 2 * DFF; break;
                case PH_DOWN: kind = 3; g.A = R0; g.Bt = Wt + WO_DN; g.K = DFF; if (l == DEPTH - 1) er.xb = nullptr; break;
                default: break;
            }
            if (kind >= 0) {
#ifndef SKIP_GEMM
                StaticOrder S; S.init(g.M, g.N, G, (int)((blockIdx.x + cshift) % G));
#ifndef SKIP_G0
                if (kind == 0) gemm_phase<EpiIn, StaticOrder, true, true>(lds, g, S, ei);
#endif
#ifndef SKIP_G1
                if (kind == 1) gemm_phase<EpiB, StaticOrder, true, true>(lds, g, S, eb);
#endif
#ifndef SKIP_G2
                if (kind == 2) { EpiFfn ef{R0, ssq}; gemm_phase<EpiFfn, StaticOrder, true, true>(lds, g, S, ef); }
#endif
#ifndef SKIP_G3
                if (kind == 3) gemm_phase<EpiRes, StaticOrder, true, true>(lds, g, S, er);
#endif
#endif
            } else if (ph == PH_PREP) {
#ifndef SKIP_PREP
                prep_phase(lds, R0, ab, halo, as_global(in.p[4]) + (size_t)l * 4 * 3072, as_global(in.p[5]) + l * 8, as_global(in.p[6]) + l * 8, R4, R5, Eg, (rep_ == 0 && dupl) ? (bf16_t*)out : R0, (rep_ == 0 && dupl) ? (bf16_t*)out + SLOTE : R1, (rep_ == 0 && dupl) ? (bf16_t*)out : R2, tid, wid, lane);
#endif
            } else if (ph == PH_SCAN) {
#ifndef SKIP_SCAN
                scan_phase(lds, R0, R4, R5, Eg, (rep_ == 0 && dupl) ? (bf16_t*)out : R2, tid, wid, lane);
#endif
            } else if (ph == PH_BAND) {
                if (!(rep_ == 1)) oa_norm(R2, R3, as_global(in.p[7]) + l * 128, gw, NGW, lane);
#ifndef SKIP_BAND
                band_phase(lds, R0, R1, R4, (rep_ == 0 && dupl) ? (bf16_t*)out : R0, as_global(in.p[10]), tid, wid, lane);
#endif
            } else if (ph == PH_XATTN) {
#ifndef SKIP_XATTN
                xattn_phase(lds, R0, memkv, R1, tid, wid, lane);
#endif
            } else if (ph == PH_CONV || ph < 0) {
                convert_phase(lds, in, Wt, ph < 0 ? 0 : l + 1, gw, NGW, wid, lane);
                if (ph < 0) { rows_to_bf16(as_global(in.p[0]), xb, ssq, MROWS, gw, NGW, lane); rows_to_bf16(as_global(in.p[1]), memb, mssq, MEMROWS, gw, NGW, lane); }
            }
            if (dupl && rep_ == 0) { rep_ = 1; --ph; continue; }
            rep_ = 0;
            if (sync_after) { xcd_barrier(xbar); for (int e_ = 0; e_ < PROBE_EXTRA_SYNC; ++e_) xcd_barrier(xbar); }
        }
    }
    final_norm(out, ssq, as_global(in.p[20]), gw, NGW, lane);
}

extern "C" void kernel_launch(void* const* d_in, const int* in_sizes, int n_in, void* d_out, int out_size, void* d_ws, size_t ws_size, hipStream_t stream) {
    static int grid = 0;
    if (grid == 0) {
        if (n_in != 21 || out_size != MROWS * DM || ws_size < WS_END) { fprintf(stderr, "kernel_launch: unexpected shapes (n_in %d out %d ws %zu)\n", n_in, out_size, ws_size); grid = -1; return; }
        int dev = 0, cus = 0, per_cu = 0;
        hipGetDevice(&dev); hipDeviceGetAttribute(&cus, hipDeviceAttributeMultiprocessorCount, dev);
        if (hipFuncSetAttribute((const void*)fwd_megakernel, hipFuncAttributeMaxDynamicSharedMemorySize, LDS_BYTES) != hipSuccess) { fprintf(stderr, "kernel_launch: hipFuncSetAttribute failed\n"); grid = -1; return; }
        if (hipOccupancyMaxActiveBlocksPerMultiprocessor(&per_cu, (const void*)fwd_megakernel, 512, LDS_BYTES) != hipSuccess || per_cu < 1) { fprintf(stderr, "kernel_launch: occupancy query says %d\n", per_cu); per_cu = 1; }
        (void)hipGetLastError();
        grid = cus * 1;
        if (grid > 256) grid = 256;
    }
    if (grid < 0) return;
    if (hipMemsetAsync(d_ws, 0, 16384, stream) != hipSuccess) { fprintf(stderr, "kernel_launch: memset failed\n"); return; }
    Args a{};
    for (int i = 0; i < 21; ++i) a.in.p[i] = (const float*)d_in[i];
    a.out = (float*)d_out; a.ws = (unsigned char*)d_ws;
    void* kargs[] = {&a};
    hipError_t e = hipLaunchCooperativeKernel((const void*)fwd_megakernel, dim3(grid), dim3(512), kargs, LDS_BYTES, stream);
    if (e != hipSuccess) fprintf(stderr, "cooperative launch failed: %s (grid %d)\n", hipGetErrorString(e), grid);
}
```

```cpp
#include <hip/hip_runtime.h>
#include <hip/hip_cooperative_groups.h>
#include <cstdio>
#include <cstdint>
namespace cg = cooperative_groups;
namespace pg8 {
#define PG8_LAS __attribute__((address_space(3)))
typedef unsigned short bf16_t;
typedef short bf16x8 __attribute__((ext_vector_type(8)));
typedef float f32x4 __attribute__((ext_vector_type(4)));
typedef unsigned u32x4 __attribute__((ext_vector_type(4)));
constexpr int BM = 256, BK = 64, HALF = 128, HTB = HALF * BK * 2  , STAGE_BYTES = 8 * HTB, NXCD = 8, WGM = 8;

__host__ __device__ __forceinline__ int lds_byte(int r, int c) { const int st = (r >> 4) * 2 + (c >> 5), rr = r & 15, cc = c & 31, ob = rr * 64 + cc * 2; return st * 1024 + (ob ^ (((ob >> 9) & 1) << 5)); }
__host__ __device__ __forceinline__ void stage_rc(int b, int& R, int& C) { const int st = b / 1024, sb = b % 1024, swz = sb ^ (((sb >> 9) & 1) << 5); R = (st >> 1) * 16 + swz / 64; C = (st & 1) * 32 + (swz % 64) / 2; }
__host__ __device__ __forceinline__ int perm32(int rho) { const int n = rho >> 4, i = rho & 15; return 8 * (i >> 2) + 4 * n + (i & 3); }

struct Unit { int pm, pn; };
struct Gemm { const bf16_t* A; const bf16_t* Bt; int M, N, K; };

struct StaticOrder {
    int nM, nN, nwg, G, c;
    __host__ __device__ void init(int M, int N, int G_, int c_) { nM = M / BM; nN = N / BM; nwg = nM * nN; G = G_; c = c_; }
    __host__ __device__ bool next(int i, Unit& u) const {
        const long L = (long)i * G + c; if (L >= nwg) return false;
        int wgid = (int)L; { const int q = nwg / NXCD, r = nwg % NXCD, xcd = wgid % NXCD, off = wgid / NXCD; wgid = (xcd < r ? xcd * (q + 1) : r * (q + 1) + (xcd - r) * q) + off; }
        const int nig = WGM * nN, gid = wgid / nig, fm = gid * WGM, gsz = (nM - fm) < WGM ? (nM - fm) : WGM;
        u.pm = fm + ((wgid % nig) % gsz); u.pn = (wgid % nig) / gsz; return true;
    }
    __device__ __forceinline__ void a_ready(const Unit&) const {}
    __device__ __forceinline__ void done(const Unit&) const {}
};

typedef float f32x2 __attribute__((ext_vector_type(2)));
typedef __bf16 bf16x2_t __attribute__((ext_vector_type(2)));
typedef unsigned u32x2 __attribute__((ext_vector_type(2)));
__device__ __forceinline__ unsigned pk2(float lo, float hi) { f32x2 v = {lo, hi}; bf16x2_t b = __builtin_convertvector(v, bf16x2_t); return __builtin_bit_cast(unsigned, b); }
template <class Epi, class Sched, bool ALIGN_EPI = false, bool SP2 = false>
__device__ __forceinline__ void gemm_phase(PG8_LAS unsigned char* lds, const Gemm g, const Sched& S, const Epi& E) {
    int tid_ = threadIdx.x; asm volatile("" : "+v"(tid_));
    const int tid = tid_, wid = __builtin_amdgcn_readfirstlane(tid >> 6), lane = tid & 63, wr = wid >> 2, wc = wid & 3, fr = lane & 15, fq = lane >> 4;
    const int K = g.K, nt = K / BK;
    unsigned voffA[2], voffB[2];
#pragma unroll
    for (int i = 0; i < 2; ++i) { int R, C; stage_rc(tid * 16 + i * 8192, R, C); const int Rb = Epi::PERM ? ((R & ~31) + perm32(R & 31)) : R;
        voffA[i] = (unsigned)(R * K + C) * 2u; voffB[i] = (unsigned)(Rb * K + C) * 2u; }
    const size_t kstep = (size_t)(BK * 2);
    const size_t hstep = (size_t)HALF * K * 2;
    const size_t tstep = 2 * hstep;
    const unsigned ldsw = (unsigned)wid * 1024u;
    const int aoff = lds_byte(wr * 64 + fr, fq * 8), boff = lds_byte(wc * 32 + fr, fq * 8);
#define PG8_SA(b, h) (((b) * 2 + (h)) * HTB)
#define PG8_SB(b, h) ((4 + (b) * 2 + (h)) * HTB)
#define PG8_STAGE(bufoff, gbase, voff) do { _Pragma("unroll") for (int _i = 0; _i < 2; ++_i) \
        __builtin_amdgcn_global_load_lds((const unsigned*)((const char*)(gbase) + (voff)[_i]), (PG8_LAS unsigned*)(lds + (bufoff) + ldsw + _i * 8192), 16, 0, 0); } while (0)
#define PG8_LDA(dst, b, h) do { _Pragma("unroll") for (int m = 0; m < 4; ++m) _Pragma("unroll") for (int k = 0; k < 2; ++k) dst[m][k] = *(const PG8_LAS bf16x8*)(lds + PG8_SA(b, h) + aoff + m * 2048 + k * 1024); } while (0)
#define PG8_LDB(dst, b, h) do { _Pragma("unroll") for (int n = 0; n < 2; ++n) _Pragma("unroll") for (int k = 0; k < 2; ++k) dst[n][k] = *(const PG8_LAS bf16x8*)(lds + PG8_SB(b, h) + boff + n * 2048 + k * 1024); } while (0)
#define PG8_MMA(ai, bj, At, Bt) do { __builtin_amdgcn_s_setprio(1); _Pragma("unroll") for (int m = 0; m < 4; ++m) _Pragma("unroll") for (int n = 0; n < 2; ++n) _Pragma("unroll") for (int k = 0; k < 2; ++k) \
        acc[ai][bj][m][n] = __builtin_amdgcn_mfma_f32_16x16x32_bf16(Bt[n][k], At[m][k], acc[ai][bj][m][n], 0, 0, 0); __builtin_amdgcn_s_setprio(0); } while (0)
#define PG8_WAIT_V(n) asm volatile("s_waitcnt vmcnt(" #n ")" ::: "memory")
#define PG8_WAIT_L(n) asm volatile("s_waitcnt lgkmcnt(" #n ")" ::: "memory")
#define PG8_BAR __builtin_amdgcn_s_barrier()
#define PG8_SCHED __builtin_amdgcn_sched_barrier(0)
    Unit cur, nxt; int ui = 0;
    if (!S.next(0, cur)) return;
    f32x4 acc[2][2][4][2];
#pragma unroll
    for (int a = 0; a < 2; ++a)
#pragma unroll
        for (int b = 0; b < 2; ++b)
#pragma unroll
            for (int m = 0; m < 4; ++m)
#pragma unroll
                for (int n = 0; n < 2; ++n) acc[a][b][m][n] = (f32x4){0.f, 0.f, 0.f, 0.f};
    bf16x8 At[4][2], B0[2][2], B1[2][2];
    const char* cA = (const char*)g.A + (size_t)cur.pm * tstep; const char* cB = (const char*)g.Bt + (size_t)cur.pn * tstep;
    S.a_ready(cur);
    if constexpr (SP2) {
        PG8_STAGE(PG8_SB(0, 0), cB, voffB); PG8_STAGE(PG8_SB(0, 1), cB + hstep, voffB); PG8_STAGE(PG8_SA(0, 0), cA, voffA); PG8_STAGE(PG8_SA(0, 1), cA + hstep, voffA);
        if (wr == 1) PG8_BAR;
        PG8_WAIT_V(2); PG8_BAR;
        PG8_STAGE(PG8_SB(1, 0), cB + kstep, voffB); PG8_STAGE(PG8_SA(1, 0), cA + kstep, voffA); PG8_STAGE(PG8_SB(1, 1), cB + hstep + kstep, voffB);
        PG8_WAIT_V(6); PG8_BAR;
    } else {
        PG8_STAGE(PG8_SB(0, 0), cB, voffB); PG8_STAGE(PG8_SA(0, 0), cA, voffA); PG8_STAGE(PG8_SB(0, 1), cB + hstep, voffB); PG8_STAGE(PG8_SA(0, 1), cA + hstep, voffA);
        if (wr == 1) PG8_BAR;
        PG8_WAIT_V(4); PG8_BAR;
        PG8_STAGE(PG8_SB(1, 0), cB + kstep, voffB); PG8_STAGE(PG8_SA(1, 0), cA + kstep, voffA); PG8_STAGE(PG8_SB(1, 1), cB + hstep + kstep, voffB);
        PG8_WAIT_V(6); PG8_BAR;
    }
    for (;;) {
        const bool has_next = S.next(ui + 1, nxt);
        const char* nA = has_next ? (const char*)g.A + (size_t)nxt.pm * tstep : cA; const char* nB = has_next ? (const char*)g.Bt + (size_t)nxt.pn * tstep : cB;
        for (int t = 0; t < nt; t += 2) {
            const bool last = (t == nt - 2);
            const char* a1 = cA + (size_t)(t + 1) * kstep;
            const char* a2 = last ? nA : cA + (size_t)(t + 2) * kstep; const char* b2 = last ? nB : cB + (size_t)(t + 2) * kstep;
            const char* a3 = a2 + kstep; const char* b3 = b2 + kstep;
            if (last && has_next) S.a_ready(nxt);
            if constexpr (SP2) {
            PG8_LDB(B0, 0, 0); PG8_LDB(B1, 0, 1); PG8_SCHED; PG8_LDA(At, 0, 0); PG8_STAGE(PG8_SA(1, 1), a1 + hstep, voffA);
            PG8_WAIT_V(8); PG8_WAIT_L(0); PG8_BAR; PG8_MMA(0, 0, At, B0); PG8_MMA(0, 1, At, B1); PG8_BAR; PG8_SCHED;
            PG8_LDA(At, 0, 1); PG8_STAGE(PG8_SB(0, 0), b2, voffB); PG8_STAGE(PG8_SB(0, 1), b2 + hstep, voffB); PG8_STAGE(PG8_SA(0, 0), a2, voffA);
            PG8_WAIT_V(8); PG8_WAIT_L(0); PG8_BAR; PG8_MMA(1, 0, At, B0); PG8_MMA(1, 1, At, B1); PG8_BAR; PG8_SCHED;
            PG8_LDB(B0, 1, 0); PG8_LDB(B1, 1, 1); PG8_SCHED; PG8_LDA(At, 1, 0); PG8_STAGE(PG8_SA(0, 1), a2 + hstep, voffA);
            PG8_WAIT_V(8); PG8_WAIT_L(0); PG8_BAR; PG8_MMA(0, 0, At, B0); PG8_MMA(0, 1, At, B1); PG8_BAR; PG8_SCHED;
            PG8_LDA(At, 1, 1); PG8_STAGE(PG8_SB(1, 0), b3, voffB); PG8_STAGE(PG8_SB(1, 1), b3 + hstep, voffB); PG8_STAGE(PG8_SA(1, 0), a3, voffA);
            PG8_WAIT_V(8); PG8_WAIT_L(0); PG8_BAR; PG8_MMA(1, 0, At, B0); PG8_MMA(1, 1, At, B1); PG8_BAR; PG8_SCHED;
            } else {
            PG8_LDB(B0, 0, 0); PG8_SCHED; PG8_LDA(At, 0, 0); PG8_STAGE(PG8_SA(1, 1), a1 + hstep, voffA);
            PG8_WAIT_L(8); PG8_BAR; PG8_WAIT_L(0); PG8_MMA(0, 0, At, B0); PG8_BAR; PG8_SCHED;
            PG8_LDB(B1, 0, 1); PG8_STAGE(PG8_SB(0, 0), b2, voffB);
            PG8_BAR; PG8_WAIT_L(0); PG8_MMA(0, 1, At, B1); PG8_BAR;
            PG8_LDA(At, 0, 1); PG8_STAGE(PG8_SA(0, 0), a2, voffA);
            PG8_BAR; PG8_WAIT_L(0); PG8_MMA(1, 0, At, B0); PG8_BAR; PG8_SCHED;
            PG8_STAGE(PG8_SB(0, 1), b2 + hstep, voffB);
            PG8_WAIT_V(6); PG8_BAR; PG8_MMA(1, 1, At, B1); PG8_BAR;
            PG8_LDB(B0, 1, 0); PG8_SCHED; PG8_LDA(At, 1, 0); PG8_STAGE(PG8_SA(0, 1), a2 + hstep, voffA);
            PG8_WAIT_L(8); PG8_BAR; PG8_WAIT_L(0); PG8_MMA(0, 0, At, B0); PG8_BAR; PG8_SCHED;
            PG8_LDB(B1, 1, 1); PG8_STAGE(PG8_SB(1, 0), b3, voffB);
            PG8_BAR; PG8_WAIT_L(0); PG8_MMA(0, 1, At, B1); PG8_BAR;
            PG8_LDA(At, 1, 1); PG8_STAGE(PG8_SA(1, 0), a3, voffA);
            PG8_BAR; PG8_WAIT_L(0); PG8_MMA(1, 0, At, B0); PG8_BAR; PG8_SCHED;
            PG8_STAGE(PG8_SB(1, 1), b3 + hstep, voffB);
            PG8_WAIT_V(6); PG8_BAR; PG8_MMA(1, 1, At, B1); PG8_BAR;
            }
        }
        if constexpr (ALIGN_EPI) { if (wr == 0) PG8_BAR; }
        if constexpr (!Epi::AFTER_DRAIN) { E(acc, cur, wr, wc, fr, fq); S.done(cur); }
        if (!has_next) break;
#pragma unroll
        for (int a = 0; a < 2; ++a)
#pragma unroll
            for (int b = 0; b < 2; ++b)
#pragma unroll
                for (int m = 0; m < 4; ++m)
#pragma unroll
                    for (int n = 0; n < 2; ++n) acc[a][b][m][n] = (f32x4){0.f, 0.f, 0.f, 0.f};
        cur = nxt; cA = nA; cB = nB; ++ui;
        if constexpr (ALIGN_EPI) { if (wr == 1) PG8_BAR; }
    }
    PG8_WAIT_V(0);
    if constexpr (!ALIGN_EPI) { if (wr == 0) PG8_BAR; }
    PG8_BAR;
    if constexpr (Epi::AFTER_DRAIN) { E.fused(acc, cur, wr, wc, fr, fq, lds, wid, lane); S.done(cur); }
#undef PG8_SA
#undef PG8_SB
#undef PG8_STAGE
#undef PG8_LDA
#undef PG8_LDB
#undef PG8_MMA
#undef PG8_WAIT_V
#undef PG8_WAIT_L
#undef PG8_BAR
#undef PG8_SCHED
}
}
using namespace pg8;
#define LAS __attribute__((address_space(3)))
#define GAS __attribute__((address_space(1)))
template <class T> __device__ __forceinline__ T* as_global(T* p) { return (T*)(GAS T*)p; }
typedef short s16x4 __attribute__((ext_vector_type(4)));
typedef float f32x16 __attribute__((ext_vector_type(16)));

constexpr int BATCH = 8, SEQ = 2048, DM = 1024, MROWS = BATCH * SEQ, DEPTH = 2, NCH = 32;
constexpr int DFF = 2816, NIN = 9232, NIN_PAD = 9472, MEMROWS = BATCH * 256;
constexpr float EPS = 1e-6f, LOG2E = 1.4426950408889634f;
constexpr float QB_SCALE = 0.125f * LOG2E, QM_SCALE = 0.0625f * LOG2E;
constexpr size_t MiB = 1u << 20, SLOTB = 32 * MiB, SLOTE = (size_t)MROWS * DM;
constexpr size_t WS_SSQ = 1 * MiB, WS_AB = 2 * MiB, WS_HALO = 3 * MiB, WS_E = 8 * MiB, WS_MSSQ = 8 * MiB + 65536;
constexpr size_t WS_MEMB = 12 * MiB, WS_MEMKV = 16 * MiB, WS_W = 24 * MiB, WS_XB = 76 * MiB, WS_BIG = 108 * MiB, WS_END = 284 * MiB;
constexpr size_t WO_IN = 0, WO_A = WO_IN + (size_t)NIN_PAD * 1024, WO_B = WO_A + 1048576, WO_O = WO_B + 1048576, WO_MQ = WO_O + 1048576,
                 WO_MKV = WO_MQ + 1048576, WO_MO = WO_MKV + 2097152, WO_GU = WO_MO + 1048576, WO_DN = WO_GU + (size_t)2 * DFF * 1024, WO_END = WO_DN + (size_t)DFF * 1024;
static_assert(WS_W + WO_END * 2 <= WS_XB, "weights fit");
constexpr int LDS_BYTES = 147456;

__device__ __forceinline__ float bf2f(unsigned short b) { return __uint_as_float((unsigned)b << 16); }
__device__ __forceinline__ float bflo(unsigned w) { return __uint_as_float(w << 16); }
__device__ __forceinline__ float bfhi(unsigned w) { return __uint_as_float(w & 0xffff0000u); }
__device__ __forceinline__ float sigmoidf_(float x) { return __builtin_amdgcn_rcpf(1.f + __expf(-x)); }
__device__ __forceinline__ float siluf_(float x) { return x * __builtin_amdgcn_rcpf(1.f + __expf(-x)); }
__device__ __forceinline__ float row_rstd(const float* ssq, int row) {
    const f32x4* p = (const f32x4*)(ssq + (size_t)row * 16); const f32x4 a = p[0], b = p[1], c = p[2], d = p[3];
    const float s = ((a.x + a.y) + (a.z + a.w)) + ((b.x + b.y) + (b.z + b.w)) + ((c.x + c.y) + (c.z + c.w)) + ((d.x + d.y) + (d.z + d.w));
    return rsqrtf(s * (1.f / 1024.f) + EPS);
}
__device__ __forceinline__ float wave_sum(float v) {
#pragma unroll
    for (int o = 1; o < 64; o <<= 1) v += __shfl_xor(v, o);
    return v;
}

struct EpiIn {
    static constexpr bool PERM = true, AFTER_DRAIN = false;
    bf16_t* slot0; int act_slot, ab_tile; float* ab; bf16_t* halo; const float* ssq; int slot2;
    __device__ __forceinline__ void operator()(const f32x4 (&acc)[2][2][4][2], const Unit& u, int wr, int wc, int fr, int fq) const {
        float rs[2][4];
#pragma unroll
        for (int ai = 0; ai < 2; ++ai)
#pragma unroll
            for (int m = 0; m < 4; ++m) rs[ai][m] = row_rstd(ssq, u.pm * BM + ai * HALF + wr * 64 + m * 16 + fr);
        if (u.pn == ab_tile) {
            if (wc == 0 && fq < 2) {
#pragma unroll
                for (int ai = 0; ai < 2; ++ai)
#pragma unroll
                    for (int m = 0; m < 4; ++m) { const int row = u.pm * BM + ai * HALF + wr * 64 + m * 16 + fr;
#pragma unroll
                        for (int n = 0; n < 2; ++n) *(f32x4*)(ab + (size_t)row * 16 + 8 * fq + 4 * n) = acc[ai][0][m][n] * rs[ai][m]; }
            }
            return;
        }
        const int slot = u.pn >> 2; bf16_t* base = slot0 + (size_t)(slot == 2 ? slot2 : slot) * SLOTE; const bool act = (slot == act_slot);
        const int col0 = (u.pn & 3) * BM + wc * 32 + 8 * fq;
#pragma unroll
        for (int ai = 0; ai < 2; ++ai)
#pragma unroll
            for (int m = 0; m < 4; ++m) { const int row = u.pm * BM + ai * HALF + wr * 64 + m * 16 + fr; bf16_t* rowp = base + (size_t)row * DM + col0;
#pragma unroll
                for (int bj = 0; bj < 2; ++bj) { f32x4 v0 = acc[ai][bj][m][0] * rs[ai][m], v1 = acc[ai][bj][m][1] * rs[ai][m];
                    if (act) { v0 = (f32x4){siluf_(v0[0]), siluf_(v0[1]), siluf_(v0[2]), siluf_(v0[3])}; v1 = (f32x4){siluf_(v1[0]), siluf_(v1[1]), siluf_(v1[2]), siluf_(v1[3])}; }
                    u32x4 w; w.x = pk2(v0[0], v0[1]); w.y = pk2(v0[2], v0[3]); w.z = pk2(v1[0], v1[1]); w.w = pk2(v1[2], v1[3]);
                    *(u32x4*)(rowp + bj * HALF) = w;
                    if (halo && slot < 3 && m == 3 && fr >= 13) { const int hrow = (row >> 6) * 3 + (fr - 13); *(u32x4*)(halo + (size_t)hrow * 3072 + slot * 1024 + col0 + bj * HALF) = w; }
                } }
    }
};
struct EpiB {
    static constexpr bool PERM = true, AFTER_DRAIN = false;
    bf16_t* O; int ldc; const float* ssq; const bf16_t* g1; const bf16_t* t; int mode;
    __device__ __forceinline__ void operator()(const f32x4 (&acc)[2][2][4][2], const Unit& u, int wr, int wc, int fr, int fq) const {
        const int col0 = u.pn * BM + wc * 32 + 8 * fq;
#pragma unroll
        for (int ai = 0; ai < 2; ++ai)
#pragma unroll
            for (int m = 0; m < 4; ++m) { const int row = u.pm * BM + ai * HALF + wr * 64 + m * 16 + fr; const size_t off = (size_t)row * ldc + col0;
                float rs = 1.f; if (mode < 2) rs = row_rstd(ssq, row);
#pragma unroll
                for (int bj = 0; bj < 2; ++bj) { f32x4 v0 = acc[ai][bj][m][0] * rs, v1 = acc[ai][bj][m][1] * rs;
                    if (mode == 1) { v0 = (f32x4){sigmoidf_(v0[0]), sigmoidf_(v0[1]), sigmoidf_(v0[2]), sigmoidf_(v0[3])}; v1 = (f32x4){sigmoidf_(v1[0]), sigmoidf_(v1[1]), sigmoidf_(v1[2]), sigmoidf_(v1[3])}; }
                    if (mode >= 2) { const u32x4 g = *(const u32x4*)(g1 + off + bj * HALF);
                        v0 = v0 * (f32x4){bflo(g.x), bfhi(g.x), bflo(g.y), bfhi(g.y)}; v1 = v1 * (f32x4){bflo(g.z), bfhi(g.z), bflo(g.w), bfhi(g.w)};
                        if (mode == 3) { const u32x4 tt = *(const u32x4*)(t + off + bj * HALF);
                            v0 = v0 + (f32x4){bflo(tt.x), bfhi(tt.x), bflo(tt.y), bfhi(tt.y)}; v1 = v1 + (f32x4){bflo(tt.z), bfhi(tt.z), bflo(tt.w), bfhi(tt.w)}; } }
                    u32x4 w; w.x = pk2(v0[0], v0[1]); w.y = pk2(v0[2], v0[3]); w.z = pk2(v1[0], v1[1]); w.w = pk2(v1[2], v1[3]);
                    *(u32x4*)(O + off + bj * HALF) = w; } }
    }
};
struct EpiFfn {
    static constexpr bool PERM = true, AFTER_DRAIN = false;
    bf16_t* O; const float* ssq;
    __device__ __forceinline__ void operator()(const f32x4 (&acc)[2][2][4][2], const Unit& u, int wr, int wc, int fr, int fq) const {
        const int col0 = u.pn * HALF + wc * 32 + 8 * fq;
#pragma unroll
        for (int ai = 0; ai < 2; ++ai)
#pragma unroll
            for (int m = 0; m < 4; ++m) { const int row = u.pm * BM + ai * HALF + wr * 64 + m * 16 + fr; const float rs = row_rstd(ssq, row);
                const f32x4 g0 = acc[ai][0][m][0] * rs, g1 = acc[ai][0][m][1] * rs, u0 = acc[ai][1][m][0] * rs, u1 = acc[ai][1][m][1] * rs;
                u32x4 w; w.x = pk2(siluf_(g0[0]) * u0[0], siluf_(g0[1]) * u0[1]); w.y = pk2(siluf_(g0[2]) * u0[2], siluf_(g0[3]) * u0[3]);
                w.z = pk2(siluf_(g1[0]) * u1[0], siluf_(g1[1]) * u1[1]); w.w = pk2(siluf_(g1[2]) * u1[2], siluf_(g1[3]) * u1[3]);
                *(u32x4*)(O + (size_t)row * DFF + col0) = w; }
    }
};
struct EpiRes {
    static constexpr bool PERM = false, AFTER_DRAIN = false;
    const float* base; float* out; bf16_t* xb; float* ssq;
    __device__ __forceinline__ void operator()(const f32x4 (&acc)[2][2][4][2], const Unit& u, int wr, int wc, int fr, int fq) const {
        const int col0 = u.pn * BM + wc * 32 + 4 * fq;
#pragma unroll
        for (int ai = 0; ai < 2; ++ai)
#pragma unroll
            for (int m = 0; m < 4; ++m) { const int row = u.pm * BM + ai * HALF + wr * 64 + m * 16 + fr; const size_t off = (size_t)row * DM + col0; float s = 0.f;
#pragma unroll
                for (int bj = 0; bj < 2; ++bj)
#pragma unroll
                    for (int n = 0; n < 2; ++n) { const size_t o2 = off + bj * HALF + n * 16; const f32x4 v = *(const f32x4*)(base + o2) + acc[ai][bj][m][n];
                        *(f32x4*)(out + o2) = v; if (xb) { u32x2 w; w.x = pk2(v[0], v[1]); w.y = pk2(v[2], v[3]); *(u32x2*)(xb + o2) = w; }
                        s += (v[0] * v[0] + v[1] * v[1]) + (v[2] * v[2] + v[3] * v[3]); }
                s += __shfl_xor(s, 16); s += __shfl_xor(s, 32);
                if (fq == 0) ssq[(size_t)row * 16 + u.pn * 4 + wc] = s; }
    }
};
__device__ __forceinline__ int map_row(int mode, int n) {
    if (mode == 1) return n >= 4112 ? n + 240 : n;
    if (mode == 2) { const int m = n < DFF ? n : n - DFF; return (m >> 7) * 256 + (n < DFF ? 0 : 128) + (m & 127); }
    return n;
}
__device__ __forceinline__ void tr_item(const float* W, int K, int N, bf16_t* WT, int mode, const float* g, LAS float* scr, int item, int lane) {
    const int nblk = (N + 63) / 64, kb = item / nblk, nb = item % nblk, k0 = 64 * kb, n0 = 64 * nb;
    const int nl = n0 + 4 * (lane & 15), kr = lane >> 4;
    f32x4 v[16];
#pragma unroll
    for (int i = 0; i < 16; ++i) { const int kk = 4 * i + kr; v[i] = (nl < N) ? *(const f32x4*)(W + (size_t)(k0 + kk) * N + nl) : (f32x4){0.f, 0.f, 0.f, 0.f}; }
#pragma unroll
    for (int i = 0; i < 16; ++i) { const int kk = 4 * i + kr; f32x4 x = v[i]; if (g) x = x * g[k0 + kk]; *(LAS f32x4*)(scr + kk * 68 + 4 * (lane & 15)) = x; }
    asm volatile("s_waitcnt lgkmcnt(0)" ::: "memory");
    const int c = lane & 7;
#pragma unroll
    for (int j = 0; j < 8; ++j) { const int nn = (lane >> 3) + 8 * j, n = n0 + nn;
        if (n < N) { float sc = 1.f; if (mode == 1 && n >= 4112 && n < 5136) sc = QB_SCALE; if (mode == 3) sc = QM_SCALE;
            const LAS float* s = scr + (8 * c) * 68 + nn;
            u32x4 o; o.x = pk2(s[0 * 68] * sc, s[1 * 68] * sc); o.y = pk2(s[2 * 68] * sc, s[3 * 68] * sc); o.z = pk2(s[4 * 68] * sc, s[5 * 68] * sc); o.w = pk2(s[6 * 68] * sc, s[7 * 68] * sc);
            *(u32x4*)(WT + (size_t)map_row(mode, n) * K + k0 + 8 * c) = o; } }
    asm volatile("s_waitcnt lgkmcnt(0)" ::: "memory");
}
struct Inputs { const float* p[21]; };
__device__ __forceinline__ void convert_phase(LAS unsigned char* lds, const Inputs& in, bf16_t* Wt, int l, int gw, int NGW, int wid, int lane) {
    LAS float* scr = (LAS float*)(lds + wid * 18432);
    constexpr int I_IN = 16 * 145, I_SQ = 16 * 16, I_MKV = 16 * 32, I_GU = 16 * 88, I_DN = 44 * 16;
    constexpr int NITEMS = I_IN + 5 * I_SQ + I_MKV + I_GU + I_DN;
    for (int it = gw; it < NITEMS; it += NGW) {
        int r = it;
        if (r < I_IN) { tr_item(as_global(in.p[3]) + (size_t)l * 1024 * NIN, 1024, NIN, Wt + WO_IN, 1, as_global(in.p[2]) + l * 1024, scr, r, lane); continue; } r -= I_IN;
        if (r < I_SQ) { tr_item(as_global(in.p[8]) + (size_t)l * 1048576, 1024, 1024, Wt + WO_A, 0, nullptr, scr, r, lane); continue; } r -= I_SQ;
        if (r < I_SQ) { tr_item(as_global(in.p[9]) + (size_t)l * 1048576, 1024, 1024, Wt + WO_B, 0, nullptr, scr, r, lane); continue; } r -= I_SQ;
        if (r < I_SQ) { tr_item(as_global(in.p[11]) + (size_t)l * 1048576, 1024, 1024, Wt + WO_O, 0, nullptr, scr, r, lane); continue; } r -= I_SQ;
        if (r < I_SQ) { tr_item(as_global(in.p[14]) + (size_t)l * 1048576, 1024, 1024, Wt + WO_MQ, 3, as_global(in.p[12]) + l * 1024, scr, r, lane); continue; } r -= I_SQ;
        if (r < I_SQ) { tr_item(as_global(in.p[16]) + (size_t)l * 1048576, 1024, 1024, Wt + WO_MO, 0, nullptr, scr, r, lane); continue; } r -= I_SQ;
        if (r < I_MKV) { tr_item(as_global(in.p[15]) + (size_t)l * 2097152, 1024, 2048, Wt + WO_MKV, 0, as_global(in.p[13]) + l * 1024, scr, r, lane); continue; } r -= I_MKV;
        if (r < I_GU) { tr_item(as_global(in.p[18]) + (size_t)l * 1024 * 2 * DFF, 1024, 2 * DFF, Wt + WO_GU, 2, as_global(in.p[17]) + l * 1024, scr, r, lane); continue; } r -= I_GU;
        tr_item(as_global(in.p[19]) + (size_t)l * DFF * 1024, DFF, 1024, Wt + WO_DN, 0, nullptr, scr, r, lane);
    }
    for (int i = gw * 64 + lane; i < 240 * 128; i += NGW * 64) *(u32x4*)(Wt + WO_IN + (size_t)4112 * 1024 + (size_t)i * 8) = (u32x4){0u, 0u, 0u, 0u};
}
__device__ __forceinline__ void rows_to_bf16(const float* x, bf16_t* xb, float* ssq, int nrows, int gw, int NGW, int lane) {
    for (int m = gw; m < nrows; m += NGW) {
        const f32x4* xr = (const f32x4*)(x + (size_t)m * DM) + lane; f32x4 v[4]; float s = 0.f;
#pragma unroll
        for (int j = 0; j < 4; ++j) { v[j] = xr[64 * j]; s += (v[j].x * v[j].x + v[j].y * v[j].y) + (v[j].z * v[j].z + v[j].w * v[j].w); }
        s = wave_sum(s);
        u32x2* o8 = (u32x2*)(xb + (size_t)m * DM) + lane;
#pragma unroll
        for (int j = 0; j < 4; ++j) { u32x2 w; w.x = pk2(v[j].x, v[j].y); w.y = pk2(v[j].z, v[j].w); o8[64 * j] = w; }
        if (lane < 16) ssq[(size_t)m * 16 + lane] = (lane == 0) ? s : 0.f;
    }
}
__device__ __forceinline__ void final_norm(float* out, const float* ssq, const float* g, int gw, int NGW, int lane) {
    for (int m = gw; m < MROWS; m += NGW) {
        const float rs = row_rstd(ssq, m); f32x4* xr = (f32x4*)(out + (size_t)m * DM) + lane; const f32x4* gr = (const f32x4*)g + lane;
#pragma unroll
        for (int j = 0; j < 4; ++j) xr[64 * j] = xr[64 * j] * rs * gr[64 * j];
    }
}
__device__ __forceinline__ void oa_norm_rows(const bf16_t* o, bf16_t* za, const float* hn, int m0, int NGW, int lane) {
    for (int m = m0; m < MROWS; m += NGW) {
        const size_t off = (size_t)m * DM + lane * 16; const u32x4 a0 = *(const u32x4*)(o + off), a1 = *(const u32x4*)(o + off + 8); const u32x4 z0 = *(const u32x4*)(za + off), z1 = *(const u32x4*)(za + off + 8);
        float v[16] = {bflo(a0.x), bfhi(a0.x), bflo(a0.y), bfhi(a0.y), bflo(a0.z), bfhi(a0.z), bflo(a0.w), bfhi(a0.w), bflo(a1.x), bfhi(a1.x), bflo(a1.y), bfhi(a1.y), bflo(a1.z), bfhi(a1.z), bflo(a1.w), bfhi(a1.w)};
        float z[16] = {bflo(z0.x), bfhi(z0.x), bflo(z0.y), bfhi(z0.y), bflo(z0.z), bfhi(z0.z), bflo(z0.w), bfhi(z0.w), bflo(z1.x), bfhi(z1.x), bflo(z1.y), bfhi(z1.y), bflo(z1.z), bfhi(z1.z), bflo(z1.w), bfhi(z1.w)};
        float s = 0.f;
#pragma unroll
        for (int j = 0; j < 16; ++j) s += v[j] * v[j];
        s += __shfl_xor(s, 1); s += __shfl_xor(s, 2); s += __shfl_xor(s, 4);
        const float rs = rsqrtf(s * (1.f / 128.f) + EPS); const float* h = hn + (lane & 7) * 16;
#pragma unroll
        for (int j = 0; j < 16; ++j) v[j] = v[j] * rs * h[j] * z[j];
        u32x4 w0, w1; w0.x = pk2(v[0], v[1]); w0.y = pk2(v[2], v[3]); w0.z = pk2(v[4], v[5]); w0.w = pk2(v[6], v[7]); w1.x = pk2(v[8], v[9]); w1.y = pk2(v[10], v[11]); w1.z = pk2(v[12], v[13]); w1.w = pk2(v[14], v[15]);
        *(u32x4*)(za + off) = w0; *(u32x4*)(za + off + 8) = w1;
    }
}

#define MFMA16(a, b, c) __builtin_amdgcn_mfma_f32_16x16x32_bf16((a), (b), (c), 0, 0, 0)
#define MFMA32(a, b, c) __builtin_amdgcn_mfma_f32_32x32x16_bf16((a), (b), (c), 0, 0, 0)
constexpr int RP = 272, LP = 68;
constexpr int PR_QS = 0, PR_KS = 17408, PR_RHS = 34816, PR_LM = 104448, PR_G = 121856, PR_B = 122112, PR_CW = 122368, PR_DP = 128512;
#define LBAR() asm volatile("s_waitcnt lgkmcnt(0)\n\ts_barrier" ::: "memory")
__device__ __forceinline__ void prep_phase(LAS unsigned char* lds, bf16_t* R0, const float* ab, const bf16_t* halo, const float* convw, const float* a_log, const float* dt_bias,
                                           bf16_t* KT, bf16_t* PT, float* Eg, bf16_t* Oq, bf16_t* Ow, bf16_t* Ou, int tid, int wid, int lane) {
    LAS unsigned char* qs = lds + PR_QS; LAS unsigned char* ks = lds + PR_KS; LAS float* rhs = (LAS float*)(lds + PR_RHS); LAS float* Lm = (LAS float*)(lds + PR_LM);
    LAS float* Gs = (LAS float*)(lds + PR_G); LAS float* Bs = (LAS float*)(lds + PR_B); LAS float* cw = (LAS float*)(lds + PR_CW);
    int cw_head = -1;
    float pa, pb; { const int u0 = (int)blockIdx.x < BATCH * NCH * 8 ? (int)blockIdx.x : 0; pa = ab[(size_t)((u0 >> 3) * 64 + lane) * 16 + (u0 & 7)]; pb = ab[(size_t)((u0 >> 3) * 64 + lane) * 16 + 8 + (u0 & 7)]; }
#pragma unroll 1
    for (int unit = blockIdx.x; unit < BATCH * NCH * 8; unit += gridDim.x) {
        const int h = unit & 7, row0 = (unit >> 3) * 64, nchunk = (unit >> 3) & 31;
        const bool restaged = (h != cw_head);
        if (h != cw_head) {
            for (int i = tid; i < 4 * 3 * 128; i += 512) { const int tap = i / 384, rem = i % 384; cw[i] = convw[(size_t)tap * 3072 + (rem >> 7) * 1024 + h * 128 + (rem & 127)]; }
            cw_head = h;
        }
        {
            const float a = pa, bt = pb;
            { const int un = unit + (int)gridDim.x < BATCH * NCH * 8 ? unit + (int)gridDim.x : unit; pa = ab[(size_t)((un >> 3) * 64 + lane) * 16 + (un & 7)]; pb = ab[(size_t)((un >> 3) * 64 + lane) * 16 + 8 + (un & 7)]; }
            const float x = a + dt_bias[h]; const float sp = x > 20.f ? x : __logf(1.f + __expf(x)); float g = -__expf(a_log[h]) * sp;
#pragma unroll
            for (int o = 1; o < 64; o <<= 1) { const float y = __shfl_up(g, o); if (lane >= o) g += y; }
            Gs[lane] = g; Bs[lane] = 1.f / (1.f + __expf(-bt)); if (wid == 0 && lane == 63) Eg[unit] = __expf(g);
        }
        if (restaged) LBAR(); else asm volatile("s_waitcnt lgkmcnt(0)" ::: "memory");
        {
            const int t = tid >> 3, c0 = (tid & 7) * 16; const float beta = Bs[t], eg = __expf(Gs[t]);
#pragma unroll
            for (int mat = 0; mat < 3; ++mat) {
                const bf16_t* src = R0 + (size_t)mat * SLOTE; float acc[16];
#pragma unroll
                for (int j = 0; j < 16; ++j) acc[j] = 0.f;
#pragma unroll
                for (int i = 0; i < 4; ++i) { const int tt = t - 3 + i; u32x4 x0 = {0u, 0u, 0u, 0u}, x1 = {0u, 0u, 0u, 0u};
                    if (tt >= 0) { const bf16_t* p = src + (size_t)(row0 + tt) * DM + h * 128 + c0; x0 = *(const u32x4*)p; x1 = *(const u32x4*)(p + 8); }
                    else if (nchunk > 0) { const bf16_t* p = halo + (size_t)(((row0 >> 6) - 1) * 3 + (3 + tt)) * 3072 + mat * 1024 + h * 128 + c0; x0 = *(const u32x4*)p; x1 = *(const u32x4*)(p + 8); }
                    const LAS f32x4* wp = (const LAS f32x4*)(cw + i * 384 + mat * 128 + c0); const f32x4 w0 = wp[0], w1 = wp[1], w2 = wp[2], w3 = wp[3];
                    acc[0] += w0.x * bflo(x0.x); acc[1] += w0.y * bfhi(x0.x); acc[2] += w0.z * bflo(x0.y); acc[3] += w0.w * bfhi(x0.y);
                    acc[4] += w1.x * bflo(x0.z); acc[5] += w1.y * bfhi(x0.z); acc[6] += w1.z * bflo(x0.w); acc[7] += w1.w * bfhi(x0.w);
                    acc[8] += w2.x * bflo(x1.x); acc[9] += w2.y * bfhi(x1.x); acc[10] += w2.z * bflo(x1.y); acc[11] += w2.w * bfhi(x1.y);
                    acc[12] += w3.x * bflo(x1.z); acc[13] += w3.y * bfhi(x1.z); acc[14] += w3.z * bflo(x1.w); acc[15] += w3.w * bfhi(x1.w); }
                float ss = 0.f;
#pragma unroll
                for (int j = 0; j < 16; ++j) { acc[j] = siluf_(acc[j]); ss += acc[j] * acc[j]; }
                if (mat < 2) {
                    ss += __shfl_xor(ss, 1); ss += __shfl_xor(ss, 2); ss += __shfl_xor(ss, 4);
                    const float rn = rsqrtf(ss + EPS) * (mat == 0 ? 0.08838834764831845f : 1.f);
#pragma unroll
                    for (int j = 0; j < 16; ++j) acc[j] *= rn;
                    u32x4 w0, w1; w0.x = pk2(acc[0], acc[1]); w0.y = pk2(acc[2], acc[3]); w0.z = pk2(acc[4], acc[5]); w0.w = pk2(acc[6], acc[7]);
                    w1.x = pk2(acc[8], acc[9]); w1.y = pk2(acc[10], acc[11]); w1.z = pk2(acc[12], acc[13]); w1.w = pk2(acc[14], acc[15]);
                    LAS unsigned char* d = (mat == 0 ? qs : ks) + t * 272 + c0 * 2; *(LAS u32x4*)d = w0; *(LAS u32x4*)(d + 16) = w1;
                }
                if (mat >= 1) { const float sc = (mat == 1) ? beta * eg : beta; LAS float* d = rhs + t * RP + (mat == 1 ? 128 : 0) + c0;
#pragma unroll
                    for (int j4 = 0; j4 < 4; ++j4) *(LAS f32x4*)(d + 4 * j4) = (f32x4){acc[4 * j4] * sc, acc[4 * j4 + 1] * sc, acc[4 * j4 + 2] * sc, acc[4 * j4 + 3] * sc}; }
            }
        }
        LBAR();
        {
            const int mtx = wid >> 2, ti = wid & 3, r = lane & 15, quad = lane >> 4; const LAS unsigned char* Ab = mtx ? qs : ks;
#pragma unroll
            for (int tj = 0; tj < 4; ++tj) { f32x4 c = {0.f, 0.f, 0.f, 0.f};
#pragma unroll
                for (int s = 0; s < 4; ++s) { const bf16x8 a = *(const LAS bf16x8*)(Ab + (16 * ti + r) * 272 + (32 * s + quad * 8) * 2); const bf16x8 b = *(const LAS bf16x8*)(ks + (16 * tj + r) * 272 + (32 * s + quad * 8) * 2); c = MFMA16(a, b, c); }
#pragma unroll
                for (int jj = 0; jj < 4; ++jj) { const int t = 16 * ti + quad * 4 + jj, col = 16 * tj + r; const float dec = (col <= t) ? __expf(Gs[t] - Gs[col]) : 0.f;
                    if (mtx == 0) Lm[t * LP + col] = (col < t) ? -(Bs[t] * c[jj] * dec) : 0.f;
                    else PT[(size_t)unit * 4096 + t * 64 + col] = (bf16_t)(pk2(c[jj] * dec, 0.f) & 0xffffu); }
            }
            if (mtx == 0 && lane < 16) {
                float d[16]; const LAS float* Lb = Lm + (16 * ti) * LP + 16 * ti; LAS float* DP = (LAS float*)(lds + PR_DP) + ti * 256 + (lane & 3) * 64 + (lane >> 2) * 16;
                f32x4 rc[4], rn[4];
#pragma unroll
                for (int q = 0; q < 4; ++q) { rc[q] = *(const LAS f32x4*)(Lb + 1 * LP + 4 * q); rn[q] = rc[q]; }
                d[0] = (lane == 0) ? 1.f : 0.f; DP[0] = d[0];
#pragma unroll
                for (int rr = 1; rr < 16; ++rr) {
                    if (rr < 15) {
#pragma unroll
                        for (int q = 0; q < 4; ++q) if (4 * q < rr + 1) rn[q] = *(const LAS f32x4*)(Lb + (rr + 1) * LP + 4 * q); }
                    float a0 = (rr == lane) ? 1.f : 0.f, a1 = 0.f;
#pragma unroll
                    for (int k = 0; k < rr; ++k) { if (k & 1) a1 += rc[k >> 2][k & 3] * d[k]; else a0 += rc[k >> 2][k & 3] * d[k]; }
                    d[rr] = a0 + a1; DP[rr] = d[rr];
#pragma unroll
                    for (int q = 0; q < 4; ++q) rc[q] = rn[q];
                }
            }
        }
        LBAR();
        {
            const int r = lane & 15, quad = lane >> 4; const LAS float* DPb = (const LAS float*)(lds + PR_DP);
#pragma unroll 1
            for (int I = 0; I < 4; ++I) {
                f32x4 C0, C1; LAS float* x0 = rhs + (16 * I + 4 * quad) * RP + wid * 32 + r; LAS float* x1 = x0 + 16;
#pragma unroll
                for (int jj = 0; jj < 4; ++jj) { C0[jj] = x0[jj * RP]; C1[jj] = x1[jj * RP]; }
#pragma unroll 2
                for (int j0 = 0; j0 < 16 * I; j0 += 4) { const float a = Lm[(16 * I + r) * LP + j0 + quad]; const LAS float* bp = rhs + (j0 + quad) * RP + wid * 32 + r;
                    C0 = __builtin_amdgcn_mfma_f32_16x16x4f32(a, bp[0], C0, 0, 0, 0); C1 = __builtin_amdgcn_mfma_f32_16x16x4f32(a, bp[16], C1, 0, 0, 0); }
                f32x4 X0 = {0.f, 0.f, 0.f, 0.f}, X1 = {0.f, 0.f, 0.f, 0.f};
#pragma unroll
                for (int sx = 0; sx < 4; ++sx) { const float a = DPb[I * 256 + sx * 64 + quad * 16 + r];
                    X0 = __builtin_amdgcn_mfma_f32_16x16x4f32(a, C0[sx], X0, 0, 0, 0); X1 = __builtin_amdgcn_mfma_f32_16x16x4f32(a, C1[sx], X1, 0, 0, 0); }
#pragma unroll
                for (int jj = 0; jj < 4; ++jj) { x0[jj * RP] = X0[jj]; x1[jj * RP] = X1[jj]; }
            }
        }
        {
#pragma unroll
            for (int k = 0; k < 2; ++k) { const int p = tid + 512 * k, t = p >> 4, c8 = (p & 15) * 8; const u32x4 v = *(const LAS u32x4*)(qs + t * 272 + c8 * 2); const float eg = __expf(Gs[t]);
                u32x4 w; w.x = pk2(bflo(v.x) * eg, bfhi(v.x) * eg); w.y = pk2(bflo(v.y) * eg, bfhi(v.y) * eg); w.z = pk2(bflo(v.z) * eg, bfhi(v.z) * eg); w.w = pk2(bflo(v.w) * eg, bfhi(v.w) * eg);
                *(u32x4*)(Oq + (size_t)(row0 + t) * DM + h * 128 + c8) = w; }
            const int dk = tid & 127, qtr = tid >> 7; const float g63 = Gs[63];
#pragma unroll
            for (int tg = 0; tg < 2; ++tg) { float v[8];
#pragma unroll
                for (int i = 0; i < 8; ++i) { const int t = 16 * qtr + 8 * tg + i; v[i] = bf2f(*(const LAS unsigned short*)(ks + t * 272 + dk * 2)) * __expf(g63 - Gs[t]); }
                u32x4 w; w.x = pk2(v[0], v[1]); w.y = pk2(v[2], v[3]); w.z = pk2(v[4], v[5]); w.w = pk2(v[6], v[7]);
                *(u32x4*)(KT + (size_t)unit * 8192 + dk * 64 + 16 * qtr + 8 * tg) = w; }
        }
        LBAR();
#pragma unroll
        for (int k = 0; k < 4; ++k) { const int p = tid + 512 * k, t = p >> 5, c8 = (p & 31) * 8; const f32x4 v0 = *(const LAS f32x4*)(rhs + t * RP + c8), v1 = *(const LAS f32x4*)(rhs + t * RP + c8 + 4);
            const float sg = (c8 < 128) ? 1.f : -1.f; u32x4 w; w.x = pk2(v0.x * sg, v0.y * sg); w.y = pk2(v0.z * sg, v0.w * sg); w.z = pk2(v1.x * sg, v1.y * sg); w.w = pk2(v1.z * sg, v1.w * sg);
            bf16_t* dst = (c8 < 128) ? (Ou + (size_t)(row0 + t) * DM + h * 128 + c8) : (Ow + (size_t)(row0 + t) * DM + h * 128 + (c8 - 128));
            *(u32x4*)dst = w; }
        LBAR();
    }
}
constexpr int SC_W = 0, SC_Q = 17408, SC_P = 34816, SC_K = 44032, SC_U = 62464, SC_BUF = 66560;
__device__ __forceinline__ bf16x8 afrag(const LAS unsigned char* p) { const u32x2 lo = *(const LAS u32x2*)p; const u32x2 hi = *(const LAS u32x2*)(p + 32); const u32x4 v = {lo.x, lo.y, hi.x, hi.y}; return __builtin_bit_cast(bf16x8, v); }
__device__ __forceinline__ bf16x8 packB(const f32x4 a, const f32x4 b) { const u32x4 v = {pk2(a.x, a.y), pk2(a.z, a.w), pk2(b.x, b.y), pk2(b.z, b.w)}; return __builtin_bit_cast(bf16x8, v); }
__device__ __forceinline__ void scan_phase(LAS unsigned char* lds, bf16_t* R0, const bf16_t* KT, const bf16_t* PT, const float* Eg, bf16_t* Odst, int tid, int wid, int lane) {
    const int r = lane & 15, quad = lane >> 4;
    const int vcu = (gridDim.x % 8 == 0) ? (int)((blockIdx.x & 7) * (gridDim.x >> 3) + (blockIdx.x >> 3)) : (int)blockIdx.x;
    for (int task = vcu; task < 256; task += gridDim.x) {
        const int bh = task >> 2, dvq = task & 3, b = bh >> 3, h = bh & 7, dv16 = dvq * 32 + (wid & 1) * 16;
        const bf16_t* Wsrc = R0 + SLOTE; const bf16_t* Qsrc = R0; const bf16_t* Usrc = R0 + 2 * SLOTE;
        if (wid < 2) {
            f32x4 S[8];
#pragma unroll
            for (int d = 0; d < 8; ++d) S[d] = (f32x4){0.f, 0.f, 0.f, 0.f};
            float en = Eg[(size_t)((b * NCH + 0) * 8 + h)];
            __syncthreads();
#pragma unroll 1
            for (int n = 0; n < NCH; ++n) {
                f32x4 U[4], O[4]; const float ec = en; int rq = quad * 4 * DM + h * 128 + dv16 + r; asm volatile("" : "+v"(rq));
                const LAS unsigned char* B_ = lds + (n & 1) * SC_BUF; const int row0 = (b * NCH + n) * 64;
#pragma unroll
                for (int m = 0; m < 4; ++m) { const LAS unsigned short* up = (const LAS unsigned short*)(B_ + SC_U + (16 * m + quad * 4) * 64 + ((wid & 1) * 16 + r) * 2);
                    U[m] = (f32x4){bf2f(up[0]), bf2f(up[32]), bf2f(up[64]), bf2f(up[96])}; }
                if (n + 1 < NCH) en = Eg[(size_t)((b * NCH + n + 1) * 8 + h)];
                bf16x8 Sb[4];
#pragma unroll
                for (int s = 0; s < 4; ++s) Sb[s] = packB(S[2 * s], S[2 * s + 1]);
#pragma unroll
                for (int m = 0; m < 4; ++m) O[m] = (f32x4){0.f, 0.f, 0.f, 0.f};
#define SBAR_ __builtin_amdgcn_sched_barrier(0)
#define LM(m, fw, fq) do { _Pragma("unroll") for (int s = 0; s < 4; ++s) { fw[s] = afrag(B_ + SC_W + (16 * (m) + r) * 272 + (32 * s + quad * 4) * 2); fq[s] = afrag(B_ + SC_Q + (16 * (m) + r) * 272 + (32 * s + quad * 4) * 2); } } while (0)
#define MM(m, fw, fq) do { _Pragma("unroll") for (int s = 0; s < 4; ++s) { U[m] = MFMA16(fw[s], Sb[s], U[m]); O[m] = MFMA16(fq[s], Sb[s], O[m]); } } while (0)
                bf16x8 fwa[4], fqa[4], fwb[4], fqb[4], fp[8], fk[8];
                LM(0, fwa, fqa);
                LM(1, fwb, fqb); SBAR_; MM(0, fwa, fqa); SBAR_;
                LM(2, fwa, fqa); SBAR_; MM(1, fwb, fqb); SBAR_;
                LM(3, fwb, fqb); SBAR_; MM(2, fwa, fqa); SBAR_;
#pragma unroll
                for (int m = 0; m < 4; ++m)
#pragma unroll
                    for (int s = 0; s < 2; ++s) fp[m * 2 + s] = afrag(B_ + SC_P + (16 * m + r) * 144 + (32 * s + quad * 4) * 2);
                SBAR_; MM(3, fwb, fqb); SBAR_;
                bf16x8 Ub[2]; Ub[0] = packB(U[0], U[1]); Ub[1] = packB(U[2], U[3]);
#pragma unroll
                for (int d = 0; d < 4; ++d)
#pragma unroll
                    for (int s = 0; s < 2; ++s) fk[d * 2 + s] = afrag(B_ + SC_K + (16 * d + r) * 144 + (32 * s + quad * 4) * 2);
                SBAR_;
#pragma unroll
                for (int m = 0; m < 4; ++m)
#pragma unroll
                    for (int s = 0; s < 2; ++s) O[m] = MFMA16(fp[m * 2 + s], Ub[s], O[m]);
                SBAR_;
#pragma unroll
                for (int d = 0; d < 4; ++d)
#pragma unroll
                    for (int s = 0; s < 2; ++s) fp[d * 2 + s] = afrag(B_ + SC_K + (16 * (d + 4) + r) * 144 + (32 * s + quad * 4) * 2);
                SBAR_;
#pragma unroll
                for (int d = 0; d < 4; ++d) { S[d] = S[d] * ec;
#pragma unroll
                    for (int s = 0; s < 2; ++s) S[d] = MFMA16(fk[d * 2 + s], Ub[s], S[d]); }
                SBAR_;
#pragma unroll
                for (int d = 0; d < 4; ++d) { S[d + 4] = S[d + 4] * ec;
#pragma unroll
                    for (int s = 0; s < 2; ++s) S[d + 4] = MFMA16(fp[d * 2 + s], Ub[s], S[d + 4]); }
#undef LM
#undef MM
#undef SBAR_
#pragma unroll
                for (int m = 0; m < 4; ++m)
#pragma unroll
                    for (int jj = 0; jj < 4; ++jj) Odst[(size_t)(row0 + 16 * m + jj) * DM + rq] = (bf16_t)(pk2(O[m][jj], 0.f) & 0xffffu);
                __syncthreads();
            }
        } else {
            const int lt = tid - 128;
            u32x4 pfa[10], pfb[10];
#define SC_LOAD(n, pf) do { const int row0_ = (b * NCH + (n)) * 64; const size_t unit_ = (size_t)((b * NCH + (n)) * 8 + h); \
                int lt_ = lt; asm volatile("" : "+v"(lt_)); _Pragma("unroll") for (int k = 0; k < 10; ++k) { const int p = lt_ + 384 * k; const bf16_t* src; \
                    if (p < 2048) { const int q = p & 1023; src = (p < 1024 ? Wsrc : Qsrc) + (size_t)(row0_ + (q >> 4)) * DM + h * 128 + (q & 15) * 8; } \
                    else if (p < 2560) src = PT + unit_ * 4096 + (size_t)(p - 2048) * 8; \
                    else if (p < 3584) src = KT + unit_ * 8192 + (size_t)(p - 2560) * 8; \
                    else { const int q = p - 3584; src = Usrc + (size_t)(row0_ + (q >> 2)) * DM + h * 128 + dvq * 32 + (q & 3) * 8; } \
                    pf[k] = *(const u32x4*)src; } } while (0)
#define SC_STORE(buf, pf) do { LAS unsigned char* B_ = lds + (buf) * SC_BUF; \
                int lt_ = lt; asm volatile("" : "+v"(lt_)); _Pragma("unroll") for (int k = 0; k < 10; ++k) { const int p = lt_ + 384 * k; int off; \
                    if (p < 2048) { const int q = p & 1023; off = (p < 1024 ? SC_W : SC_Q) + (q >> 4) * 272 + (q & 15) * 16; } \
                    else if (p < 2560) { const int q = p - 2048; off = SC_P + (q >> 3) * 144 + (q & 7) * 16; } \
                    else if (p < 3584) { const int q = p - 2560; off = SC_K + (q >> 3) * 144 + (q & 7) * 16; } \
                    else { const int q = p - 3584; off = SC_U + (q >> 2) * 64 + (q & 3) * 16; } \
                    *(LAS u32x4*)(B_ + off) = pf[k]; } } while (0)
            SC_LOAD(0, pfa); SC_STORE(0, pfa); SC_LOAD(1, pfb);
            __syncthreads();
#pragma unroll 1
            for (int n = 0; n < NCH; n += 2) {
                if (n + 2 < NCH) SC_LOAD(n + 2, pfa);
                SC_STORE(1, pfb);
                __syncthreads();
                if (n + 3 < NCH) SC_LOAD(n + 3, pfb);
                if (n + 2 < NCH) SC_STORE(0, pfa);
                __syncthreads();
            }
#undef SC_LOAD
#undef SC_STORE
        }
    }
}

__device__ __forceinline__ int crow(int reg, int h) { return (reg & 3) + 8 * (reg >> 2) + 4 * h; }
__device__ __forceinline__ bf16x8 pack8(const f32x16& p, int s) { const u32x4 v = {pk2(p[8 * s], p[8 * s + 1]), pk2(p[8 * s + 2], p[8 * s + 3]), pk2(p[8 * s + 4], p[8 * s + 5]), pk2(p[8 * s + 6], p[8 * s + 7])}; return __builtin_bit_cast(bf16x8, v); }
__device__ __forceinline__ bf16x8 vfrag(const LAS unsigned char* p) { const u32x2 lo = *(const LAS u32x2*)p; const u32x2 hi = *(const LAS u32x2*)(p + 16); const u32x4 v = {lo.x, lo.y, hi.x, hi.y}; return __builtin_bit_cast(bf16x8, v); }
constexpr int BA_K = 0, BA_V = 18432, BA_T = 36864;
__device__ __forceinline__ void band_phase(LAS unsigned char* lds, const bf16_t* Qb, const bf16_t* Kb, const bf16_t* Vb, bf16_t* Ob, const float* rel_bias, const bf16_t* on_o, bf16_t* on_za, const float* on_hn, int gw, int NGW, int tid, int wid, int lane) {
    const int r = lane & 31, h5 = lane >> 5; LAS float* btab = (LAS float*)(lds + BA_T);
    const int vcu = (gridDim.x % 8 == 0) ? (int)((blockIdx.x & 7) * (gridDim.x >> 3) + (blockIdx.x >> 3)) : (int)blockIdx.x;
    int on_m = gw;
    for (int uu = vcu * 4; uu < 1024; uu += gridDim.x * 4)
    for (int ui = 0; ui < 4; ++ui) {
        const int bhh = uu >> 3, b = bhh >> 4, h = bhh & 15, odd = (uu >> 2) & 1; const int qblk = odd ? ((ui == 0) ? 1 : (ui == 1) ? 2 : (ui == 2) ? 5 : 6) : ((ui == 0) ? 0 : (ui == 1) ? 3 : (ui == 2) ? 4 : 7);
        const int rowb = b * SEQ, c_first = (4 * qblk - 8) > 0 ? (4 * qblk - 8) : 0, ntile = 4 * qblk + 4 - c_first;
        const int nq = 4 * qblk + (wid >> 1), qi = 32 * (wid & 1) + r; const int q0 = rowb + 256 * qblk + 32 * wid;
        if (tid < 384) { int rel = 319 - tid; rel = rel < -63 ? -63 : (rel > 256 ? 256 : rel); btab[tid] = rel_bias[h * 320 + rel + 63] * LOG2E; }
        bf16x8 qf[4];
#pragma unroll
        for (int d0 = 0; d0 < 4; ++d0) qf[d0] = *(const bf16x8*)(Qb + (size_t)(q0 + r) * DM + h * 64 + 16 * d0 + 8 * h5);
        u32x4 kreg, vreg; const int skey = tid >> 3, sc8 = tid & 7;
#define BA_LOAD(c) do { const size_t o_ = (size_t)(rowb + 64 * (c) + skey) * DM + h * 64 + sc8 * 8; kreg = *(const u32x4*)(Kb + o_); vreg = *(const u32x4*)(Vb + o_); } while (0)
#define BA_STORE(buf) do { *(LAS u32x4*)(lds + BA_K + (buf) * 9216 + skey * 144 + sc8 * 16) = kreg; LAS unsigned char* v_ = lds + BA_V + (buf) * 9216 + (sc8 * 8) * 136 + skey * 2; \
            *(LAS unsigned short*)(v_) = (unsigned short)kregv(vreg.x, 0); *(LAS unsigned short*)(v_ + 136) = (unsigned short)kregv(vreg.x, 1); *(LAS unsigned short*)(v_ + 272) = (unsigned short)kregv(vreg.y, 0); *(LAS unsigned short*)(v_ + 408) = (unsigned short)kregv(vreg.y, 1); \
            *(LAS unsigned short*)(v_ + 544) = (unsigned short)kregv(vreg.z, 0); *(LAS unsigned short*)(v_ + 680) = (unsigned short)kregv(vreg.z, 1); *(LAS unsigned short*)(v_ + 816) = (unsigned short)kregv(vreg.w, 0); *(LAS unsigned short*)(v_ + 952) = (unsigned short)kregv(vreg.w, 1); } while (0)
#define kregv(w, hi) ((hi) ? ((w) >> 16) : ((w) & 0xffffu))
        BA_LOAD(c_first); BA_STORE(0);
        float m_run = -1e30f, l_run = 0.f; f32x16 O[2];
#pragma unroll
        for (int i = 0; i < 16; ++i) { O[0][i] = 0.f; O[1][i] = 0.f; }
        __syncthreads();
        for (int ti = 0; ti < ntile; ++ti) {
            const int c = c_first + ti;
            if (ti + 1 < ntile) BA_LOAD(c + 1);
            const bool on_do = on_m < MROWS; u32x4 na0, na1, nz0, nz1; const size_t on_off = (size_t)(on_do ? on_m : 0) * DM + lane * 16;
            if (on_do) { na0 = *(const u32x4*)(on_o + on_off); na1 = *(const u32x4*)(on_o + on_off + 8); nz0 = *(const u32x4*)(on_za + on_off); nz1 = *(const u32x4*)(on_za + on_off + 8); }
            if (c >= nq - 8 && c <= nq) {
                const LAS unsigned char* Kt = lds + BA_K + (ti & 1) * 9216; const LAS unsigned char* Vt = lds + BA_V + (ti & 1) * 9216;
                f32x16 P0, P1;
#pragma unroll
                for (int i = 0; i < 16; ++i) { P0[i] = 0.f; P1[i] = 0.f; }
#pragma unroll
                for (int d0 = 0; d0 < 4; ++d0) { const bf16x8 a0 = *(const LAS bf16x8*)(Kt + r * 144 + (16 * d0 + 8 * h5) * 2); const bf16x8 a1 = *(const LAS bf16x8*)(Kt + (32 + r) * 144 + (16 * d0 + 8 * h5) * 2);
                    P0 = MFMA32(a0, qf[d0], P0); P1 = MFMA32(a1, qf[d0], P1); }
                const int dch = nq - c;
                if (dch >= 5) { const float bc = btab[0];
#pragma unroll
                    for (int i = 0; i < 16; ++i) { P0[i] += bc; P1[i] += bc; } }
                else {
                    const LAS float* bp = btab + (319 - dch * 64 - qi + 4 * h5);
#pragma unroll
                    for (int i = 0; i < 16; ++i) { P0[i] += bp[(i & 3) + 8 * (i >> 2)]; P1[i] += bp[(i & 3) + 8 * (i >> 2) + 32]; } }
                float mx = P0[0];
#pragma unroll
                for (int i = 0; i < 16; ++i) { mx = fmaxf(mx, P0[i]); mx = fmaxf(mx, P1[i]); }
                mx = fmaxf(mx, __shfl_xor(mx, 32));
                const float m_new = fmaxf(m_run, mx), alpha = __builtin_amdgcn_exp2f(m_run - m_new); m_run = m_new;
                float ls = 0.f;
#pragma unroll
                for (int i = 0; i < 16; ++i) { P0[i] = __builtin_amdgcn_exp2f(P0[i] - m_new); P1[i] = __builtin_amdgcn_exp2f(P1[i] - m_new); ls += P0[i] + P1[i]; }
                l_run = l_run * alpha + ls;
#pragma unroll
                for (int i = 0; i < 16; ++i) { O[0][i] *= alpha; O[1][i] *= alpha; }
#pragma unroll
                for (int p = 0; p < 2; ++p)
#pragma unroll
                    for (int s = 0; s < 2; ++s) { const bf16x8 pb = pack8(p ? P1 : P0, s);
#pragma unroll
                        for (int dt = 0; dt < 2; ++dt) O[dt] = MFMA32(vfrag(Vt + (32 * dt + r) * 136 + (32 * p + 16 * s + 4 * h5) * 2), pb, O[dt]); }
            }
            if (on_do) {
                float v[16] = {bflo(na0.x), bfhi(na0.x), bflo(na0.y), bfhi(na0.y), bflo(na0.z), bfhi(na0.z), bflo(na0.w), bfhi(na0.w), bflo(na1.x), bfhi(na1.x), bflo(na1.y), bfhi(na1.y), bflo(na1.z), bfhi(na1.z), bflo(na1.w), bfhi(na1.w)};
                float z[16] = {bflo(nz0.x), bfhi(nz0.x), bflo(nz0.y), bfhi(nz0.y), bflo(nz0.z), bfhi(nz0.z), bflo(nz0.w), bfhi(nz0.w), bflo(nz1.x), bfhi(nz1.x), bflo(nz1.y), bfhi(nz1.y), bflo(nz1.z), bfhi(nz1.z), bflo(nz1.w), bfhi(nz1.w)};
                float ss = 0.f;
#pragma unroll
                for (int j = 0; j < 16; ++j) ss += v[j] * v[j];
                ss += __shfl_xor(ss, 1); ss += __shfl_xor(ss, 2); ss += __shfl_xor(ss, 4);
                const float rs = rsqrtf(ss * (1.f / 128.f) + EPS); const float* hh = on_hn + (lane & 7) * 16;
#pragma unroll
                for (int j = 0; j < 16; ++j) v[j] = v[j] * rs * hh[j] * z[j];
                u32x4 w0, w1; w0.x = pk2(v[0], v[1]); w0.y = pk2(v[2], v[3]); w0.z = pk2(v[4], v[5]); w0.w = pk2(v[6], v[7]); w1.x = pk2(v[8], v[9]); w1.y = pk2(v[10], v[11]); w1.z = pk2(v[12], v[13]); w1.w = pk2(v[14], v[15]);
                *(u32x4*)(on_za + on_off) = w0; *(u32x4*)(on_za + on_off + 8) = w1; on_m += NGW;
            }
            if (ti + 1 < ntile) BA_STORE((ti + 1) & 1);
            __syncthreads();
        }
        l_run += __shfl_xor(l_run, 32); const float inv = 1.f / l_run;
#pragma unroll
        for (int dt = 0; dt < 2; ++dt)
#pragma unroll
            for (int g = 0; g < 4; ++g) { u32x2 w; w.x = pk2(O[dt][4 * g] * inv, O[dt][4 * g + 1] * inv); w.y = pk2(O[dt][4 * g + 2] * inv, O[dt][4 * g + 3] * inv);
                *(u32x2*)(Ob + (size_t)(q0 + r) * DM + h * 64 + 32 * dt + 8 * g + 4 * h5) = w; }
#undef BA_LOAD
#undef BA_STORE
#undef kregv
    }
    if (on_m < MROWS) oa_norm_rows(on_o, on_za, on_hn, on_m, NGW, lane);
}

__device__ __forceinline__ void xattn_phase(LAS unsigned char* lds, const bf16_t* Qm, const bf16_t* KV, bf16_t* Om, int tid, int wid, int lane) {
    const int r = lane & 31, h5 = lane >> 5;
    const int vcu = (gridDim.x % 8 == 0) ? (int)((blockIdx.x & 7) * (gridDim.x >> 3) + (blockIdx.x >> 3)) : (int)blockIdx.x;
#define SBAR_ __builtin_amdgcn_sched_barrier(0)
    for (int unit = vcu; unit < 256; unit += gridDim.x) {
        const int b = unit >> 5, mh = (unit >> 3) & 3, qblk = unit & 7; const int q0 = b * SEQ + qblk * 256 + 32 * wid;
        const bf16_t* Kg = KV + (size_t)(b * 256) * 2048 + mh * 256; const bf16_t* Vg = Kg + 1024;
#pragma unroll 1
        for (int kb = 0; kb < 16; kb += 8) { u32x4 kst[8];
#pragma unroll
          for (int k = 0; k < 8; ++k) { const int p = tid + 512 * (kb + k), key = p >> 5, c = p & 31; kst[k] = *(const u32x4*)(Kg + (size_t)key * 2048 + c * 8); }
#pragma unroll
          for (int k = 0; k < 8; ++k) { const int p = tid + 512 * (kb + k), key = p >> 5, c = p & 31; *(LAS u32x4*)(lds + key * 528 + c * 16) = kst[k]; } }
        const bf16_t* qp = Qm + (size_t)(q0 + r) * DM + mh * 256 + 8 * h5;
        bf16x8 qa = *(const bf16x8*)(qp), qb = *(const bf16x8*)(qp + 16);
        __syncthreads();
        f32x16 Sx[8];
#pragma unroll
        for (int kt = 0; kt < 8; ++kt)
#pragma unroll
            for (int i = 0; i < 16; ++i) Sx[kt][i] = 0.f;
#define LK(d0, hf, kf) do { _Pragma("unroll") for (int kt = 0; kt < 4; ++kt) kf[kt] = *(const LAS bf16x8*)(lds + (32 * ((hf) * 4 + kt) + r) * 528 + (16 * (d0) + 8 * h5) * 2); } while (0)
#define MK(kf, hf, q) do { _Pragma("unroll") for (int kt = 0; kt < 4; ++kt) Sx[(hf) * 4 + kt] = MFMA32(kf[kt], q, Sx[(hf) * 4 + kt]); } while (0)
        bf16x8 kfa[4], kfb[4];
        LK(0, 0, kfa);
#pragma unroll 1
        for (int d0 = 0; d0 < 16; d0 += 2) {
            LK(d0, 1, kfb); SBAR_; MK(kfa, 0, qa); SBAR_;
            LK(d0 + 1, 0, kfa); SBAR_; MK(kfb, 1, qa); SBAR_;
            if (d0 + 2 < 16) qa = *(const bf16x8*)(qp + 16 * (d0 + 2));
            LK(d0 + 1, 1, kfb); SBAR_; MK(kfa, 0, qb); SBAR_;
            if (d0 + 2 < 16) LK(d0 + 2, 0, kfa);
            SBAR_; MK(kfb, 1, qb); SBAR_;
            if (d0 + 3 < 16) qb = *(const bf16x8*)(qp + 16 * (d0 + 3));
        }
#undef LK
#undef MK
        float mx = Sx[0][0];
#pragma unroll
        for (int kt = 0; kt < 8; ++kt)
#pragma unroll
            for (int i = 0; i < 16; ++i) mx = fmaxf(mx, Sx[kt][i]);
        mx = fmaxf(mx, __shfl_xor(mx, 32));
        float ls = 0.f;
#pragma unroll
        for (int kt = 0; kt < 8; ++kt)
#pragma unroll
            for (int i = 0; i < 16; ++i) { Sx[kt][i] = __builtin_amdgcn_exp2f(Sx[kt][i] - mx); ls += Sx[kt][i]; }
        ls += __shfl_xor(ls, 32); const float inv = 1.f / ls;
        bf16x8 Pb[16];
#pragma unroll
        for (int kt = 0; kt < 8; ++kt) { Pb[2 * kt] = pack8(Sx[kt], 0); Pb[2 * kt + 1] = pack8(Sx[kt], 1); }
        __syncthreads();
        {
            const int kh = wid & 1, cg4 = wid >> 1, k0 = 128 * kh + 2 * lane;
#pragma unroll 1
            for (int ib = 0; ib < 8; ib += 4) { u32x4 vsa[4], vsb[4];
#pragma unroll
              for (int i = 0; i < 4; ++i) { const int c = cg4 + 4 * (ib + i); vsa[i] = *(const u32x4*)(Vg + (size_t)k0 * 2048 + c * 8); vsb[i] = *(const u32x4*)(Vg + (size_t)(k0 + 1) * 2048 + c * 8); }
#pragma unroll
              for (int i = 0; i < 4; ++i) { const int c = cg4 + 4 * (ib + i); const u32x4 va = vsa[i], vb = vsb[i];
                LAS unsigned char* d = lds + (c * 8) * 536 + k0 * 2;
                *(LAS unsigned*)(d) = (va.x & 0xffffu) | (vb.x << 16); *(LAS unsigned*)(d + 536) = (va.x >> 16) | (vb.x & 0xffff0000u);
                *(LAS unsigned*)(d + 1072) = (va.y & 0xffffu) | (vb.y << 16); *(LAS unsigned*)(d + 1608) = (va.y >> 16) | (vb.y & 0xffff0000u);
                *(LAS unsigned*)(d + 2144) = (va.z & 0xffffu) | (vb.z << 16); *(LAS unsigned*)(d + 2680) = (va.z >> 16) | (vb.z & 0xffff0000u);
                *(LAS unsigned*)(d + 3216) = (va.w & 0xffffu) | (vb.w << 16); *(LAS unsigned*)(d + 3752) = (va.w >> 16) | (vb.w & 0xffff0000u); } }
        }
        __syncthreads();
#define LV(dt, k8, vf) do { _Pragma("unroll") for (int ks = 0; ks < 8; ++ks) vf[ks] = vfrag(lds + (32 * (dt) + r) * 536 + (16 * ((k8) * 8 + ks) + 4 * h5) * 2); } while (0)
        bf16x8 vfa[8], vfb[8];
        LV(0, 0, vfa);
#pragma unroll 1
        for (int dt = 0; dt < 8; ++dt) {
            f32x16 Oa;
#pragma unroll
            for (int i = 0; i < 16; ++i) Oa[i] = 0.f;
            LV(dt, 1, vfb); SBAR_;
#pragma unroll
            for (int ks = 0; ks < 8; ++ks) Oa = MFMA32(vfa[ks], Pb[ks], Oa);
            SBAR_;
            if (dt + 1 < 8) LV(dt + 1, 0, vfa);
            SBAR_;
#pragma unroll
            for (int ks = 0; ks < 8; ++ks) Oa = MFMA32(vfb[ks], Pb[8 + ks], Oa);
            SBAR_;
#pragma unroll
            for (int g = 0; g < 4; ++g) { u32x2 w; w.x = pk2(Oa[4 * g] * inv, Oa[4 * g + 1] * inv); w.y = pk2(Oa[4 * g + 2] * inv, Oa[4 * g + 3] * inv);
                *(u32x2*)(Om + (size_t)(q0 + r) * DM + mh * 256 + 32 * dt + 8 * g + 4 * h5) = w; }
        }
#undef LV
        __syncthreads();
    }
#undef SBAR_
}
#define XB_TMO      128
#define XB_XCNT(j)  (256  + 64 * (j))
#define XB_XSUB(j)  (1280 + 64 * (j))
#define XB_XGEN(j)  (2304 + 64 * (j))
#define XB_TOP      3328
#define XB_TOPGEN   3392
#define XCD_BAR_WORDS 3456
#define XB_SPIN_CAP (1u << 18)

__device__ __forceinline__ unsigned xb_ld(unsigned* p)              { return __hip_atomic_load(p, __ATOMIC_RELAXED, __HIP_MEMORY_SCOPE_AGENT); }
__device__ __forceinline__ unsigned xb_add(unsigned* p, unsigned v) { return __hip_atomic_fetch_add(p, v, __ATOMIC_RELAXED, __HIP_MEMORY_SCOPE_AGENT); }
__device__ __forceinline__ unsigned xb_xcc_id() { return (unsigned)__builtin_amdgcn_s_getreg((3 << 11) | 20) & 0xFu; }
#define XB_SPIN(cond, bar) do { unsigned _sp = 0; while (cond) { __builtin_amdgcn_s_sleep(1); \
    if ((++_sp & 255u) == 0u) { if (xb_ld(&(bar)[XB_TMO])) break; if (_sp > XB_SPIN_CAP) { atomicAdd(&(bar)[XB_TMO], 1u); break; } } } } while (0)

struct XcdBarrier {
    unsigned* bar; unsigned x;
    volatile LAS unsigned* st;
};

__device__ __forceinline__ XcdBarrier xcd_barrier_post(unsigned* bar, volatile LAS unsigned* st) {
    XcdBarrier b; b.bar = bar; b.x = xb_xcc_id(); b.st = st;
    if (threadIdx.x == 0) (void)xb_add(&bar[XB_XCNT(b.x)], 1u);
    return b;
}
__device__ __forceinline__ void xcd_barrier_complete(unsigned* bar, unsigned x, unsigned& nloc, unsigned& nx) {
    const unsigned G = gridDim.x * gridDim.y * gridDim.z;
    unsigned sum, cnt, mine, sp = 0u;
    for (;;) {
        sum = 0u; cnt = 0u; mine = 0u;
#pragma unroll
        for (unsigned j = 0; j < 16; ++j) { const unsigned c = xb_ld(&bar[XB_XCNT(j)]); sum += c; cnt += (c > 0u) ? 1u : 0u; mine = (j == x) ? c : mine; }
        if (sum == G) break;
        __builtin_amdgcn_s_sleep(1);
        if ((++sp & 255u) == 0u) { if (xb_ld(&bar[XB_TMO])) break; if (sp > XB_SPIN_CAP) { atomicAdd(&bar[XB_TMO], 1u); break; } }
    }
    nloc = mine > 0u ? mine : 1u; nx = cnt > 0u ? cnt : 1u;
}

__device__ __forceinline__ void xcd_barrier(const XcdBarrier& b) {
    asm volatile("s_waitcnt vmcnt(0)" ::: "memory");
    __syncthreads();
    if (threadIdx.x == 0) {
        unsigned* bar = b.bar;
        __builtin_amdgcn_s_waitcnt(0);
        unsigned nloc = b.st[0], nx = b.st[1];
        if (nloc == 0u) { xcd_barrier_complete(bar, b.x, nloc, nx); b.st[0] = nloc; b.st[1] = nx; }
        const unsigned old = xb_add(&bar[XB_XSUB(b.x)], 1u);
        const unsigned gen = old / nloc;
        if (old + 1u == (gen + 1u) * nloc) {
            __builtin_amdgcn_fence(__ATOMIC_RELEASE, "agent");
            asm volatile("s_waitcnt vmcnt(0)" ::: "memory");
            const unsigned og = xb_add(&bar[XB_TOP], 1u);
            const unsigned tg = og / nx;
            if (og + 1u == (tg + 1u) * nx) xb_add(&bar[XB_TOPGEN], 1u);
            else XB_SPIN(xb_ld(&bar[XB_TOPGEN]) == tg, bar);
            __builtin_amdgcn_fence(__ATOMIC_ACQUIRE, "agent");
            xb_add(&bar[XB_XGEN(b.x)], 1u);
            asm volatile("s_waitcnt vmcnt(0)" ::: "memory");
        } else {
            XB_SPIN(xb_ld(&bar[XB_XGEN(b.x)]) == gen, bar);
            __builtin_amdgcn_fence(__ATOMIC_ACQUIRE, "agent");
            asm volatile("s_waitcnt vmcnt(0)" ::: "memory");
        }
    }
    __syncthreads();
}
#ifndef PROBE_DUP_MASK
#define PROBE_DUP_MASK 0
#endif
#ifndef PROBE_EXTRA_SYNC
#define PROBE_EXTRA_SYNC 0
#endif
struct Args { Inputs in; float* out; unsigned char* ws; };
enum { PH_IN_A = 0, PH_MEMKV, PH_PREP, PH_SCAN, PH_IN_B, PH_BAND, PH_GA, PH_T, PH_GB, PH_Y, PH_WO, PH_QM, PH_XATTN, PH_WMO, PH_FFN, PH_DOWN, PH_CONV, PH_COUNT };
__global__ void __launch_bounds__(512, 2) fwd_megakernel(Args args) {
    extern __shared__ __attribute__((aligned(16))) unsigned char lds_raw[];
    cg::grid_group grid = cg::this_grid();
    LAS unsigned char* lds = (LAS unsigned char*)lds_raw;
    const int tid = threadIdx.x, lane = tid & 63, wid = __builtin_amdgcn_readfirstlane(tid >> 6);
    const int G = gridDim.x, gw = blockIdx.x * 8 + wid, NGW = G * 8;
    unsigned char* ws = as_global(args.ws); const Inputs& in = args.in;
    float* ssq = (float*)(ws + WS_SSQ); float* ab = (float*)(ws + WS_AB); bf16_t* halo = (bf16_t*)(ws + WS_HALO); float* Eg = (float*)(ws + WS_E); float* mssq = (float*)(ws + WS_MSSQ);
    bf16_t* memb = (bf16_t*)(ws + WS_MEMB); bf16_t* memkv = (bf16_t*)(ws + WS_MEMKV); bf16_t* Wt = (bf16_t*)(ws + WS_W); bf16_t* xb = (bf16_t*)(ws + WS_XB);
    bf16_t* R0 = (bf16_t*)(ws + WS_BIG); bf16_t* R1 = R0 + SLOTE; bf16_t* R2 = R0 + 2 * SLOTE; bf16_t* R3 = R0 + 3 * SLOTE; bf16_t* R4 = R0 + 4 * SLOTE; bf16_t* R5 = R0 + 5 * SLOTE;
    float* out = as_global(args.out);
    volatile LAS unsigned* bst = (volatile LAS unsigned*)(lds + LDS_BYTES - 64);
    if (threadIdx.x < 16) bst[threadIdx.x] = 0u;
    __syncthreads();
    XcdBarrier xbar = xcd_barrier_post((unsigned*)ws, bst);

    if (args.out == nullptr) grid.sync();

    for (int l = 0; l < DEPTH; ++l) {
        int rep_ = 0;
        for (int ph = (l == 0) ? -1 : 0; ph < PH_COUNT; ++ph) {
            if (ph == PH_CONV && l == DEPTH - 1) continue;
            const bool dupl = (ph >= 0) && ((PROBE_DUP_MASK >> (ph & 31)) & 1) && !((ph == PH_PREP || ph == PH_SCAN || ph == PH_BAND) && l != 0);
            unsigned char* ws = as_global(args.ws);
            float* ssq = (float*)(ws + WS_SSQ); float* ab = (float*)(ws + WS_AB); bf16_t* halo = (bf16_t*)(ws + WS_HALO); float* Eg = (float*)(ws + WS_E); float* mssq = (float*)(ws + WS_MSSQ);
            bf16_t* memb = (bf16_t*)(ws + WS_MEMB); bf16_t* memkv = (bf16_t*)(ws + WS_MEMKV); bf16_t* Wt = (bf16_t*)(ws + WS_W); bf16_t* xb = (bf16_t*)(ws + WS_XB);
            bf16_t* R0 = (bf16_t*)(ws + WS_BIG); bf16_t* R1 = R0 + SLOTE; bf16_t* R2 = R0 + 2 * SLOTE; bf16_t* R3 = R0 + 3 * SLOTE; bf16_t* R4 = R0 + 4 * SLOTE; bf16_t* R5 = R0 + 5 * SLOTE;
            int tid = threadIdx.x; asm volatile("" : "+v"(tid)); const int lane = tid & 63, wid = __builtin_amdgcn_readfirstlane(tid >> 6), gw = blockIdx.x * 8 + wid;
            int kind = -1;
            Gemm g{nullptr, nullptr, MROWS, 1024, 1024}; int cshift = 0;
            EpiIn ei{R0, -1, -1, ab, nullptr, ssq, 2}; EpiB eb{nullptr, DM, ssq, nullptr, nullptr, 0}; EpiRes er{out, out, xb, ssq};
            bool sync_after = true;
            switch (ph) {
                case PH_IN_A: kind = 0; g.A = xb; g.Bt = Wt + WO_IN; g.N = 4352; ei.act_slot = 3; ei.ab_tile = 16; ei.halo = halo; sync_after = false; break;
                case PH_MEMKV: kind = 1; g.A = memb; g.Bt = Wt + WO_MKV; g.M = MEMROWS; g.N = 2048; eb.O = memkv; eb.ldc = 2048; eb.ssq = mssq; eb.mode = 0; cshift = 192; break;
                case PH_IN_B: kind = 0; g.A = xb; g.Bt = Wt + WO_IN + (size_t)4352 * 1024; g.N = 3072; ei.slot2 = 4; break;
                case PH_GA: kind = 1; g.A = xb; g.Bt = Wt + WO_IN + (size_t)7424 * 1024; eb.O = R1; eb.mode = 1; sync_after = false; break;
                case PH_T: kind = 1; g.A = R3; g.Bt = Wt + WO_A; eb.O = R2; eb.g1 = R1; eb.mode = 2; sync_after = false; break;
                case PH_GB: kind = 1; g.A = xb; g.Bt = Wt + WO_IN + (size_t)8448 * 1024; eb.O = R1; eb.mode = 1; sync_after = false; break;
                case PH_Y: kind = 1; g.A = R0; g.Bt = Wt + WO_B; eb.O = R4; eb.g1 = R1; eb.t = R2; eb.mode = 3; break;
                case PH_WO: kind = 3; g.A = R4; g.Bt = Wt + WO_O; er.base = (l == 0) ? as_global(in.p[0]) : out; break;
                case PH_QM: kind = 1; g.A = xb; g.Bt = Wt + WO_MQ; eb.O = R0; eb.mode = 0; break;
                case PH_WMO: kind = 3; g.A = R1; g.Bt = Wt + WO_MO; break;
                case PH_FFN: kind = 2; g.A = xb; g.Bt = Wt + WO_GU; g.N = 2 * DFF; break;
                case PH_DOWN: kind = 3; g.A = R0; g.Bt = Wt + WO_DN; g.K = DFF; if (l == DEPTH - 1) er.xb = nullptr; break;
                default: break;
            }
            if (kind >= 0) {
#ifndef SKIP_GEMM
                StaticOrder S; S.init(g.M, g.N, G, (int)((blockIdx.x + cshift) % G));
#ifndef SKIP_G0
                if (kind == 0) gemm_phase<EpiIn, StaticOrder, true, true>(lds, g, S, ei);
#endif
#ifndef SKIP_G1
                if (kind == 1) gemm_phase<EpiB, StaticOrder, true, true>(lds, g, S, eb);
#endif
#ifndef SKIP_G2
                if (kind == 2) { EpiFfn ef{R0, ssq}; gemm_phase<EpiFfn, StaticOrder, true, true>(lds, g, S, ef); }
#endif
#ifndef SKIP_G3
                if (kind == 3) gemm_phase<EpiRes, StaticOrder, true, true>(lds, g, S, er);
#endif
#endif
            } else if (ph == PH_PREP) {
#ifndef SKIP_PREP
                prep_phase(lds, R0, ab, halo, as_global(in.p[4]) + (size_t)l * 4 * 3072, as_global(in.p[5]) + l * 8, as_global(in.p[6]) + l * 8, R4, R5, Eg, (rep_ == 0 && dupl) ? (bf16_t*)out : R0, (rep_ == 0 && dupl) ? (bf16_t*)out + SLOTE : R1, (rep_ == 0 && dupl) ? (bf16_t*)out : R2, tid, wid, lane);
#endif
            } else if (ph == PH_SCAN) {
#ifndef SKIP_SCAN
                scan_phase(lds, R0, R4, R5, Eg, (rep_ == 0 && dupl) ? (bf16_t*)out : R2, tid, wid, lane);
#endif
            } else if (ph == PH_BAND) {
#ifndef SKIP_BAND
                band_phase(lds, R0, R1, R4, (rep_ == 0 && dupl) ? (bf16_t*)out : R0, as_global(in.p[10]), R2, R3, as_global(in.p[7]) + l * 128, gw, NGW, tid, wid, lane);
#endif
            } else if (ph == PH_XATTN) {
#ifndef SKIP_XATTN
                xattn_phase(lds, R0, memkv, R1, tid, wid, lane);
#endif
            } else if (ph == PH_CONV || ph < 0) {
                convert_phase(lds, in, Wt, ph < 0 ? 0 : l + 1, gw, NGW, wid, lane);
                if (ph < 0) { rows_to_bf16(as_global(in.p[0]), xb, ssq, MROWS, gw, NGW, lane); rows_to_bf16(as_global(in.p[1]), memb, mssq, MEMROWS, gw, NGW, lane); }
            }
            if (dupl && rep_ == 0) { rep_ = 1; --ph; continue; }
            rep_ = 0;
            if (sync_after) { xcd_barrier(xbar); for (int e_ = 0; e_ < PROBE_EXTRA_SYNC; ++e_) xcd_barrier(xbar); }
        }
    }
    final_norm(out, ssq, as_global(in.p[20]), gw, NGW, lane);
}

extern "C" void kernel_launch(void* const* d_in, const int* in_sizes, int n_in, void* d_out, int out_size, void* d_ws, size_t ws_size, hipStream_t stream) {
    static int grid = 0;
    if (grid == 0) {
        if (n_in != 21 || out_size != MROWS * DM || ws_size < WS_END) { fprintf(stderr, "kernel_launch: unexpected shapes (n_in %d out %d ws %zu)\n", n_in, out_size, ws_size); grid = -1; return; }
        int dev = 0, cus = 0, per_cu = 0;
        hipGetDevice(&dev); hipDeviceGetAttribute(&cus, hipDeviceAttributeMultiprocessorCount, dev);
        if (hipFuncSetAttribute((const void*)fwd_megakernel, hipFuncAttributeMaxDynamicSharedMemorySize, LDS_BYTES) != hipSuccess) { fprintf(stderr, "kernel_launch: hipFuncSetAttribute failed\n"); grid = -1; return; }
        if (hipOccupancyMaxActiveBlocksPerMultiprocessor(&per_cu, (const void*)fwd_megakernel, 512, LDS_BYTES) != hipSuccess || per_cu < 1) { fprintf(stderr, "kernel_launch: occupancy query says %d\n", per_cu); per_cu = 1; }
        (void)hipGetLastError();
        grid = cus * 1;
        if (grid > 256) grid = 256;
    }
    if (grid < 0) return;
    if (hipMemsetAsync(d_ws, 0, 16384, stream) != hipSuccess) { fprintf(stderr, "kernel_launch: memset failed\n"); return; }
    Args a{};
    for (int i = 0; i < 21; ++i) a.in.p[i] = (const float*)d_in[i];
    a.out = (float*)d_out; a.ws = (unsigned char*)d_ws;
    void* kargs[] = {&a};
    hipError_t e = hipLaunchCooperativeKernel((const void*)fwd_megakernel, dim3(grid), dim3(512), kargs, LDS_BYTES, stream);
    if (e != hipSuccess) fprintf(stderr, "cooperative launch failed: %s (grid %d)\n", hipGetErrorString(e), grid);
}
```
